# Optimizing an MI355X kernel written in HIP

```python
import math
import jax, jax.numpy as jnp
from jax import lax
import numpy as np

D_MODEL = 1024
BATCH = 2
SEQ = 8192
DEPTH = 2

LRU_WIDTH = D_MODEL // 2
LRU_HEADS = 8
LRU_HEAD_DIM = LRU_WIDTH // LRU_HEADS
CONV_WIDTH = 4
LRU_C = 8.0
RWKV_WIDTH = D_MODEL // 2
RWKV_HEAD_DIM = 64
RWKV_HEADS = RWKV_WIDTH // RWKV_HEAD_DIM
DECAY_LORA = 64
AAA_LORA = 64
GATE_LORA = 128
RWKV_IN = 3 * RWKV_WIDTH + DECAY_LORA + AAA_LORA + GATE_LORA
EVEN_IN = 2 * LRU_WIDTH + RWKV_IN
GN_EPS = 64e-5
DIFF_HEAD_DIM = 64
DIFF_HEADS = D_MODEL // (2 * DIFF_HEAD_DIM)
DIFF_V_DIM = 2 * DIFF_HEAD_DIM
QKV_DIM = 2 * DIFF_HEADS * 2 * DIFF_HEAD_DIM + DIFF_HEADS * DIFF_V_DIM
ROPE_DIM = DIFF_HEAD_DIM // 4
ROPE_THETA = 500000.0
Q_BLOCK = 128
FFN_DIM = 2816
N_EXPERTS = 8
TOP_K = 2
EXPERT_DIM = 3584
RMS_EPS = 1e-6

kernel_name = 'hybrid_rglru_rwkv7_diffattn_moe'

F32 = jnp.float32


def rms_norm(x, g, eps=RMS_EPS):
    xf = x.astype(F32)
    y = xf * lax.rsqrt(jnp.mean(jnp.square(xf), axis=-1, keepdims=True) + eps)
    return (y * g.astype(F32)).astype(x.dtype)


def token_shift(x):
    return jnp.pad(x, ((0, 0), (1, 0), (0, 0)))[:, :-1]


def swiglu(x, wg, wu, wd):
    return (jax.nn.silu(x @ wg) * (x @ wu)) @ wd


def causal_dwconv(x, w, b):
    y = lax.conv_general_dilated(x, w[:, None, :].astype(x.dtype), window_strides=(1,),
                                 padding=[(CONV_WIDTH - 1, 0)],
                                 dimension_numbers=('NWC', 'WIO', 'NWC'),
                                 feature_group_count=x.shape[-1])
    return y + b


def rg_lru(x, wa, ba, wx, bx, lam):
    B, T, _ = x.shape
    xf = x.astype(F32)
    xh = xf.reshape(B, T, LRU_HEADS, LRU_HEAD_DIM)
    gate_a = jnp.einsum('bthi,hij->bthj', xh, wa.astype(F32)).reshape(B, T, LRU_WIDTH) + ba
    gate_x = jnp.einsum('bthi,hij->bthj', xh, wx.astype(F32)).reshape(B, T, LRU_WIDTH) + bx
    log_a = -LRU_C * jax.nn.sigmoid(gate_a) * jax.nn.softplus(-lam.astype(F32))
    a = jnp.exp(log_a)
    u = jnp.sqrt(-jnp.expm1(2.0 * log_a)) * jax.nn.sigmoid(gate_x) * xf

    def combine(l, r):
        return (l[0] * r[0], r[0] * l[1] + r[1])

    _, h = lax.associative_scan(combine, (a, u), axis=1)
    return h.astype(x.dtype)


def rwkv7_scan(r, w, k, v, kk, a):
    B, T, H, N = r.shape

    def step(S, inp):
        r_t, w_t, k_t, v_t, kk_t, a_t = inp
        sa = jnp.einsum('bhvk,bhk->bhv', S, -kk_t)
        S = S * w_t[:, :, None, :] + sa[..., None] * (kk_t * a_t)[:, :, None, :] \
            + v_t[..., None] * k_t[:, :, None, :]
        o = jnp.einsum('bhvk,bhk->bhv', S, r_t)
        return S, o

    xs = tuple(jnp.moveaxis(t, 1, 0) for t in (r, w, k, v, kk, a))
    S0 = jnp.zeros((B, H, N, N), F32)
    _, o = lax.scan(step, S0, xs)
    return jnp.moveaxis(o, 0, 1)


def rwkv7_mixer(p, mu, w0, w2, a0, a2, g2, k_k, k_a, r_k, gn_w, gn_b):
    B, T, _ = p.shape
    pf = p.astype(F32)
    ps = pf + (token_shift(pf) - pf) * mu
    idx = np.cumsum([RWKV_WIDTH, RWKV_WIDTH, RWKV_WIDTH, DECAY_LORA, AAA_LORA]).tolist()
    r, k, v, xw, xa, xg = jnp.split(ps, idx, axis=-1)
    wlog = -jax.nn.softplus(-(w0 + jnp.tanh(xw) @ w2)) - 0.5
    decay = jnp.exp(-jnp.exp(wlog))
    a = jax.nn.sigmoid(a0 + xa @ a2)
    g = jax.nn.sigmoid(xg) @ g2

    def hs(t):
        return t.reshape(B, T, RWKV_HEADS, RWKV_HEAD_DIM)

    kk = hs(k * k_k)
    kk = kk / jnp.maximum(jnp.linalg.norm(kk, axis=-1, keepdims=True), 1e-12)
    k = k * (1.0 + (a - 1.0) * k_a)
    rh, kh, vh = hs(r), hs(k), hs(v)
    o = rwkv7_scan(rh, hs(decay), kh, vh, kk, hs(a))
    mean = jnp.mean(o, axis=-1, keepdims=True)
    var = jnp.mean(jnp.square(o - mean), axis=-1, keepdims=True)
    on = ((o - mean) * lax.rsqrt(var + GN_EPS)).reshape(B, T, RWKV_WIDTH) * gn_w + gn_b
    bonus = (jnp.sum(rh * kh * r_k, axis=-1, keepdims=True) * vh).reshape(B, T, RWKV_WIDTH)
    return (on + bonus) * g


def even_mixer(xn, w_in, conv_w, conv_b, gate_a_w, gate_a_b, gate_x_w, gate_x_b, lru_lambda,
               shift_mu, w0, w2, a0, a2, g2, k_k, k_a, r_k, gn_w, gn_b, w_out):
    proj = xn @ w_in
    lru_x, lru_g, rw = jnp.split(proj, [LRU_WIDTH, 2 * LRU_WIDTH], axis=-1)
    h = rg_lru(causal_dwconv(lru_x, conv_w, conv_b), gate_a_w, gate_a_b, gate_x_w, gate_x_b, lru_lambda)
    y_lru = jax.nn.gelu(lru_g) * h
    y_rwkv = rwkv7_mixer(rw, shift_mu, w0, w2, a0, a2, g2, k_k, k_a, r_k, gn_w, gn_b)
    y = jnp.concatenate([y_lru, y_rwkv.astype(y_lru.dtype)], axis=-1)
    return y @ w_out


def partial_rope(x, positions):
    half = ROPE_DIM // 2
    inv_freq = ROPE_THETA ** (-jnp.arange(0, ROPE_DIM, 2, dtype=F32) / ROPE_DIM)
    ang = positions.astype(F32)[:, :, None] * inv_freq
    cos = jnp.cos(ang)[:, :, None, None, :]
    sin = jnp.sin(ang)[:, :, None, None, :]
    xf = x.astype(F32)
    x1 = xf[..., :half]
    x2 = xf[..., half:ROPE_DIM]
    out = jnp.concatenate([x1 * cos - x2 * sin, x2 * cos + x1 * sin, xf[..., ROPE_DIM:]], axis=-1)
    return out.astype(x.dtype)


def diff_attention(xn, positions, w_qkv, q_norm, k_norm, lq1, lk1, lq2, lk2, subln, w_o, lambda_init):
    B, T, _ = xn.shape
    qkv = xn @ w_qkv
    qd = DIFF_HEADS * 2 * DIFF_HEAD_DIM
    q, k, v = jnp.split(qkv, [qd, 2 * qd], axis=-1)
    q = q.reshape(B, T, DIFF_HEADS, 2, DIFF_HEAD_DIM)
    k = k.reshape(B, T, DIFF_HEADS, 2, DIFF_HEAD_DIM)
    v = v.reshape(B, T, DIFF_HEADS, DIFF_V_DIM).astype(F32)
    q = partial_rope(rms_norm(q, q_norm), positions)
    k = partial_rope(rms_norm(k, k_norm), positions)
    lam = jnp.exp(jnp.sum(lq1.astype(F32) * lk1.astype(F32))) \
        - jnp.exp(jnp.sum(lq2.astype(F32) * lk2.astype(F32))) + lambda_init
    n_blk = T // Q_BLOCK
    qb = jnp.moveaxis(q.reshape(B, n_blk, Q_BLOCK, DIFF_HEADS, 2, DIFF_HEAD_DIM), 1, 0)
    kpos = jnp.arange(T)
    scale = DIFF_HEAD_DIM ** -0.5

    def block(args):
        q_blk, bi = args
        s = jnp.einsum('bqhcd,bkhcd->bhcqk', q_blk, k, preferred_element_type=F32) * scale
        qpos = bi * Q_BLOCK + jnp.arange(Q_BLOCK)
        s = jnp.where(kpos[None, :] <= qpos[:, None], s, -jnp.inf)
        p = jax.nn.softmax(s, axis=-1)
        attn = p[:, :, 0] - lam * p[:, :, 1]
        return jnp.einsum('bhqk,bkhe->bqhe', attn, v)

    o = lax.map(block, (qb, jnp.arange(n_blk)))
    o = jnp.moveaxis(o, 0, 1).reshape(B, T, DIFF_HEADS, DIFF_V_DIM)
    o = rms_norm(o, subln) * (1.0 - lambda_init)
    return o.reshape(B, T, DIFF_HEADS * DIFF_V_DIM).astype(xn.dtype) @ w_o


def moe_swiglu(xn, router, wg, wu, wd):
    B, T, D = xn.shape
    xt = xn.reshape(B * T, D)
    logits = (xt @ router).astype(F32)
    topv, topi = lax.top_k(logits, TOP_K)
    gates = jax.nn.softmax(topv, axis=-1)
    combine = jnp.sum(jax.nn.one_hot(topi, N_EXPERTS, dtype=F32) * gates[..., None], axis=1)
    y = jnp.zeros((B * T, D), F32)
    for e in range(N_EXPERTS):
        y = y + combine[:, e:e + 1] * swiglu(xt, wg[e], wu[e], wd[e]).astype(F32)
    return y.reshape(B, T, D).astype(xn.dtype)


def setup_inputs(seed: int = 0) -> dict:
    key = jax.random.key(seed)
    keys = jax.random.split(key, 64)
    counter = [0]

    def nk():
        kk = keys[counter[0]]
        counter[0] += 1
        return kk

    def nrm(shape, scale):
        return jax.random.normal(nk(), shape, F32) * scale

    def gain(shape):
        return 1.0 + nrm(shape, 0.02)

    ne = (DEPTH + 1) // 2
    no = DEPTH // 2
    D = D_MODEL
    x = jax.random.normal(nk(), (BATCH, SEQ, D), F32)
    positions = jnp.broadcast_to(jnp.arange(SEQ, dtype=jnp.int32), (BATCH, SEQ))
    u = jax.random.uniform(nk(), (ne, LRU_WIDTH), F32, 0.9, 0.999)
    s = u ** (1.0 / LRU_C)
    return {
        'x': x,
        'positions': positions,
        'e_ln_mix': gain((ne, D)),
        'e_w_in': nrm((ne, D, EVEN_IN), D ** -0.5),
        'e_conv_w': nrm((ne, CONV_WIDTH, LRU_WIDTH), CONV_WIDTH ** -0.5),
        'e_conv_b': nrm((ne, LRU_WIDTH), 0.01),
        'e_gate_a_w': nrm((ne, LRU_HEADS, LRU_HEAD_DIM, LRU_HEAD_DIM), LRU_HEAD_DIM ** -0.5),
        'e_gate_a_b': nrm((ne, LRU_WIDTH), 0.01),
        'e_gate_x_w': nrm((ne, LRU_HEADS, LRU_HEAD_DIM, LRU_HEAD_DIM), LRU_HEAD_DIM ** -0.5),
        'e_gate_x_b': nrm((ne, LRU_WIDTH), 0.01),
        'e_lru_lambda': jnp.log(s) - jnp.log1p(-s),
        'e_shift_mu': jax.random.uniform(nk(), (ne, RWKV_IN), F32),
        'e_w0': jax.random.uniform(nk(), (ne, RWKV_WIDTH), F32, -6.0, 1.0),
        'e_w2': nrm((ne, DECAY_LORA, RWKV_WIDTH), 0.1),
        'e_a0': nrm((ne, RWKV_WIDTH), 0.1),
        'e_a2': nrm((ne, AAA_LORA, RWKV_WIDTH), 0.1),
        'e_g2': nrm((ne, GATE_LORA, RWKV_WIDTH), GATE_LORA ** -0.5),
        'e_k_k': 0.85 + nrm((ne, RWKV_WIDTH), 0.02),
        'e_k_a': gain((ne, RWKV_WIDTH)),
        'e_r_k': nrm((ne, RWKV_HEADS, RWKV_HEAD_DIM), 0.1),
        'e_gn_w': gain((ne, RWKV_WIDTH)),
        'e_gn_b': nrm((ne, RWKV_WIDTH), 0.01),
        'e_w_out': nrm((ne, D, D), D ** -0.5),
        'e_ln_ffn': gain((ne, D)),
        'e_ffn_gate': nrm((ne, D, FFN_DIM), D ** -0.5),
        'e_ffn_up': nrm((ne, D, FFN_DIM), D ** -0.5),
        'e_ffn_down': nrm((ne, FFN_DIM, D), FFN_DIM ** -0.5),
        'o_ln_mix': gain((no, D)),
        'o_w_qkv': nrm((no, D, QKV_DIM), D ** -0.5),
        'o_q_norm': gain((no, DIFF_HEAD_DIM)),
        'o_k_norm': gain((no, DIFF_HEAD_DIM)),
        'o_lambda_q1': nrm((no, DIFF_HEAD_DIM), 0.1),
        'o_lambda_k1': nrm((no, DIFF_HEAD_DIM), 0.1),
        'o_lambda_q2': nrm((no, DIFF_HEAD_DIM), 0.1),
        'o_lambda_k2': nrm((no, DIFF_HEAD_DIM), 0.1),
        'o_subln': gain((no, DIFF_V_DIM)),
        'o_w_o': nrm((no, DIFF_HEADS * DIFF_V_DIM, D), D ** -0.5),
        'o_ln_ffn': gain((no, D)),
        'o_router': nrm((no, D, N_EXPERTS), D ** -0.5),
        'o_moe_gate': nrm((no, N_EXPERTS, D, EXPERT_DIM), D ** -0.5),
        'o_moe_up': nrm((no, N_EXPERTS, D, EXPERT_DIM), D ** -0.5),
        'o_moe_down': nrm((no, N_EXPERTS, EXPERT_DIM, D), EXPERT_DIM ** -0.5),
    }


def reference(x, positions, e_ln_mix, e_w_in, e_conv_w, e_conv_b, e_gate_a_w, e_gate_a_b,
              e_gate_x_w, e_gate_x_b, e_lru_lambda, e_shift_mu, e_w0, e_w2, e_a0, e_a2, e_g2,
              e_k_k, e_k_a, e_r_k, e_gn_w, e_gn_b, e_w_out, e_ln_ffn, e_ffn_gate, e_ffn_up,
              e_ffn_down, o_ln_mix, o_w_qkv, o_q_norm, o_k_norm, o_lambda_q1, o_lambda_k1,
              o_lambda_q2, o_lambda_k2, o_subln, o_w_o, o_ln_ffn, o_router, o_moe_gate,
              o_moe_up, o_moe_down):
    for i in range(DEPTH):
        j = i // 2
        if i % 2 == 0:
            h = rms_norm(x, e_ln_mix[j])
            x = x + even_mixer(h, e_w_in[j], e_conv_w[j], e_conv_b[j], e_gate_a_w[j], e_gate_a_b[j],
                               e_gate_x_w[j], e_gate_x_b[j], e_lru_lambda[j], e_shift_mu[j], e_w0[j],
                               e_w2[j], e_a0[j], e_a2[j], e_g2[j], e_k_k[j], e_k_a[j], e_r_k[j],
                               e_gn_w[j], e_gn_b[j], e_w_out[j])
            h = rms_norm(x, e_ln_ffn[j])
            x = x + swiglu(h, e_ffn_gate[j], e_ffn_up[j], e_ffn_down[j])
        else:
            lambda_init = 0.8 - 0.6 * math.exp(-0.3 * i)
            h = rms_norm(x, o_ln_mix[j])
            x = x + diff_attention(h, positions, o_w_qkv[j], o_q_norm[j], o_k_norm[j],
                                   o_lambda_q1[j], o_lambda_k1[j], o_lambda_q2[j], o_lambda_k2[j],
                                   o_subln[j], o_w_o[j], lambda_init)
            h = rms_norm(x, o_ln_ffn[j])
            x = x + moe_swiglu(h, o_router[j], o_moe_gate[j], o_moe_up[j], o_moe_down[j])
    return x
```

```cpp
#include <hip/hip_runtime.h>
#include <hip/hip_bf16.h>
#include <cstdio>
#include <cstdint>
#include <cmath>

#define LAS __attribute__((address_space(3)))
#define GAS __attribute__((address_space(1)))
typedef unsigned short bf16;
typedef short bf16x8 __attribute__((ext_vector_type(8)));
typedef float f32x4 __attribute__((ext_vector_type(4)));
typedef float f32x2 __attribute__((ext_vector_type(2)));
typedef unsigned u32x4 __attribute__((ext_vector_type(4)));
typedef unsigned u32x2 __attribute__((ext_vector_type(2)));
typedef GAS unsigned gu32;

__device__ __forceinline__ unsigned cvt_pk_bf16(float lo, float hi) { unsigned r; asm volatile("v_cvt_pk_bf16_f32 %0, %1, %2" : "=v"(r) : "v"(lo), "v"(hi)); return r; }
__device__ __forceinline__ float bflo(unsigned w) { return __builtin_bit_cast(float, w << 16); }
__device__ __forceinline__ float bfhi(unsigned w) { return __builtin_bit_cast(float, w & 0xffff0000u); }
__device__ __forceinline__ float bf1(bf16 b) { return __builtin_bit_cast(float, (unsigned)b << 16); }
__device__ __forceinline__ bf16 f2bf(float f) { return (bf16)(cvt_pk_bf16(f, 0.f) & 0xffffu); }
__device__ __forceinline__ float rbf(float f) { return bflo(cvt_pk_bf16(f, 0.f)); }
__device__ __forceinline__ void unpack8(u32x4 w, float (&f)[8]) { f[0] = bflo(w.x); f[1] = bfhi(w.x); f[2] = bflo(w.y); f[3] = bfhi(w.y); f[4] = bflo(w.z); f[5] = bfhi(w.z); f[6] = bflo(w.w); f[7] = bfhi(w.w); }
__device__ __forceinline__ u32x4 pack8(const float (&f)[8]) { u32x4 w; w.x = cvt_pk_bf16(f[0], f[1]); w.y = cvt_pk_bf16(f[2], f[3]); w.z = cvt_pk_bf16(f[4], f[5]); w.w = cvt_pk_bf16(f[6], f[7]); return w; }
__device__ __forceinline__ float wave_sum(float v) {
#pragma unroll
    for (int o = 1; o < 64; o <<= 1) v += __shfl_xor(v, o);
    return v;
}
__device__ __forceinline__ float sigmoidf_(float x) { return __builtin_amdgcn_rcpf(1.0f + __expf(-x)); }
__device__ __forceinline__ float tanhf_(float x) { const float e = __expf(2.0f * x); return 1.0f - 2.0f * __builtin_amdgcn_rcpf(e + 1.0f); }
__device__ __forceinline__ float gelu_tanh(float x) { return 0.5f * x * (1.0f + tanhf_(0.7978845608028654f * (x + 0.044715f * x * x * x))); }
__device__ __forceinline__ float silu_(float x) { return x * __builtin_amdgcn_rcpf(1.0f + __expf(-x)); }
#define ONE_LAUNCH 1
namespace pg8 {
typedef unsigned short bf16_t;
constexpr int BM = 256, BK = 64, HALF = 128, HTB = HALF * BK * 2  , STAGE_BYTES = 8 * HTB, NXCD = 8, WGM = 8;
__host__ __device__ __forceinline__ int lds_byte(int r, int c) { const int st = (r >> 4) * 2 + (c >> 5), rr = r & 15, cc = c & 31, ob = rr * 64 + cc * 2; return st * 1024 + (ob ^ (((ob >> 9) & 1) << 5)); }
__host__ __device__ __forceinline__ void stage_rc(int b, int& R, int& C) { const int st = b / 1024, sb = b % 1024, swz = sb ^ (((sb >> 9) & 1) << 5); R = (st >> 1) * 16 + swz / 64; C = (st & 1) * 32 + (swz % 64) / 2; }
__host__ __device__ __forceinline__ int perm32(int rho) { const int n = rho >> 4, i = rho & 15; return 8 * (i >> 2) + 4 * n + (i & 3); }

struct Unit { int pm, pn, pb; };
struct Gemm { const bf16_t* A; const bf16_t* Bt; int K; int scale; int ld; };
typedef int i32x4_t __attribute__((ext_vector_type(4))); typedef int i32x8_t __attribute__((ext_vector_type(8)));

__device__ __forceinline__ void order_map(int L, int nwg, int nM, int nN, int& pm, int& pn) {
    int wgid = L; { const int q = nwg / NXCD, r = nwg % NXCD, xcd = wgid % NXCD, off = wgid / NXCD; wgid = (xcd < r ? xcd * (q + 1) : r * (q + 1) + (xcd - r) * q) + off; }
    const int nig = WGM * nN, gid = wgid / nig, fm = gid * WGM, gsz = (nM - fm) < WGM ? (nM - fm) : WGM;
    pm = fm + ((wgid % nig) % gsz); pn = (wgid % nig) / gsz;
}
template <int KMODE> struct StaticOrderT {
    int nM, nN, nwg, G, c;
    __device__ __forceinline__ void init(int M, int N, int G_, int c_) { nM = M / BM; nN = N / BM; nwg = nM * nN; G = G_; c = c_; }
    __device__ __forceinline__ int koff(const Unit& u) const { return KMODE == 1 ? (u.pn >= 4 ? 128 : 0) : KMODE == 2 ? (u.pn & 1) * 256 : 0; }
    __device__ __forceinline__ bool next(int i, Unit& u) const {
        const long L = (long)i * G + c; if (L >= nwg) return false;
        order_map((int)L, nwg, nM, nN, u.pm, u.pn); u.pb = u.pn; return true;
    }
    __device__ __forceinline__ int gather(const Unit&, int) const { return 0; }
    __device__ __forceinline__ const int* gather_ptr(const Unit&, int) const { return nullptr; }
};
typedef StaticOrderT<0> StaticOrder;
struct MoeOrder {
    int t1, t2, t3, t4, t5, t6, t7, t8;
    int c0, c1, c2, c3, c4, c5, c6, c7;
    int nN, nwg, lim, G, c; const int* list;
    __device__ __forceinline__ void init(const unsigned* cntw, int nN_, int G_, int c_, const int* list_) {
        c0 = (int)__builtin_amdgcn_readfirstlane(__hip_atomic_load(cntw + 0 * 64, __ATOMIC_RELAXED, __HIP_MEMORY_SCOPE_AGENT));
        c1 = (int)__builtin_amdgcn_readfirstlane(__hip_atomic_load(cntw + 1 * 64, __ATOMIC_RELAXED, __HIP_MEMORY_SCOPE_AGENT));
        c2 = (int)__builtin_amdgcn_readfirstlane(__hip_atomic_load(cntw + 2 * 64, __ATOMIC_RELAXED, __HIP_MEMORY_SCOPE_AGENT));
        c3 = (int)__builtin_amdgcn_readfirstlane(__hip_atomic_load(cntw + 3 * 64, __ATOMIC_RELAXED, __HIP_MEMORY_SCOPE_AGENT));
        c4 = (int)__builtin_amdgcn_readfirstlane(__hip_atomic_load(cntw + 4 * 64, __ATOMIC_RELAXED, __HIP_MEMORY_SCOPE_AGENT));
        c5 = (int)__builtin_amdgcn_readfirstlane(__hip_atomic_load(cntw + 5 * 64, __ATOMIC_RELAXED, __HIP_MEMORY_SCOPE_AGENT));
        c6 = (int)__builtin_amdgcn_readfirstlane(__hip_atomic_load(cntw + 6 * 64, __ATOMIC_RELAXED, __HIP_MEMORY_SCOPE_AGENT));
        c7 = (int)__builtin_amdgcn_readfirstlane(__hip_atomic_load(cntw + 7 * 64, __ATOMIC_RELAXED, __HIP_MEMORY_SCOPE_AGENT));
        t1 = (c0 + 255) >> 8; t2 = t1 + ((c1 + 255) >> 8); t3 = t2 + ((c2 + 255) >> 8); t4 = t3 + ((c3 + 255) >> 8);
        t5 = t4 + ((c4 + 255) >> 8); t6 = t5 + ((c5 + 255) >> 8); t7 = t6 + ((c6 + 255) >> 8); t8 = t7 + ((c7 + 255) >> 8);
        nN = nN_; nwg = t8 * nN_; lim = nwg; G = G_; c = c_; list = list_;
    }
    __device__ __forceinline__ int koff(const Unit&) const { return 0; }
    __device__ __forceinline__ int expert_of(int pm) const { return (pm >= t1) + (pm >= t2) + (pm >= t3) + (pm >= t4) + (pm >= t5) + (pm >= t6) + (pm >= t7); }
    __device__ __forceinline__ bool next(int i, Unit& u) const {
        const long L = (long)i * G + c; if (L >= lim) return false;
        order_map((int)L, nwg, t8, nN, u.pm, u.pn); u.pb = expert_of(u.pm) * nN + u.pn; return true;
    }
    __device__ __forceinline__ int gather(const Unit& u, int r) const {
        const int e = expert_of(u.pm);
        const int tb = e == 0 ? 0 : e == 1 ? t1 : e == 2 ? t2 : e == 3 ? t3 : e == 4 ? t4 : e == 5 ? t5 : e == 6 ? t6 : t7;
        const int ce = e == 0 ? c0 : e == 1 ? c1 : e == 2 ? c2 : e == 3 ? c3 : e == 4 ? c4 : e == 5 ? c5 : e == 6 ? c6 : c7;
        int slot = (u.pm - tb) * 256 + r; if (slot >= ce) slot = 0;
        return list[e * 16384 + slot];
    }
    __device__ __forceinline__ const int* gather_ptr(const Unit& u, int r) const {
        const int e = expert_of(u.pm);
        const int tb = e == 0 ? 0 : e == 1 ? t1 : e == 2 ? t2 : e == 3 ? t3 : e == 4 ? t4 : e == 5 ? t5 : e == 6 ? t6 : t7;
        const int ce = e == 0 ? c0 : e == 1 ? c1 : e == 2 ? c2 : e == 3 ? c3 : e == 4 ? c4 : e == 5 ? c5 : e == 6 ? c6 : c7;
        int slot = (u.pm - tb) * 256 + r; if (slot >= ce) slot = 0;
        return list + e * 16384 + slot;
    }
};

struct TailOrder {
    Unit u0;
    __device__ __forceinline__ int koff(const Unit&) const { return 0; }
    __device__ __forceinline__ bool next(int i, Unit& u) const { if (i != 0) return false; u = u0; return true; }
    __device__ __forceinline__ int gather(const Unit&, int) const { return 0; }
    __device__ __forceinline__ const int* gather_ptr(const Unit&, int) const { return nullptr; }
};

struct EpiStore {
    static constexpr bool PERM = true;
    static constexpr int NST = 8;
    bf16_t* O; int ldc; int split_cols; size_t split_stride;
    __device__ __forceinline__ void operator()(const f32x4 (&acc)[2][2][4][2], const Unit& u, int wr, int wc, int fr, int fq, const float* rowv = nullptr, int ai_lo = 0, int ai_hi = 2) const {
        const int row0 = u.pm * BM + wr * 64 + fr; int colt = u.pn * BM; bf16_t* base = O;
        if (split_cols) { const int t = colt / split_cols; base += (size_t)t * split_stride; colt -= t * split_cols; }
        const int col0 = colt + wc * 64 + 8 * fq;
#pragma unroll
        for (int ai = 0; ai < 2; ++ai) if (ai >= ai_lo && ai < ai_hi)
#pragma unroll
            for (int m = 0; m < 4; ++m) { bf16_t* rowp = base + (size_t)(row0 + ai * HALF + m * 16) * ldc + col0; const float r = rowv ? rowv[ai * 4 + m] : 1.0f;
#pragma unroll
                for (int bj = 0; bj < 2; ++bj) { const f32x4 v0 = acc[ai][bj][m][0] * r, v1 = acc[ai][bj][m][1] * r;
                    u32x4 w; w.x = cvt_pk_bf16(v0[0], v0[1]); w.y = cvt_pk_bf16(v0[2], v0[3]); w.z = cvt_pk_bf16(v1[0], v1[1]); w.w = cvt_pk_bf16(v1[2], v1[3]);
                    *(u32x4*)(rowp + bj * 32) = w; } }
    }
};
struct EpiSplitK {
    static constexpr bool PERM = true; static constexpr int SK = 7, RW = 37;
    float* part; int ks; unsigned* cnt; bf16_t* O; int ldc;
    __device__ __forceinline__ void operator()(const f32x4 (&acc)[2][2][4][2], const Unit& u, int wr, int wc, int fr, int fq) const {
        float* P = part + (size_t)ks * (BM * BM);
        const int row0 = wr * 64 + fr, col0 = wc * 64 + 8 * fq;
#pragma unroll
        for (int ai = 0; ai < 2; ++ai)
#pragma unroll
            for (int m = 0; m < 4; ++m) { float* rowp = P + (row0 + ai * HALF + m * 16) * BM + col0;
#pragma unroll
                for (int bj = 0; bj < 2; ++bj) { *(f32x4*)(rowp + bj * 32) = acc[ai][bj][m][0]; *(f32x4*)(rowp + bj * 32 + 4) = acc[ai][bj][m][1]; } }
        asm volatile("s_waitcnt vmcnt(0)" ::: "memory");
        __syncthreads();
        if (threadIdx.x == 0) {
            __builtin_amdgcn_fence(__ATOMIC_RELEASE, "agent");
            (void)__hip_atomic_fetch_add(cnt, 1u, __ATOMIC_RELAXED, __HIP_MEMORY_SCOPE_AGENT);
            unsigned sp = 0u;
            while (__hip_atomic_load(cnt, __ATOMIC_RELAXED, __HIP_MEMORY_SCOPE_AGENT) < (unsigned)SK) { __builtin_amdgcn_s_sleep(1); if (++sp > (1u << 22)) break; }
            __builtin_amdgcn_fence(__ATOMIC_ACQUIRE, "agent");
        }
        __syncthreads();
        const int r0 = ks * RW, nr = (BM - r0) < RW ? (BM - r0) : RW;
        constexpr int NI = (RW * 64 + 511) / 512;
        f32x4 v[NI][SK];
#pragma unroll
        for (int i = 0; i < NI; ++i) { int f = (int)threadIdx.x + 512 * i; f = f < nr * 64 ? f : nr * 64 - 1;
            const float* src = part + (r0 + (f >> 6)) * BM + (f & 63) * 4;
#pragma unroll
            for (int k = 0; k < SK; ++k) v[i][k] = *(const f32x4*)(src + (size_t)k * (BM * BM)); }
#pragma unroll
        for (int i = 0; i < NI; ++i) { const int f = (int)threadIdx.x + 512 * i;
            f32x4 s = v[i][0];
#pragma unroll
            for (int k = 1; k < SK; ++k) s += v[i][k];
            u32x2 w; w.x = cvt_pk_bf16(s[0], s[1]); w.y = cvt_pk_bf16(s[2], s[3]);
            if (f < nr * 64) *(u32x2*)(O + (size_t)(u.pm * BM + r0 + (f >> 6)) * ldc + u.pn * BM + (f & 63) * 4) = w; }
    }
};
struct EpiSwiGLU {
    static constexpr bool PERM = true;
    static constexpr int NST = 4;
    bf16_t* H; int ldh;
    __device__ __forceinline__ void operator()(const f32x4 (&acc)[2][2][4][2], const Unit& u, int wr, int wc, int fr, int fq, const float* rowv = nullptr, int ai_lo = 0, int ai_hi = 2) const {
        const int row0 = u.pm * BM + wr * 64 + fr; const int col0 = u.pn * HALF + wc * 32 + 8 * fq;
#pragma unroll
        for (int ai = 0; ai < 2; ++ai) if (ai >= ai_lo && ai < ai_hi)
#pragma unroll
            for (int m = 0; m < 4; ++m) { bf16_t* rowp = H + (size_t)(row0 + ai * HALF + m * 16) * ldh + col0; const float r = rowv ? rowv[ai * 4 + m] : 1.0f;
                const f32x4 g0 = acc[ai][0][m][0] * r, g1 = acc[ai][0][m][1] * r, u0 = acc[ai][1][m][0] * r, u1 = acc[ai][1][m][1] * r;
                u32x4 w; w.x = cvt_pk_bf16(silu_(g0[0]) * u0[0], silu_(g0[1]) * u0[1]); w.y = cvt_pk_bf16(silu_(g0[2]) * u0[2], silu_(g0[3]) * u0[3]);
                w.z = cvt_pk_bf16(silu_(g1[0]) * u1[0], silu_(g1[1]) * u1[1]); w.w = cvt_pk_bf16(silu_(g1[2]) * u1[2], silu_(g1[3]) * u1[3]);
                *(u32x4*)rowp = w; }
    }
};
__device__ __forceinline__ unsigned pk4_fp8(float a, float b, float c, float d) { int v = 0; v = __builtin_amdgcn_cvt_pk_fp8_f32(a, b, v, false); v = __builtin_amdgcn_cvt_pk_fp8_f32(c, d, v, true); return (unsigned)v; }
struct EpiSwiGLU8 {
    static constexpr bool PERM = true;
    static constexpr int NST = 4;
    unsigned char* H; int ldh; float oscale;
    __device__ __forceinline__ void operator()(const f32x4 (&acc)[2][2][4][2], const Unit& u, int wr, int wc, int fr, int fq, const float* rowv = nullptr, int ai_lo = 0, int ai_hi = 2) const {
        const int row0 = u.pm * BM + wr * 64 + fr; const int col0 = u.pn * HALF + wc * 32 + 8 * fq;
#pragma unroll
        for (int ai = 0; ai < 2; ++ai) if (ai >= ai_lo && ai < ai_hi)
#pragma unroll
            for (int m = 0; m < 4; ++m) { unsigned char* rowp = H + (size_t)(row0 + ai * HALF + m * 16) * ldh + col0;
                const f32x4 g0 = acc[ai][0][m][0], g1 = acc[ai][0][m][1], u0 = acc[ai][1][m][0] * oscale, u1 = acc[ai][1][m][1] * oscale;
                u32x2 w; w.x = pk4_fp8(silu_(g0[0]) * u0[0], silu_(g0[1]) * u0[1], silu_(g0[2]) * u0[2], silu_(g0[3]) * u0[3]);
                w.y = pk4_fp8(silu_(g1[0]) * u1[0], silu_(g1[1]) * u1[1], silu_(g1[2]) * u1[2], silu_(g1[3]) * u1[3]);
                *(u32x2*)rowp = w; }
    }
};
template <class Base> struct RowScaled : Base {
    const float* rsq;
    static constexpr int NST = Base::NST;
    __device__ __forceinline__ void operator()(const f32x4 (&acc)[2][2][4][2], const Unit& u, int wr, int wc, int fr, int fq, const float (&ss)[8], int ai_lo = 0, int ai_hi = 2) const {
        float rowv[8];
#pragma unroll
        for (int i = 0; i < 8; ++i) rowv[i] = rsqrtf(ss[i] * (1.0f / 1024.0f) + 1e-6f);
        Base::operator()(acc, u, wr, wc, fr, fq, rowv, ai_lo, ai_hi);
    }
};
template <class T> struct epi_split { static constexpr int nst = 0; };
template <> struct epi_split<EpiStore> { static constexpr int nst = EpiStore::NST; };
template <> struct epi_split<EpiSwiGLU> { static constexpr int nst = EpiSwiGLU::NST; };
template <> struct epi_split<EpiSwiGLU8> { static constexpr int nst = 0; };
template <class B> struct epi_split<RowScaled<B>> { static constexpr int nst = epi_split<B>::nst; };
template <class T> struct is_rowscaled { static constexpr bool value = false; };
template <class B> struct is_rowscaled<RowScaled<B>> { static constexpr bool value = true; };
constexpr int ROWS_OFF = STAGE_BYTES + 1024;
struct EpiResid {
    static constexpr bool PERM = false;
    const float* resid; float* out; int ldc;
    __device__ __forceinline__ void operator()(const f32x4 (&acc)[2][2][4][2], const Unit& u, int wr, int wc, int fr, int fq) const {
        const int col0 = u.pn * BM + wc * 32 + 4 * fq;
#pragma unroll
        for (int ai = 0; ai < 2; ++ai)
#pragma unroll
            for (int m = 0; m < 4; ++m) { const size_t off = (size_t)(u.pm * BM + ai * HALF + wr * 64 + m * 16 + fr) * ldc + col0;
                f32x4 rs[2][2];
#pragma unroll
                for (int bj = 0; bj < 2; ++bj)
#pragma unroll
                    for (int n = 0; n < 2; ++n) rs[bj][n] = *(const f32x4*)(resid + off + bj * HALF + n * 16);
#pragma unroll
                for (int bj = 0; bj < 2; ++bj)
#pragma unroll
                    for (int n = 0; n < 2; ++n) *(f32x4*)(out + off + bj * HALF + n * 16) = rs[bj][n] + acc[ai][bj][m][n];
                if (m & 1) asm volatile("" ::: "memory"); }
    }
};

struct EpiResidB {
    static constexpr bool PERM = true;
    const float* rf; const bf16_t* rb; bf16_t* O; int ldc; float* rsq;
    __device__ __forceinline__ void operator()(const f32x4 (&acc)[2][2][4][2], const Unit& u, int wr, int wc, int fr, int fq) const {
        const int col0 = u.pn * BM + wc * 64 + 8 * fq;
#pragma unroll
        for (int ai = 0; ai < 2; ++ai)
#pragma unroll
            for (int m = 0; m < 4; ++m) { const size_t off = (size_t)(u.pm * BM + ai * HALF + wr * 64 + m * 16 + fr) * ldc + col0;
                f32x4 rs[2][2];
#pragma unroll
                for (int bj = 0; bj < 2; ++bj) {
                    if (rf) { rs[bj][0] = *(const f32x4*)(rf + off + bj * 32); rs[bj][1] = *(const f32x4*)(rf + off + bj * 32 + 4); }
                    else { const u32x4 w = *(const u32x4*)(rb + off + bj * 32); rs[bj][0] = (f32x4){bflo(w.x), bfhi(w.x), bflo(w.y), bfhi(w.y)}; rs[bj][1] = (f32x4){bflo(w.z), bfhi(w.z), bflo(w.w), bfhi(w.w)}; } }
                float ss = 0.f;
#pragma unroll
                for (int bj = 0; bj < 2; ++bj) { const f32x4 v0 = rs[bj][0] + acc[ai][bj][m][0], v1 = rs[bj][1] + acc[ai][bj][m][1];
                    ss += (v0[0] * v0[0] + v0[1] * v0[1]) + (v0[2] * v0[2] + v0[3] * v0[3]) + (v1[0] * v1[0] + v1[1] * v1[1]) + (v1[2] * v1[2] + v1[3] * v1[3]);
                    u32x4 w; w.x = cvt_pk_bf16(v0[0], v0[1]); w.y = cvt_pk_bf16(v0[2], v0[3]); w.z = cvt_pk_bf16(v1[0], v1[1]); w.w = cvt_pk_bf16(v1[2], v1[3]);
                    *(u32x4*)(O + off + bj * 32) = w; }
                if (rsq) { ss += __shfl_xor(ss, 16); ss += __shfl_xor(ss, 32);
                    ss = rintf(ss * 256.0f) * (1.0f / 256.0f);
                    if (fq == 0) (void)__hip_atomic_fetch_add(rsq + u.pm * BM + ai * HALF + wr * 64 + m * 16 + fr, ss, __ATOMIC_RELAXED, __HIP_MEMORY_SCOPE_AGENT); }
                if (m & 1) asm volatile("" ::: "memory"); }
    }
};

#ifndef PG8_SPLIT_EPI
#define PG8_SPLIT_EPI 1
#endif
#ifndef PG8_ALIGN_DEFAULT
#define PG8_ALIGN_DEFAULT true
#endif
template <class Epi, class Sched, bool GATHER, bool FP8 = false, bool ALIGN_EPI = PG8_ALIGN_DEFAULT>
__device__ __forceinline__ void gemm_phase(LAS unsigned char* lds, const Gemm g, const Sched& S, const Epi& E) {
    const int tid = threadIdx.x, wid = __builtin_amdgcn_readfirstlane(tid >> 6), lane = tid & 63, wr = wid >> 2, wc = wid & 3, fr = lane & 15, fq = lane >> 4;
    const int K = g.ld ? g.ld : g.K; int nt = g.K / BK; asm volatile("" : "+s"(nt));
    const size_t kstep = (size_t)(BK * 2);
    const size_t hstep = (size_t)HALF * K * 2;
    const size_t tstep = 2 * hstep;
    int sR[2], sC[2];
    unsigned voffB[2];
    const size_t bstep = Epi::PERM ? (size_t)32 * K * 2 : hstep;
#pragma unroll
    for (int i = 0; i < 2; ++i) { stage_rc(tid * 16 + i * 8192, sR[i], sC[i]);
        const int Rb0 = Epi::PERM ? (64 * (sR[i] >> 5) + perm32(sR[i] & 31)) : sR[i];
        voffB[i] = (unsigned)(Rb0 * K + sC[i]) * 2u; }
    const unsigned ldsw = (unsigned)wid * 1024u;
    const int aoff = lds_byte(wr * 64 + fr, fq * 8), boff = lds_byte(wc * 32 + fr, fq * 8);
#define PG8_SA(b, h) (((b) * 2 + (h)) * HTB)
#define PG8_SB(b, h) ((4 + (b) * 2 + (h)) * HTB)
#define PG8_STAGE(bufoff, gbase, voff) do { _Pragma("unroll") for (int _i = 0; _i < 2; ++_i) \
        __builtin_amdgcn_global_load_lds((const unsigned*)((const char*)(gbase) + (voff)[_i]), (LAS unsigned*)(lds + (bufoff) + ldsw + _i * 8192), 16, 0, 0); } while (0)
#define PG8_STAGEA(bufoff, gbase, o0, o1) do { \
        __builtin_amdgcn_global_load_lds((const unsigned*)((const char*)(gbase) + (o0)), (LAS unsigned*)(lds + (bufoff) + ldsw), 16, 0, 0); \
        __builtin_amdgcn_global_load_lds((const unsigned*)((const char*)(gbase) + (o1)), (LAS unsigned*)(lds + (bufoff) + ldsw + 8192), 16, 0, 0); } while (0)
#define PG8_LDA(dst, b, h) do { _Pragma("unroll") for (int m = 0; m < 4; ++m) _Pragma("unroll") for (int k = 0; k < 2; ++k) dst[m][k] = *(const LAS bf16x8*)(lds + PG8_SA(b, h) + aoff + m * 2048 + k * 1024); } while (0)
#define PG8_LDB(dst, b, h) do { _Pragma("unroll") for (int n = 0; n < 2; ++n) _Pragma("unroll") for (int k = 0; k < 2; ++k) dst[n][k] = *(const LAS bf16x8*)(lds + PG8_SB(b, h) + boff + n * 2048 + k * 1024); } while (0)
#define PG8_CAT(x) __builtin_shufflevector(__builtin_bit_cast(i32x4_t, x[0]), __builtin_bit_cast(i32x4_t, x[1]), 0, 1, 2, 3, 4, 5, 6, 7)
#define PG8_MMA(ai, bj, At, Bt) do { __builtin_amdgcn_s_setprio(1); \
        if constexpr (FP8) { _Pragma("unroll") for (int m = 0; m < 4; ++m) _Pragma("unroll") for (int n = 0; n < 2; ++n) \
            { const i32x8_t b8_ = PG8_CAT(Bt[n]), a8_ = PG8_CAT(At[m]); asm volatile("v_mfma_scale_f32_16x16x128_f8f6f4 %0, %1, %2, %0, %3, %4 op_sel_hi:[0,0,0]" : "+v"(acc[ai][bj][m][n]) : "v"(b8_), "v"(a8_), "v"(sc_w), "v"(sc_a)); } } \
        else { _Pragma("unroll") for (int m = 0; m < 4; ++m) _Pragma("unroll") for (int n = 0; n < 2; ++n) _Pragma("unroll") for (int k = 0; k < 2; ++k) \
            acc[ai][bj][m][n] = __builtin_amdgcn_mfma_f32_16x16x32_bf16(Bt[n][k], At[m][k], acc[ai][bj][m][n], 0, 0, 0); } \
        __builtin_amdgcn_s_setprio(0); } while (0)
#define PG8_WAIT_V(n) asm volatile("s_waitcnt vmcnt(" #n ")" ::: "memory")
#define PG8_WAIT_L(n) asm volatile("s_waitcnt lgkmcnt(" #n ")" ::: "memory")
#define PG8_BAR __builtin_amdgcn_s_barrier()
#define PG8_SCHED __builtin_amdgcn_sched_barrier(0)
    Unit cur, nxt; int ui = 0;
    if (!S.next(0, cur)) return;
    constexpr bool ROWS = is_rowscaled<Epi>::value;
    constexpr int SPLIT_NST = PG8_SPLIT_EPI ? epi_split<Epi>::nst : 0;
#define PG8_EPI(lo, hi) do { int fr_ = fr, fq_ = fq; asm volatile("" : "+v"(fr_), "+v"(fq_));        \
        if constexpr (ROWS) { float ssv[8]; _Pragma("unroll") for (int i_ = 0; i_ < 8; ++i_) ssv[i_] = *(const LAS float*)(lds + ROWS_OFF + rsl * 1024 + (wr * 64 + fr_ + (i_ >> 2) * HALF + (i_ & 3) * 16) * 4); \
        E(acc, cur, wr, wc, fr_, fq_, ssv, lo, hi); } else if constexpr (SPLIT_NST > 0) E(acc, cur, wr, wc, fr_, fq_, nullptr, lo, hi); else E(acc, cur, wr, wc, fr_, fq_); } while (0)
    int rsl = 0; (void)rsl;
#define PG8_ROWDMA(unit, slot) do { if constexpr (ROWS) { if (wid < 4) __builtin_amdgcn_global_load_lds((const unsigned*)(E.rsq + (size_t)(unit).pm * BM + wid * 64 + lane), \
        (LAS unsigned*)(lds + ROWS_OFF + (slot) * 1024 + wid * 256), 4, 0, 0); } } while (0)
    PG8_ROWDMA(cur, 0);
    int sc_w = g.scale, sc_a = 0x7f7f7f7f; asm volatile("" : "+v"(sc_w), "+v"(sc_a));
    (void)sc_w; (void)sc_a;
    unsigned oC00, oC01, oC10, oC11, oN00, oN01, oN10, oN11;
    if constexpr (GATHER) {
        oC00 = (unsigned)(S.gather(cur, sR[0]) * K + sC[0]) * 2u; oC01 = (unsigned)(S.gather(cur, sR[1]) * K + sC[1]) * 2u;
        oC10 = (unsigned)(S.gather(cur, 128 + sR[0]) * K + sC[0]) * 2u; oC11 = (unsigned)(S.gather(cur, 128 + sR[1]) * K + sC[1]) * 2u;
    } else {
        oC00 = (unsigned)(sR[0] * K + sC[0]) * 2u; oC01 = (unsigned)(sR[1] * K + sC[1]) * 2u; oC10 = oC00 + (unsigned)hstep; oC11 = oC01 + (unsigned)hstep;
    }
    oN00 = oC00; oN01 = oC01; oN10 = oC10; oN11 = oC11;
    int tkN0 = 0, tkN1 = 0, tkN2 = 0, tkN3 = 0; bool gnext = false; (void)tkN0; (void)tkN1; (void)tkN2; (void)tkN3; (void)gnext;
    f32x4 acc[2][2][4][2];
#pragma unroll
    for (int a = 0; a < 2; ++a)
#pragma unroll
        for (int b = 0; b < 2; ++b)
#pragma unroll
            for (int m = 0; m < 4; ++m)
#pragma unroll
                for (int n = 0; n < 2; ++n) acc[a][b][m][n] = (f32x4){0.f, 0.f, 0.f, 0.f};
    bf16x8 At[4][2], B0[2][2], B1[2][2];
    const char* cA = (const char*)g.A + (GATHER ? (size_t)0 : (size_t)cur.pm * tstep) + S.koff(cur) * 2; const char* cB = (const char*)g.Bt + (size_t)cur.pb * tstep + S.koff(cur) * 2;
    PG8_STAGE(PG8_SB(0, 0), cB, voffB); PG8_STAGE(PG8_SB(0, 1), cB + bstep, voffB); PG8_STAGEA(PG8_SA(0, 0), cA, oC00, oC01); PG8_STAGEA(PG8_SA(0, 1), cA, oC10, oC11);
    if (wr == 1) PG8_BAR;
    PG8_WAIT_V(2); PG8_BAR;
    PG8_STAGE(PG8_SB(1, 0), cB + kstep, voffB); PG8_STAGEA(PG8_SA(1, 0), cA + kstep, oC00, oC01); PG8_STAGE(PG8_SB(1, 1), cB + bstep + kstep, voffB);
    PG8_WAIT_V(6); PG8_BAR;
    for (;;) {
        const bool has_next = S.next(ui + 1, nxt);
        const char* nA = has_next ? (const char*)g.A + (GATHER ? (size_t)0 : (size_t)nxt.pm * tstep) + S.koff(nxt) * 2 : cA; const char* nB = has_next ? (const char*)g.Bt + (size_t)nxt.pb * tstep + S.koff(nxt) * 2 : cB;
        if (has_next) PG8_ROWDMA(nxt, rsl == 2 ? 0 : rsl + 1);
        if constexpr (GATHER) {
            if (has_next) { const int* p0 = S.gather_ptr(nxt, sR[0]); const int* p1 = S.gather_ptr(nxt, sR[1]); const int* p2 = S.gather_ptr(nxt, 128 + sR[0]); const int* p3 = S.gather_ptr(nxt, 128 + sR[1]);
                asm volatile("global_load_dword %0, %4, off\n\tglobal_load_dword %1, %5, off\n\tglobal_load_dword %2, %6, off\n\tglobal_load_dword %3, %7, off"
                             : "=&v"(tkN0), "=&v"(tkN1), "=&v"(tkN2), "=&v"(tkN3) : "v"(p0), "v"(p1), "v"(p2), "v"(p3) : "memory"); gnext = true;
            } else gnext = false;
        }
        for (int t = 0; t < nt; t += 2) {
            const bool last = (t == nt - 2);
            const char* a1 = cA + (size_t)(t + 1) * kstep;
            const char* a2 = last ? nA : cA + (size_t)(t + 2) * kstep; const char* b2 = last ? nB : cB + (size_t)(t + 2) * kstep;
            const char* a3 = a2 + kstep; const char* b3 = b2 + kstep;
            unsigned o00 = oC00, o01 = oC01, o10 = oC10, o11 = oC11;
            if constexpr (GATHER) { if (last) { asm volatile("" : "+v"(tkN0), "+v"(tkN1), "+v"(tkN2), "+v"(tkN3));
                if (gnext) { oN00 = (unsigned)(tkN0 * K + sC[0]) * 2u; oN01 = (unsigned)(tkN1 * K + sC[1]) * 2u; oN10 = (unsigned)(tkN2 * K + sC[0]) * 2u; oN11 = (unsigned)(tkN3 * K + sC[1]) * 2u; }
                else { oN00 = oC00; oN01 = oC01; oN10 = oC10; oN11 = oC11; }
                o00 = oN00; o01 = oN01; o10 = oN10; o11 = oN11; } }
            PG8_LDB(B0, 0, 0); PG8_LDB(B1, 0, 1); PG8_SCHED; PG8_LDA(At, 0, 0); PG8_STAGEA(PG8_SA(1, 1), a1, oC10, oC11);
            PG8_WAIT_V(8); PG8_WAIT_L(0); PG8_BAR; PG8_MMA(0, 0, At, B0); PG8_MMA(0, 1, At, B1); PG8_BAR; PG8_SCHED;
            PG8_LDA(At, 0, 1); PG8_STAGE(PG8_SB(0, 0), b2, voffB); PG8_STAGE(PG8_SB(0, 1), b2 + bstep, voffB); PG8_STAGEA(PG8_SA(0, 0), a2, o00, o01);
            PG8_WAIT_V(8); PG8_WAIT_L(0); PG8_BAR; PG8_MMA(1, 0, At, B0); PG8_MMA(1, 1, At, B1); PG8_BAR; PG8_SCHED;
            PG8_LDB(B0, 1, 0); PG8_LDB(B1, 1, 1); PG8_SCHED; PG8_LDA(At, 1, 0); PG8_STAGEA(PG8_SA(0, 1), a2, o10, o11);
            PG8_WAIT_V(8); PG8_WAIT_L(0); PG8_BAR; PG8_MMA(0, 0, At, B0); PG8_MMA(0, 1, At, B1); PG8_BAR; PG8_SCHED;
            if constexpr (SPLIT_NST > 0) { if (last) { if constexpr (FP8) asm volatile("s_nop 15\n\ts_nop 15" ::: "memory"); PG8_EPI(0, 1); PG8_SCHED; } }
            PG8_LDA(At, 1, 1); PG8_STAGE(PG8_SB(1, 0), b3, voffB); PG8_STAGE(PG8_SB(1, 1), b3 + bstep, voffB); PG8_STAGEA(PG8_SA(1, 0), a3, o00, o01);
            if constexpr (SPLIT_NST == 8) { if (last) PG8_WAIT_V(16); else PG8_WAIT_V(8); }
            else if constexpr (SPLIT_NST == 4) { if (last) PG8_WAIT_V(12); else PG8_WAIT_V(8); }
            else PG8_WAIT_V(8);
            PG8_WAIT_L(0); PG8_BAR; PG8_MMA(1, 0, At, B0); PG8_MMA(1, 1, At, B1); PG8_BAR; PG8_SCHED;
        }
        if constexpr (ALIGN_EPI) { if (wr == 0) PG8_BAR; }
        if constexpr (FP8) asm volatile("s_nop 15\n\ts_nop 15" ::: "memory");
        PG8_EPI(SPLIT_NST > 0 ? 1 : 0, 2);
        if constexpr (ROWS) rsl = rsl == 2 ? 0 : rsl + 1;
        if (!has_next) break;
#pragma unroll
        for (int a = 0; a < 2; ++a)
#pragma unroll
            for (int b = 0; b < 2; ++b)
#pragma unroll
                for (int m = 0; m < 4; ++m)
#pragma unroll
                    for (int n = 0; n < 2; ++n) acc[a][b][m][n] = (f32x4){0.f, 0.f, 0.f, 0.f};
        cur = nxt; cA = nA; cB = nB; ++ui;
        oC00 = oN00; oC01 = oN01; oC10 = oN10; oC11 = oN11;
        if constexpr (ALIGN_EPI) { if (wr == 1) PG8_BAR; }
    }
    PG8_WAIT_V(0);
    if constexpr (!ALIGN_EPI) { if (wr == 0) PG8_BAR; }
    PG8_BAR;
#undef PG8_ROWDMA
#undef PG8_EPI
#undef PG8_SA
#undef PG8_SB
#undef PG8_STAGE
#undef PG8_STAGEA
#undef PG8_LDA
#undef PG8_LDB
#undef PG8_MMA
#undef PG8_CAT
#undef PG8_WAIT_V
#undef PG8_WAIT_L
#undef PG8_BAR
#undef PG8_SCHED
}
}
namespace attn_body {
using bf16=__hip_bfloat16;
using bf16x8=__attribute__((ext_vector_type(8)))short;
using s16x4=__attribute__((ext_vector_type(4)))short;
using f32x16=__attribute__((ext_vector_type(16)))float;
using u32x4=__attribute__((ext_vector_type(4)))unsigned;
constexpr int BATCH=2,NHEAD=16,SEQ=8192,D=64,DM=NHEAD*D;
constexpr int NW=8,QBLK=32,QB=QBLK*NW,KVBLK=64,NQB=SEQ/QB;
constexpr int ATTN_PITCH=DM, ATTN_UNIT_ROWS=QB;
__device__ __forceinline__ int crow(int r,int hi){return (r&3)+8*(r>>2)+4*hi;}
#define SBAR() __builtin_amdgcn_sched_barrier(0)
__device__ __forceinline__ void cmask(f32x16&p0,f32x16&p1,int jb,int qrel,int hi){
  const float NEG=-INFINITY; int kb=64*jb+4*hi;
  #pragma unroll
  for(int r=0;r<16;++r){int kv=kb+(r&3)+8*(r>>2); if(kv>qrel)p0[r]=NEG; if(kv+32>qrel)p1[r]=NEG;}
}

constexpr int NSLOT=3, SLOTB=8192;
constexpr int LDS_K=0, LDS_V=NSLOT*SLOTB, LDS_WS=3*NSLOT*SLOTB, LDS_OST=LDS_WS+NW*64*4, LDS_BYTES=LDS_OST+NW*4096;
constexpr float C2=0.125f*1.4426950408889634f;
__device__ __forceinline__ void glds16(const void*gsrc,unsigned lds_dst){unsigned keep;
  asm volatile("s_mov_b32 %0, m0\n\ts_mov_b32 m0, %2\n\ts_nop 0\n\tglobal_load_lds_dwordx4 %1, off\n\ts_mov_b32 m0, %0":"=&s"(keep):"v"(gsrc),"s"(lds_dst):"memory");}
__device__ __forceinline__ float max3f(float a,float b,float c){float r;asm("v_max3_f32 %0, %1, %2, %3":"=v"(r):"v"(a),"v"(b),"v"(c));return r;}
__device__ __forceinline__ float max2f(float a,float b){float r;asm("v_max_f32_e32 %0, %1, %2":"=v"(r):"v"(a),"v"(b));return r;}
__device__ __forceinline__ float fadd_s(float a,float b){float r;asm("v_add_f32_e32 %0, %1, %2":"=v"(r):"v"(a),"v"(b));return r;}
__device__ __forceinline__ float fsub_s(float a,float b){float r;asm("v_sub_f32_e32 %0, %1, %2":"=v"(r):"v"(a),"v"(b));return r;}
typedef float f32x2_t __attribute__((ext_vector_type(2))); typedef __bf16 bf16x2_t __attribute__((ext_vector_type(2)));
__device__ __forceinline__ unsigned cvtpk_s(float lo,float hi){f32x2_t v={lo,hi};bf16x2_t b=__builtin_convertvector(v,bf16x2_t);return __builtin_bit_cast(unsigned,b);}
#define WAIT_BAR(N) asm volatile("s_waitcnt vmcnt(" #N ") lgkmcnt(0)\n\ts_barrier":::"memory")

__device__ __forceinline__ void qkt(f32x16&p0,f32x16&p1,const char*Kslot,const bf16x8*qr,const f32x16&negm,int r32,int hi){
  const char*kb=Kslot+hi*1024+r32*16;
  #pragma unroll
  for(int d0=0;d0<4;++d0){
    const bf16x8 b0=*reinterpret_cast<const bf16x8*>(kb+d0*2048);
    const bf16x8 b1=*reinterpret_cast<const bf16x8*>(kb+d0*2048+512);
    if(d0==0){p0=__builtin_amdgcn_mfma_f32_32x32x16_bf16(b0,qr[0],negm,0,0,0);p1=__builtin_amdgcn_mfma_f32_32x32x16_bf16(b1,qr[0],negm,0,0,0);}
    else{p0=__builtin_amdgcn_mfma_f32_32x32x16_bf16(b0,qr[d0],p0,0,0,0);p1=__builtin_amdgcn_mfma_f32_32x32x16_bf16(b1,qr[d0],p1,0,0,0);}}
}
typedef __attribute__((address_space(3))) const char* lds_cptr;
typedef short v4i16_t __attribute__((ext_vector_type(4)));
__device__ __forceinline__ void kload8(bf16x8*kf,lds_cptr kp){
  kf[0]=*(const __attribute__((address_space(3))) bf16x8*)(kp);      kf[1]=*(const __attribute__((address_space(3))) bf16x8*)(kp+512);
  kf[2]=*(const __attribute__((address_space(3))) bf16x8*)(kp+2048); kf[3]=*(const __attribute__((address_space(3))) bf16x8*)(kp+2560);
  kf[4]=*(const __attribute__((address_space(3))) bf16x8*)(kp+4096); kf[5]=*(const __attribute__((address_space(3))) bf16x8*)(kp+4608);
  kf[6]=*(const __attribute__((address_space(3))) bf16x8*)(kp+6144); kf[7]=*(const __attribute__((address_space(3))) bf16x8*)(kp+6656);
}
__device__ __forceinline__ void kload2(bf16x8*kf,lds_cptr kp,int j){ kf[2*j]=*(const __attribute__((address_space(3))) bf16x8*)(kp+j*2048); kf[2*j+1]=*(const __attribute__((address_space(3))) bf16x8*)(kp+j*2048+512); }
__device__ __forceinline__ s16x4 vtr(lds_cptr p){ return __builtin_bit_cast(s16x4,__builtin_amdgcn_ds_read_tr16_b64_v4i16((__attribute__((address_space(3))) v4i16_t*)p)); }
__device__ __forceinline__ float rowmax(const f32x16&p0,const f32x16&p1){
  float a=max3f(p0[0],p0[1],p1[0]),b=max3f(p0[2],p0[3],p1[1]);a=max3f(a,p1[2],p1[3]);
  #pragma unroll
  for(int r=4;r<16;r+=4){a=max3f(a,p0[r],p0[r+1]);b=max3f(b,p0[r+2],p0[r+3]);a=max3f(a,p1[r],p1[r+1]);b=max3f(b,p1[r+2],p1[r+3]);}
  const float m=max2f(a,b);
  auto rr=__builtin_amdgcn_permlane32_swap(__float_as_uint(m),__float_as_uint(m),false,false);
  return max2f(__uint_as_float(rr[0]),__uint_as_float(rr[1]));
}
__device__ __forceinline__ void pv(f32x16*o,int vb,bf16x8 pa0,bf16x8 pa1,bf16x8 pa2,bf16x8 pa3){
  #pragma unroll
  for(int d0=0;d0<4;++d0){s16x4 lo[4],hi[4];
    #pragma unroll
    for(int ks=0;ks<4;++ks){
      asm volatile("ds_read_b64_tr_b16 %0,%1 offset:%c2":"=&v"(lo[ks]):"v"(vb),"i"(d0*4096+ks*1024):"memory");
      asm volatile("ds_read_b64_tr_b16 %0,%1 offset:%c2":"=&v"(hi[ks]):"v"(vb),"i"(d0*4096+ks*1024+512):"memory");}
    asm volatile("s_waitcnt lgkmcnt(0)":::"memory");SBAR();
    #define PK(k) (bf16x8){lo[k][0],lo[k][1],lo[k][2],lo[k][3],hi[k][0],hi[k][1],hi[k][2],hi[k][3]}
    o[d0]=__builtin_amdgcn_mfma_f32_32x32x16_bf16(pa0,PK(0),o[d0],0,0,0);
    o[d0]=__builtin_amdgcn_mfma_f32_32x32x16_bf16(pa1,PK(1),o[d0],0,0,0);
    o[d0]=__builtin_amdgcn_mfma_f32_32x32x16_bf16(pa2,PK(2),o[d0],0,0,0);
    o[d0]=__builtin_amdgcn_mfma_f32_32x32x16_bf16(pa3,PK(3),o[d0],0,0,0);
    #undef PK
  }
}

#ifndef ATTN_STORE16
#define ATTN_STORE16(p,v) (*(u32x4*)(p)=(v))
#endif
template<int THRL> __device__ __forceinline__ void attn_unit(int b,int hq,int hv,int qb,const bf16*Q,const bf16*__restrict__ K,const bf16*__restrict__ V,bf16*O,char*shm){
  const int tid=threadIdx.x,lane=tid&63,r32=lane&31,hi=lane>>5; const int wid=__builtin_amdgcn_readfirstlane(tid>>6);
  const long rowbase=(long)b*SEQ; const int q0=qb*QB;
  const bf16*Qw=Q+(rowbase+q0+wid*QBLK)*DM+hq*D;
  const bf16*Kh=K+rowbase*DM+hq*D,*Vh=V+rowbase*DM+hv*D;
  const unsigned lds0=(unsigned)(uintptr_t)shm;
  float*wsf=(float*)(shm+LDS_WS)+wid*64;
  const bf16*ksrc=Kh+(long)lane*DM+wid*8;
  const bf16*vsrc=Vh+(long)(16*(wid&3)+(lane>>2))*DM+(wid>>2)*32+(lane&3)*8;
  const unsigned kdst=lds0+LDS_K+wid*1024, vdst=lds0+LDS_V+wid*1024;
  #define DMA_K(t,slot) glds16(ksrc+(long)(t)*KVBLK*DM,(unsigned)__builtin_amdgcn_readfirstlane(kdst+(slot)))
  #define DMA_V(t,slot) do{ glds16(vsrc+(long)(t)*KVBLK*DM,(unsigned)__builtin_amdgcn_readfirstlane(vdst+2*(slot))); glds16(vsrc+64+(long)(t)*KVBLK*DM,(unsigned)__builtin_amdgcn_readfirstlane(vdst+8192+2*(slot))); }while(0)
  const int vb0=(int)(lds0+LDS_V)+((lane>>4)&1)*32+(lane&3)*8+(4*hi+((lane&15)>>2))*64;
  const char*Kbase=shm+LDS_K; bf16x8 kf[8];
  const lds_cptr shm3=(lds_cptr)shm; const lds_cptr kp0=shm3+LDS_K+hi*1024+r32*16; const lds_cptr vp0=shm3+LDS_V+((lane>>4)&1)*32+(lane&3)*8+(4*hi+((lane&15)>>2))*64;
  if(__builtin_amdgcn_readfirstlane(wid)>=4)__builtin_amdgcn_s_setprio(1);
  const int NT=(q0+QB)/KVBLK;
  DMA_K(0,0);DMA_V(0,0);DMA_K(1,SLOTB);
  bf16x8 qr[4];
  #pragma unroll
  for(int d0=0;d0<4;++d0)qr[d0]=*reinterpret_cast<const bf16x8*>(&Qw[(long)r32*DM+d0*16+hi*8]);
  typedef __attribute__((address_space(3))) bf16x8 lds_bf16x8;
  { __attribute__((address_space(3))) char* qst=(__attribute__((address_space(3))) char*)shm+LDS_OST+wid*4096+lane*16;
    #pragma unroll
    for(int d0=0;d0<4;++d0)*(lds_bf16x8*)(qst+d0*1024)=qr[d0]; }
  const lds_cptr qp0=(lds_cptr)shm+LDS_OST+wid*4096+lane*16;
  #define QL(d) (*(const lds_bf16x8*)(qp0+(d)*1024))
  float mhat=0.f,l_reg=0.f;f32x16 o[4];o[0]=f32x16{};o[1]=f32x16{};o[2]=f32x16{};o[3]=f32x16{};f32x16 negm=f32x16{};asm volatile("":"+v"(negm));
  const int qrel=wid*QBLK+r32;
  #define CMASK(P0,P1,t) do{int jb_=(t)-(NT-4); if(jb_>=0)cmask(P0,P1,jb_,qrel,hi);}while(0)
  bool resc=false;
  #define START(P0,P1) do{ const float rm=rowmax(P0,P1); resc=false; \
    { const float dl=rm; mhat=fadd_s(mhat,dl); \
      _Pragma("unroll") for(int r=0;r<16;++r){P0[r]=fsub_s(P0[r],dl);P1[r]=fsub_s(P1[r],dl);} \
      _Pragma("unroll") for(int r=0;r<16;++r)negm[r]=-mhat; asm volatile("":"+v"(negm)); } \
    _Pragma("unroll") for(int r=0;r<16;++r)P0[r]=__builtin_amdgcn_exp2f(P0[r]); }while(0)
  #define RESC() do{ if(resc){ asm volatile("s_waitcnt lgkmcnt(0)":::"memory"); \
      _Pragma("unroll") for(int d_=0;d_<4;++d_) _Pragma("unroll") for(int r=0;r<16;++r)o[d_][r]*=wsf[crow(r,hi)]; } }while(0)
  f32x16 pA0,pA1,pB0,pB1;
  int sl_prev=0,sl_cur=0,sl_next=SLOTB;
  #define ROT() do{sl_prev=sl_cur;sl_cur=sl_next;sl_next=(sl_next==(NSLOT-1)*SLOTB)?0:sl_next+SLOTB;}while(0)
  DMA_K(2,2*SLOTB);
  WAIT_BAR(3);
  qkt(pA0,pA1,Kbase,qr,negm,r32,hi);asm volatile("s_nop 15\n\ts_nop 7":"+v"(pA0),"+v"(pA1));CMASK(pA0,pA1,0);
  START(pA0,pA1);
  _Pragma("unroll") for(int r=0;r<16;++r)pA1[r]=__builtin_amdgcn_exp2f(pA1[r]);
  WAIT_BAR(0);
  DMA_K(3,0);DMA_V(1,SLOTB);
  ROT();
  kload8(kf,kp0+sl_cur);
  WAIT_BAR(3);
  s16x4 fAlo,fAhi,fBlo,fBhi,fClo,fChi; u32x4 pw0,pw1,pw2,pw3;
  #define PKW(P,B) cvtpk_s(P[B],P[B+1])
  #define PAF(k) __builtin_bit_cast(bf16x8,pw##k)
  #define PIN(x) asm volatile("":"+v"(x))
  #define MX3(a,b,c) __builtin_fmaxf(__builtin_fmaxf((a),(b)),(c))
  #define GAPA(MF,A0,A1,A2,A3,W0,W1,PW) do{ MF; sacc+=A0; sacc+=A1; sacc+=A2; sacc+=A3; PIN(sacc); W0; W1; PIN(PW); SBAR(); }while(0)
  #define EX(v) __builtin_amdgcn_exp2f(v)
  #define GAPB(MF,X,B) do{ MF; X[B]=EX(X[B]); X[B+1]=EX(X[B+1]); PIN(X); SBAR(); }while(0)
  #define VRDF(F,n) do{ F##lo=vtr(vp_+(((n)&3)*4096+((n)>>2)*1024)); F##hi=vtr(vp_+(((n)&3)*4096+((n)>>2)*1024+512)); }while(0)
  #define VFRF(F) (bf16x8){F##lo[0],F##lo[1],F##lo[2],F##lo[3],F##hi[0],F##hi[1],F##hi[2],F##hi[3]}
  #define KRD(G,j) do{ if(G){ kload2(kf,kp0+sl_next,j); SBAR(); } }while(0)
  #define STEP(C0,C1,P0,P1,t,GK,GV,GL) do{ SBAR(); \
    const lds_cptr vp_=vp0+2*sl_prev; \
    const bf16x8 q0_=QL(0),q1_=QL(1),q2_=QL(2),q3_=QL(3); SBAR(); float sacc=(P0[0]+P0[1]); \
    GAPA(C0=__builtin_amdgcn_mfma_f32_32x32x16_bf16(kf[0],q0_,negm,0,0,0), P0[2],P0[3],P0[4],P0[5],     pw0[0]=PKW(P0,0), pw0[1]=PKW(P0,2), pw0); \
    GAPA(C1=__builtin_amdgcn_mfma_f32_32x32x16_bf16(kf[1],q0_,negm,0,0,0), P0[6],P0[7],P0[8],P0[9],     pw0[2]=PKW(P0,4), pw0[3]=PKW(P0,6), pw0); \
    GAPA(C0=__builtin_amdgcn_mfma_f32_32x32x16_bf16(kf[2],q1_,C0,0,0,0),   P0[10],P0[11],P0[12],P0[13], pw1[0]=PKW(P0,8), pw1[1]=PKW(P0,10), pw1); \
    GAPA(C1=__builtin_amdgcn_mfma_f32_32x32x16_bf16(kf[3],q1_,C1,0,0,0),   P0[14],P0[15],P1[0],P1[1],   pw1[2]=PKW(P0,12),pw1[3]=PKW(P0,14), pw1); \
    GAPA(C0=__builtin_amdgcn_mfma_f32_32x32x16_bf16(kf[4],q2_,C0,0,0,0),   P1[2],P1[3],P1[4],P1[5],     pw2[0]=PKW(P1,0), pw2[1]=PKW(P1,2), pw2); \
    GAPA(C1=__builtin_amdgcn_mfma_f32_32x32x16_bf16(kf[5],q2_,C1,0,0,0),   P1[6],P1[7],P1[8],P1[9],     pw2[2]=PKW(P1,4), pw2[3]=PKW(P1,6), pw2); \
    VRDF(fA,0); SBAR(); GAPA(C0=__builtin_amdgcn_mfma_f32_32x32x16_bf16(kf[6],q3_,C0,0,0,0),   P1[10],P1[11],P1[12],P1[13], pw3[0]=PKW(P1,8), pw3[1]=PKW(P1,10), pw3); \
    VRDF(fB,1); SBAR(); GAPA(C1=__builtin_amdgcn_mfma_f32_32x32x16_bf16(kf[7],q3_,C1,0,0,0),   P1[14],P1[15],0.f,0.f,       pw3[2]=PKW(P1,12),pw3[3]=PKW(P1,14), pw3); \
    l_reg+=sacc; \
    if(GK){DMA_K((t)+3,sl_cur);} if(GV){DMA_V((t)+1,sl_next);} \
    CMASK(C0,C1,t); \
    { float a=MX3(C0[0],C0[1],C1[0]),b=MX3(C0[2],C0[3],C1[1]); a=MX3(a,C1[2],C1[3]); \
      _Pragma("unroll") for(int r=4;r<16;r+=4){a=MX3(a,C0[r],C0[r+1]);b=MX3(b,C0[r+2],C0[r+3]);a=MX3(a,C1[r],C1[r+1]);b=MX3(b,C1[r+2],C1[r+3]);} \
      float rm=__builtin_fmaxf(a,b); { auto rr=__builtin_amdgcn_permlane32_swap(__float_as_uint(rm),__float_as_uint(rm),false,false); rm=__builtin_fmaxf(__uint_as_float(rr[0]),__uint_as_float(rr[1])); } \
      resc=false; \
      if(__builtin_expect(__any(rm>(float)THRL),0)){ const float dl=__builtin_fmaxf(rm,0.f); mhat+=dl; \
        _Pragma("unroll") for(int r=0;r<16;++r){C0[r]-=dl;C1[r]-=dl;} \
        _Pragma("unroll") for(int r=0;r<16;++r)negm[r]=-mhat; asm volatile("":"+v"(negm)); \
        const float f=__builtin_amdgcn_exp2f(-dl); l_reg*=f; if(hi==0)wsf[r32]=f; resc=true; } } \
    SBAR(); \
    VRDF(fC,2);  SBAR(); GAPB(o[0]=__builtin_amdgcn_mfma_f32_32x32x16_bf16(PAF(0),VFRF(fA),o[0],0,0,0), C0,0); \
    VRDF(fA,3);  SBAR(); GAPB(o[1]=__builtin_amdgcn_mfma_f32_32x32x16_bf16(PAF(0),VFRF(fB),o[1],0,0,0), C0,2); \
    VRDF(fB,4);  SBAR(); GAPB(o[2]=__builtin_amdgcn_mfma_f32_32x32x16_bf16(PAF(0),VFRF(fC),o[2],0,0,0), C0,4); \
    VRDF(fC,5);  SBAR(); GAPB(o[3]=__builtin_amdgcn_mfma_f32_32x32x16_bf16(PAF(0),VFRF(fA),o[3],0,0,0), C0,6); \
    VRDF(fA,6);  SBAR(); KRD(GL,0); GAPB(o[0]=__builtin_amdgcn_mfma_f32_32x32x16_bf16(PAF(1),VFRF(fB),o[0],0,0,0), C0,8); \
    VRDF(fB,7);  SBAR(); KRD(GL,1); GAPB(o[1]=__builtin_amdgcn_mfma_f32_32x32x16_bf16(PAF(1),VFRF(fC),o[1],0,0,0), C0,10); \
    VRDF(fC,8);  SBAR(); KRD(GL,2); GAPB(o[2]=__builtin_amdgcn_mfma_f32_32x32x16_bf16(PAF(1),VFRF(fA),o[2],0,0,0), C0,12); \
    VRDF(fA,9);  SBAR(); KRD(GL,3); GAPB(o[3]=__builtin_amdgcn_mfma_f32_32x32x16_bf16(PAF(1),VFRF(fB),o[3],0,0,0), C0,14); \
    VRDF(fB,10); SBAR(); GAPB(o[0]=__builtin_amdgcn_mfma_f32_32x32x16_bf16(PAF(2),VFRF(fC),o[0],0,0,0), C1,0); \
    VRDF(fC,11); SBAR(); GAPB(o[1]=__builtin_amdgcn_mfma_f32_32x32x16_bf16(PAF(2),VFRF(fA),o[1],0,0,0), C1,2); \
    VRDF(fA,12); SBAR(); GAPB(o[2]=__builtin_amdgcn_mfma_f32_32x32x16_bf16(PAF(2),VFRF(fB),o[2],0,0,0), C1,4); \
    VRDF(fB,13); SBAR(); GAPB(o[3]=__builtin_amdgcn_mfma_f32_32x32x16_bf16(PAF(2),VFRF(fC),o[3],0,0,0), C1,6); \
    VRDF(fC,14); SBAR(); GAPB(o[0]=__builtin_amdgcn_mfma_f32_32x32x16_bf16(PAF(3),VFRF(fA),o[0],0,0,0), C1,8); \
    VRDF(fA,15); SBAR(); GAPB(o[1]=__builtin_amdgcn_mfma_f32_32x32x16_bf16(PAF(3),VFRF(fB),o[1],0,0,0), C1,10); \
    GAPB(o[2]=__builtin_amdgcn_mfma_f32_32x32x16_bf16(PAF(3),VFRF(fC),o[2],0,0,0), C1,12); \
    GAPB(o[3]=__builtin_amdgcn_mfma_f32_32x32x16_bf16(PAF(3),VFRF(fA),o[3],0,0,0), C1,14); \
    }while(0)
  int t=1;
  #undef CMASK
  #define CMASK(P0,P1,t) do{}while(0)
  for(;t+5<NT;t+=2){
    STEP(pB0,pB1,pA0,pA1,t,true,true,true);     WAIT_BAR(3); RESC(); ROT();
    STEP(pA0,pA1,pB0,pB1,t+1,true,true,true);   WAIT_BAR(3); RESC(); ROT();
  }
  #undef CMASK
  #define CMASK(P0,P1,t) do{int jb_=(t)-(NT-4); if(jb_>=0)cmask(P0,P1,jb_,qrel,hi);}while(0)
  #define ENDW(tt) do{ if((tt)+3<NT){WAIT_BAR(3);} else if((tt)+2<NT){WAIT_BAR(2);} else {WAIT_BAR(0);} }while(0)
  for(;t+1<NT;t+=2){
    STEP(pB0,pB1,pA0,pA1,t,(t+3<NT),(t+1<NT),(t+1<NT));       ENDW(t);   RESC(); ROT();
    STEP(pA0,pA1,pB0,pB1,t+1,(t+4<NT),(t+2<NT),(t+2<NT));     ENDW(t+1); RESC(); ROT();
  }
  STEP(pB0,pB1,pA0,pA1,NT-1,false,false,false); RESC();
  { float sacc=pB0[0]+pB0[1]; _Pragma("unroll") for(int r=2;r<16;++r)sacc+=pB0[r]; _Pragma("unroll") for(int r=0;r<16;++r)sacc+=pB1[r]; l_reg+=sacc;
    pw0=(u32x4){PKW(pB0,0),PKW(pB0,2),PKW(pB0,4),PKW(pB0,6)};pw1=(u32x4){PKW(pB0,8),PKW(pB0,10),PKW(pB0,12),PKW(pB0,14)};pw2=(u32x4){PKW(pB1,0),PKW(pB1,2),PKW(pB1,4),PKW(pB1,6)};pw3=(u32x4){PKW(pB1,8),PKW(pB1,10),PKW(pB1,12),PKW(pB1,14)};
    SBAR(); pv(o,vb0+2*sl_cur,PAF(0),PAF(1),PAF(2),PAF(3)); }
  #undef PKW
  #undef PAF
  #undef VFRF
  #undef VRDF
  #undef PIN
  #undef MX3
  #undef GAPA
  #undef GAPB
  #undef EX
  #undef KRD
  #undef STEP
  #undef ENDW
  {auto rr=__builtin_amdgcn_permlane32_swap(__float_as_uint(l_reg),__float_as_uint(l_reg),false,false);l_reg=__uint_as_float(rr[0])+__uint_as_float(rr[1]);}
  if(hi==0)wsf[32+r32]=l_reg;asm volatile("s_waitcnt lgkmcnt(0)":::"memory");
  float rli[16];
  #pragma unroll
  for(int r=0;r<16;++r)rli[r]=__builtin_amdgcn_rcpf(wsf[32+crow(r,hi)]);
  bf16*Ow=O+(rowbase+q0+wid*QBLK)*DM+hv*D;
  { bf16*stg=(bf16*)(shm+LDS_OST)+wid*2048;
    #pragma unroll
    for(int pass=0;pass<2;++pass){
      #pragma unroll
      for(int r=0;r<16;++r){const int orow=crow(r,hi);
        #pragma unroll
        for(int d0=0;d0<2;++d0)stg[orow*64+d0*32+r32]=__float2bfloat16(o[2*pass+d0][r]*rli[r]);}
      asm volatile("s_waitcnt lgkmcnt(0)":::"memory");
      #pragma unroll
      for(int i=0;i<4;++i){const int row=i*8+(lane>>3),ch=lane&7; const u32x4 v=*(const u32x4*)(stg+row*64+ch*8); ATTN_STORE16(Ow+(long)row*DM+pass*64+ch*8,v);}
      asm volatile("s_waitcnt lgkmcnt(0)":::"memory"); } }
  __builtin_amdgcn_s_setprio(0);
  asm volatile("s_waitcnt lgkmcnt(0)\n\ts_barrier":::"memory");
  #undef DMA_K
  #undef DMA_V
  #undef CMASK
  #undef START
  #undef RESC
  #undef ROT
  #undef QL
}
constexpr int ATTN_LDS_BYTES=LDS_BYTES;
struct AttnTensors { const bf16* Q; const bf16* K; const bf16* V; bf16* O; };
struct AttnUnit { int bh; int qb; };
struct StaticOrder {
  int vcu;
  __device__ __forceinline__ explicit StaticOrder(int grid,int block):vcu((block%8)*(grid/8)+block/8){}
  __device__ __forceinline__ bool next(int i,AttnUnit&u)const{ if(i>=4)return false; const int s=vcu&7; u.bh=vcu>>3; u.qb=(i==0)?s:(i==1)?15-s:(i==2)?16+s:31-s; return true; }
  __device__ __forceinline__ void a_ready(const AttnUnit&)const{}
  __device__ __forceinline__ void done(const AttnUnit&)const{}
};
template<class Sched,int THRL=8> __device__ __forceinline__ void attn_phase(char*lds,const AttnTensors&T,const Sched&S){
  AttnUnit u;
  for(int i=0;S.next(i,u);++i){ S.a_ready(u); const int hq=u.bh&15, cm=hq&1; attn_unit<THRL>(u.bh>>4,hq,hq&~1,u.qb,T.Q,T.K,T.V,T.O+(size_t)cm*((size_t)16384*1024),lds); S.done(u); }
}
#undef SBAR
#undef WAIT_BAR
}
constexpr int NWAVES = 8, NTHR = 512;
constexpr int BATCH = 2, T = 8192, D = 1024, M = BATCH * T;
constexpr int EIN = 2816, FFN = 2816, NE = 8, ED = 3584;
constexpr int NPH = 23;
constexpr float MOE_WG_SCALE = 64.f, MOE_WD_SCALE = 128.f, MOE_H_SCALE = 8.f;
constexpr int MOE_GU_E8M0 = 0x79797979, MOE_DN_E8M0 = 0x75757575;
#ifndef LAST_PHASE
#define LAST_PHASE (NPH - 1)
#endif
#ifndef ONE_LAUNCH
#define ONE_LAUNCH 0
#endif

constexpr size_t KiB = 1024, MiB = 1u << 20;
constexpr size_t WS_CTL = 0, CTL_ZERO_BYTES = 192 * KiB;
constexpr size_t WS_WIN = 1 * MiB, WS_WOUT = WS_WIN + 5632 * KiB, WS_WGU = WS_WOUT + 2 * MiB, WS_WDN = WS_WGU + 11 * MiB, WS_WQKV = WS_WDN + 5632 * KiB, WS_WO = WS_WQKV + 6 * MiB;
static_assert(WS_WO + 2 * MiB == 33 * MiB, "weights map");
constexpr size_t WS_B2T = 33 * MiB, WS_BLRU = 34 * MiB;
constexpr size_t WS_XN = 35 * MiB;
constexpr size_t WS_LA = 35 * MiB, WS_LU = 51 * MiB;
constexpr size_t WS_PROJ = 67 * MiB;
constexpr size_t WS_Q = 67 * MiB, WS_K = 99 * MiB, WS_V = 131 * MiB;
constexpr size_t WS_XC = 155 * MiB;
constexpr size_t WS_SINIT = 155 * MiB;
constexpr size_t WS_A2 = 171 * MiB;
constexpr size_t WS_G1 = 179 * MiB;
constexpr size_t WS_G2 = 227 * MiB;
constexpr size_t WS_PL = 227 * MiB, WS_ORAW = 227 * MiB;
constexpr size_t WS_OA0 = 163 * MiB, WS_OA1 = 195 * MiB, WS_AO = 227 * MiB;
constexpr size_t WS_REC4 = 259 * MiB;
constexpr size_t WS_Y = 259 * MiB;
constexpr size_t WS_REC2 = 387 * MiB;
constexpr size_t WS_SMALL = 451 * MiB;
constexpr size_t WS_BS = WS_SMALL, WS_LSA = WS_SMALL + 1 * MiB, WS_LSH = WS_SMALL + 3 * MiB, WS_LC = WS_SMALL + 5 * MiB;
constexpr size_t WS_LIST = WS_SMALL, WS_TOKI = WS_SMALL + 512 * KiB, WS_TOKG = WS_SMALL + 1024 * KiB;
constexpr size_t WS_WGUM = 291 * MiB, WS_WDM = 347 * MiB;
constexpr size_t WS_XNM = 1 * MiB;
constexpr size_t WS_HM2 = 33 * MiB;
constexpr size_t WS_Y2 = 271 * MiB;
constexpr size_t WS_PART = 155 * MiB;
constexpr size_t WS_XR = WS_REC2;
constexpr size_t WS_RS1 = 65536, WS_RS2 = 131072;
constexpr size_t WS_END = 458 * MiB;
static_assert(WS_HM2 + (size_t)34816 * 3584 * 2 <= WS_WGUM && WS_WDM + (size_t)8 * 1024 * 3584 * 2 <= WS_SMALL && WS_Y2 + (size_t)34816 * 1024 * 2 <= WS_WDM, "MoE map");
constexpr int CW_BAR = 4096, CW_CNT = 8192, CW_SPL = 12288;
constexpr int RING_BYTES = 131072, MISC_OFF = RING_BYTES + 320, LDS_BYTES = 147456;

#define XB_TMO      128
#define XB_XCNT(j)  (256  + 64 * (j))
#define XB_XSUB(j)  (1280 + 64 * (j))
#define XB_XGEN(j)  (2304 + 64 * (j))
#define XB_TOP      3328
#define XB_TOPGEN   3392
#define XCD_BAR_WORDS 3456
#define XB_SPIN_CAP (1u << 18)
__device__ __forceinline__ unsigned xb_ld(unsigned* p)              { return __hip_atomic_load(p, __ATOMIC_RELAXED, __HIP_MEMORY_SCOPE_AGENT); }
__device__ __forceinline__ unsigned xb_add(unsigned* p, unsigned v) { return __hip_atomic_fetch_add(p, v, __ATOMIC_RELAXED, __HIP_MEMORY_SCOPE_AGENT); }
__device__ __forceinline__ unsigned xb_xcc_id() { return (unsigned)__builtin_amdgcn_s_getreg((3 << 11) | 20) & 0xFu; }
#define XB_SPIN(cond, bar) do { unsigned _sp = 0; while (cond) { __builtin_amdgcn_s_sleep(1); \
    if ((++_sp & 255u) == 0u) { if (xb_ld(&(bar)[XB_TMO])) break; if (_sp > XB_SPIN_CAP) { atomicAdd(&(bar)[XB_TMO], 1u); break; } } } } while (0)
struct XcdBarrier { unsigned* bar; unsigned x; volatile LAS unsigned* st; };
__device__ __forceinline__ XcdBarrier xcd_barrier_post(unsigned* bar, volatile LAS unsigned* st) {
    XcdBarrier b; b.bar = bar; b.x = xb_xcc_id(); b.st = st;
    if (threadIdx.x == 0) (void)xb_add(&bar[XB_XCNT(b.x)], 1u);
    return b;
}
__device__ __forceinline__ void xcd_barrier_complete(unsigned* bar, unsigned x, unsigned& nloc, unsigned& nx) {
    const unsigned G = gridDim.x * gridDim.y * gridDim.z;
    unsigned sum, cnt, mine, sp = 0u;
    for (;;) {
        sum = 0u; cnt = 0u; mine = 0u;
#pragma unroll
        for (unsigned j = 0; j < 16; ++j) { const unsigned c = xb_ld(&bar[XB_XCNT(j)]); sum += c; cnt += (c > 0u) ? 1u : 0u; mine = (j == x) ? c : mine; }
        if (sum == G) break;
        __builtin_amdgcn_s_sleep(1);
        if ((++sp & 255u) == 0u) { if (xb_ld(&bar[XB_TMO])) break; if (sp > XB_SPIN_CAP) { atomicAdd(&bar[XB_TMO], 1u); break; } }
    }
    nloc = mine > 0u ? mine : 1u; nx = cnt > 0u ? cnt : 1u;
}
__device__ __forceinline__ void xcd_barrier(const XcdBarrier& b) {
    asm volatile("s_waitcnt vmcnt(0)" ::: "memory");
    __syncthreads();
    if (threadIdx.x == 0) {
        unsigned* bar = b.bar;
        __builtin_amdgcn_s_waitcnt(0);
        unsigned nloc = b.st[0], nx = b.st[1];
        if (nloc == 0u) { xcd_barrier_complete(bar, b.x, nloc, nx); b.st[0] = nloc; b.st[1] = nx; }
        const unsigned old = xb_add(&bar[XB_XSUB(b.x)], 1u);
        const unsigned gen = old / nloc;
        if (old + 1u == (gen + 1u) * nloc) {
            __builtin_amdgcn_fence(__ATOMIC_RELEASE, "agent");
            asm volatile("s_waitcnt vmcnt(0)" ::: "memory");
            const unsigned og = xb_add(&bar[XB_TOP], 1u);
            const unsigned tg = og / nx;
            if (og + 1u == (tg + 1u) * nx) xb_add(&bar[XB_TOPGEN], 1u);
            else XB_SPIN(xb_ld(&bar[XB_TOPGEN]) == tg, bar);
            __builtin_amdgcn_fence(__ATOMIC_ACQUIRE, "agent");
            xb_add(&bar[XB_XGEN(b.x)], 1u);
            asm volatile("s_waitcnt vmcnt(0)" ::: "memory");
        } else {
            XB_SPIN(xb_ld(&bar[XB_XGEN(b.x)]) == gen, bar);
            __builtin_amdgcn_fence(__ATOMIC_ACQUIRE, "agent");
            asm volatile("s_waitcnt vmcnt(0)" ::: "memory");
        }
    }
    __syncthreads();
}

#ifndef FLAT_BAR
#define FLAT_BAR 0
#endif
constexpr int CW_SLOT = 14336;
__device__ __forceinline__ void flat_barrier(unsigned* slots, unsigned gen) {
    asm volatile("s_waitcnt vmcnt(0)" ::: "memory");
    __syncthreads();
    if (threadIdx.x < 64) {
        const unsigned G = gridDim.x, lane = threadIdx.x;
        if (lane == 0) { __builtin_amdgcn_fence(__ATOMIC_RELEASE, "agent"); __hip_atomic_store(&slots[blockIdx.x], gen, __ATOMIC_RELAXED, __HIP_MEMORY_SCOPE_AGENT); }
        unsigned sp = 0u;
        for (;;) {
            bool ok = true;
            for (unsigned i = lane; i < G; i += 64u) ok = ok && (__hip_atomic_load(&slots[i], __ATOMIC_RELAXED, __HIP_MEMORY_SCOPE_AGENT) >= gen);
            if (__all(ok)) break;
            __builtin_amdgcn_s_sleep(1);
            if (++sp > XB_SPIN_CAP) break;
        }
        __builtin_amdgcn_fence(__ATOMIC_ACQUIRE, "agent");
    }
    __syncthreads();
}
#define XB_XSLOT 3520
__device__ __forceinline__ void xcd_barrier2(const XcdBarrier& b) {
    asm volatile("s_waitcnt vmcnt(0)" ::: "memory");
    __syncthreads();
    if (threadIdx.x < 64) {
        unsigned* bar = b.bar; const unsigned lane = threadIdx.x;
        unsigned gen = 0u;
        if (lane == 0) {
            __builtin_amdgcn_s_waitcnt(0);
            unsigned nloc = b.st[0], nx = b.st[1];
            if (nloc == 0u) { xcd_barrier_complete(bar, b.x, nloc, nx); b.st[0] = nloc; b.st[1] = nx;
                unsigned mask = 0u;
#pragma unroll
                for (unsigned j = 0; j < 16; ++j) mask |= (xb_ld(&bar[XB_XCNT(j)]) > 0u) ? (1u << j) : 0u;
                b.st[2] = mask; }
            const unsigned old = xb_add(&bar[XB_XSUB(b.x)], 1u);
            const unsigned g0 = old / nloc; gen = g0 + 1u;
            if (old + 1u == gen * nloc) {
                __builtin_amdgcn_fence(__ATOMIC_RELEASE, "agent");
                asm volatile("s_waitcnt vmcnt(0)" ::: "memory");
                __hip_atomic_store(&bar[XB_XSLOT + b.x], gen, __ATOMIC_RELAXED, __HIP_MEMORY_SCOPE_AGENT);
            }
        }
        gen = __builtin_amdgcn_readfirstlane(gen);
        asm volatile("s_waitcnt lgkmcnt(0)" ::: "memory");
        const unsigned mask = b.st[2];
        const bool need = lane < 16u && ((mask >> lane) & 1u);
        unsigned sp = 0u;
        for (;;) {
            const bool ok = !need || xb_ld(&bar[XB_XSLOT + (lane & 15u)]) >= gen;
            if (__all(ok)) break;
            __builtin_amdgcn_s_sleep(1);
            if (++sp > XB_SPIN_CAP) break;
        }
        __builtin_amdgcn_fence(__ATOMIC_ACQUIRE, "agent");
    }
    __syncthreads();
}
#if FLAT_BAR == 2
#define GRID_BARRIER(b) xcd_barrier2(b)
#elif FLAT_BAR
#define GRID_BARRIER(b) flat_barrier(ctl + CW_SLOT, ++bar_gen)
#else
#define GRID_BARRIER(b) xcd_barrier(b)
#endif

#ifndef P21_SPLIT_EN
#define P21_SPLIT_EN 1
#endif
#define P21_CNT_OFF 0
#define P21_TAIL_EN 1
#ifndef PROBE_BUILD
#define PROBE_BUILD 0
#endif
#ifndef REPMASK
#define REPMASK 0u
#endif
#if PROBE_BUILD
struct Args { const void* in[42]; float* out; unsigned char* ws; int ph_lo, ph_hi; unsigned repmask; unsigned pad; };
#else
struct Args { const void* in[42]; float* out; unsigned char* ws; int ph_lo, ph_hi; };
#endif
struct Ctx { LAS unsigned char* lds; unsigned char* ws; int tid, lane, wave, G, bx, vcu, gw, ngw; };
#define INF(k) ((const float*)a.in[k])
enum { I_X = 0, I_POS, I_ELNMIX, I_EWIN, I_CONVW, I_CONVB, I_GAW, I_GAB, I_GXW, I_GXB, I_LAM, I_MU, I_W0, I_W2, I_A0, I_A2, I_G2, I_KK, I_KA, I_RK, I_GNW, I_GNB, I_EWOUT, I_ELNFFN,
       I_FFG, I_FFU, I_FFD, I_OLNMIX, I_WQKV, I_QNORM, I_KNORM, I_LQ1, I_LK1, I_LQ2, I_LK2, I_SUBLN, I_WO, I_OLNFFN, I_ROUTER, I_MOEG, I_MOEU, I_MOED };

__device__ __forceinline__ void transpose_item(const float* __restrict__ W, int K, int N, bf16* __restrict__ WT, int mode, LAS float* scr, int item, int lane, const float* __restrict__ ks = nullptr) {
    const int nblk = N / 32, kb = item / nblk, nb = item % nblk, k0 = 64 * kb, n0 = 32 * nb;
#pragma unroll 8
    for (int i = 0; i < 32; ++i) { const int kk = 2 * i + (lane >> 5); scr[kk * 33 + (lane & 31)] = W[(size_t)(k0 + kk) * N + n0 + (lane & 31)] * (ks ? ks[k0 + kk] : 1.0f); }
    asm volatile("s_waitcnt lgkmcnt(0)" ::: "memory");
    const int rb = mode == 0 ? n0 : (256 * (n0 >> 7) + 2 * (n0 & 127) + (mode == 2 ? 32 : 0));
    const int c = lane & 7;
#pragma unroll
    for (int j = 0; j < 4; ++j) { const int n = (lane >> 3) + 8 * j; const LAS float* s = scr + (8 * c) * 33 + n;
        u32x4 o; o.x = cvt_pk_bf16(s[0 * 33], s[1 * 33]); o.y = cvt_pk_bf16(s[2 * 33], s[3 * 33]); o.z = cvt_pk_bf16(s[4 * 33], s[5 * 33]); o.w = cvt_pk_bf16(s[6 * 33], s[7 * 33]);
        *(u32x4*)(WT + (size_t)(rb + n) * K + k0 + 8 * c) = o; }
    asm volatile("s_waitcnt lgkmcnt(0)" ::: "memory");
}
__device__ __forceinline__ void transpose_item8(const float* __restrict__ W, int K, int N, unsigned char* __restrict__ WT, int mode, float wscale, LAS float* scr, int item, int lane) {
    const int nblk = N / 32, kb = item / nblk, nb = item % nblk, k0 = 64 * kb, n0 = 32 * nb;
#pragma unroll 8
    for (int i = 0; i < 32; ++i) { const int kk = 2 * i + (lane >> 5); scr[kk * 33 + (lane & 31)] = W[(size_t)(k0 + kk) * N + n0 + (lane & 31)] * wscale; }
    asm volatile("s_waitcnt lgkmcnt(0)" ::: "memory");
    const int rb = mode == 0 ? n0 : (256 * (n0 >> 7) + 2 * (n0 & 127) + (mode == 2 ? 32 : 0));
    const int c = lane & 7;
#pragma unroll
    for (int j = 0; j < 4; ++j) { const int n = (lane >> 3) + 8 * j; const LAS float* s = scr + (8 * c) * 33 + n;
        u32x2 o; o.x = pg8::pk4_fp8(s[0 * 33], s[1 * 33], s[2 * 33], s[3 * 33]); o.y = pg8::pk4_fp8(s[4 * 33], s[5 * 33], s[6 * 33], s[7 * 33]);
        *(u32x2*)(WT + (size_t)(rb + n) * K + k0 + 8 * c) = o; }
    asm volatile("s_waitcnt lgkmcnt(0)" ::: "memory");
}
__device__ __forceinline__ f32x4 ld_x4(const float* row, int idx) { return ((const f32x4*)row)[idx]; }
__device__ __forceinline__ f32x4 ld_x4(const bf16* row, int idx) { const u32x2 w = ((const u32x2*)row)[idx]; return (f32x4){bflo(w.x), bfhi(w.x), bflo(w.y), bfhi(w.y)}; }
template <class XT> __device__ __forceinline__ void rms_row_bf16(const XT* __restrict__ xrow, const float* __restrict__ g, bf16* __restrict__ orow, int lane) {
    f32x4 v[4]; float s = 0.f;
#pragma unroll
    for (int j = 0; j < 4; ++j) { v[j] = ld_x4(xrow, lane + 64 * j); s += (v[j].x * v[j].x + v[j].y * v[j].y) + (v[j].z * v[j].z + v[j].w * v[j].w); }
    const float r = rsqrtf(wave_sum(s) * (1.0f / 1024.0f) + 1e-6f);
#pragma unroll
    for (int j = 0; j < 4; ++j) { const f32x4 gv = ((const f32x4*)g)[lane + 64 * j]; const f32x4 o = v[j] * r * gv;
        u32x2 w; w.x = cvt_pk_bf16(o.x, o.y); w.y = cvt_pk_bf16(o.z, o.w); ((u32x2*)orow)[lane + 64 * j] = w; }
}
__device__ __forceinline__ void rowstat_phase(const Ctx& c, const bf16* x, float* RS) {
    for (int m = c.gw; m < M; m += c.ngw) { float s = 0.f;
#pragma unroll
        for (int j = 0; j < 2; ++j) { float f[8]; unpack8(((const u32x4*)(x + (size_t)m * D))[c.lane + 64 * j], f);
#pragma unroll
            for (int e = 0; e < 8; ++e) s += f[e] * f[e]; }
        s = wave_sum(s);
        if (c.lane == 0) RS[m] = rsqrtf(s * (1.0f / 1024.0f) + 1e-6f); }
}
template <class XT> __device__ __forceinline__ void rms_rows_phase(const Ctx& c, const XT* x, const float* g, bf16* out) {
    for (int m = c.gw; m < M; m += c.ngw) rms_row_bf16(x + (size_t)m * D, g, out + (size_t)m * D, c.lane);
}
__device__ __forceinline__ void moe_convert(const Ctx& c, const Args& a, int which, int e_lo = 0, int e_hi = NE, int gw = -1, int ngw = 0) {
    if (gw < 0) { gw = c.gw; ngw = c.ngw; }
    LAS float* scr = (LAS float*)(c.lds + c.wave * 16384);
    unsigned char* WG = (unsigned char*)(c.ws + WS_WGUM); unsigned char* WD = (unsigned char*)(c.ws + WS_WDM);
    if (which < 2) { constexpr int IPE = (D / 64) * (ED / 32);
        const float* W = INF(which == 0 ? I_MOEG : I_MOEU);
        for (int it = e_lo * IPE + gw; it < e_hi * IPE; it += ngw) { const int e = it / IPE, r = it % IPE;
            transpose_item8(W + (size_t)e * D * ED, D, ED, WG + (size_t)e * 2 * ED * D, 1 + which, MOE_WG_SCALE, scr, r, c.lane); }
    } else { constexpr int IPE = (ED / 64) * (D / 32);
        const float* W = INF(I_MOED);
        for (int it = e_lo * IPE + gw; it < e_hi * IPE; it += ngw) { const int e = it / IPE, r = it % IPE;
            transpose_item8(W + (size_t)e * ED * D, ED, D, WD + (size_t)e * D * ED, 0, MOE_WD_SCALE, scr, r, c.lane); }
    }
}
constexpr int P6_BUSY = 96, P6_MOE_E = 5, P6_MOE_U = 0, P11_MOE_U = 4, P17_MOE_D = 4;
__device__ __forceinline__ void convert_rest(const Ctx& c, const Args& a, int gw, int ngw) {
    LAS float* scr = (LAS float*)(c.lds + c.wave * 16384);
    constexpr int I_SQ = (D / 64) * (D / 32), I_FF = (D / 64) * (FFN / 32), I_DN = (FFN / 64) * (D / 32), I_QKV = (D / 64) * (3072 / 32);
    constexpr int NITEMS = I_SQ + 2 * I_FF + I_DN + I_QKV + I_SQ;
    for (int it = gw; it < NITEMS; it += ngw) {
        int r = it;
        if (r < I_SQ) { transpose_item(INF(I_EWOUT), D, D, (bf16*)(c.ws + WS_WOUT), 0, scr, r, c.lane); continue; } r -= I_SQ;
        if (r < I_FF) { transpose_item(INF(I_FFG), D, FFN, (bf16*)(c.ws + WS_WGU), 1, scr, r, c.lane, INF(I_ELNFFN)); continue; } r -= I_FF;
        if (r < I_FF) { transpose_item(INF(I_FFU), D, FFN, (bf16*)(c.ws + WS_WGU), 2, scr, r, c.lane, INF(I_ELNFFN)); continue; } r -= I_FF;
        if (r < I_DN) { transpose_item(INF(I_FFD), FFN, D, (bf16*)(c.ws + WS_WDN), 0, scr, r, c.lane); continue; } r -= I_DN;
        if (r < I_QKV) { transpose_item(INF(I_WQKV), D, 3072, (bf16*)(c.ws + WS_WQKV), 0, scr, r, c.lane, INF(I_OLNMIX)); continue; } r -= I_QKV;
        transpose_item(INF(I_WO), D, D, (bf16*)(c.ws + WS_WO), 0, scr, r, c.lane);
    }
}
__device__ __forceinline__ void phase0(const Ctx& c, const Args& a) {
    LAS float* scr = (LAS float*)(c.lds + c.wave * 16384);
    constexpr int I_IN = (D / 64) * (EIN / 32);
    for (int it = c.gw; it < I_IN; it += c.ngw) transpose_item(INF(I_EWIN), D, EIN, (bf16*)(c.ws + WS_WIN), 0, scr, it, c.lane);
    if (c.G <= P6_BUSY) convert_rest(c, a, c.gw, c.ngw);
    { const float* w2 = INF(I_W2); const float* a2 = INF(I_A2); const float* g2 = INF(I_G2); const float* wa = INF(I_GAW); const float* wx = INF(I_GXW);
      bf16* B2 = (bf16*)(c.ws + WS_B2T); bf16* BL = (bf16*)(c.ws + WS_BLRU);
      constexpr int N1 = 1536 * 32, N2 = 1024 * 64;
      for (int id = c.bx * NTHR + c.tid; id < N1 + N2; id += c.G * NTHR) {
          float f[8];
          if (id < N1) { const int n = id >> 5, k0 = (id & 31) * 8;
#pragma unroll
              for (int e = 0; e < 8; ++e) { const int k = k0 + e; float v = 0.f;
                  if (n < 512) { if (k < 64) v = w2[k * 512 + n]; }
                  else if (n < 1024) { if (k >= 64 && k < 128) v = a2[(k - 64) * 512 + (n - 512)]; }
                  else { if (k >= 128) v = g2[(k - 128) * 512 + (n - 1024)]; }
                  f[e] = v; }
              *(u32x4*)(B2 + (size_t)n * 256 + k0) = pack8(f);
          } else { const int id2 = id - N1, n = id2 >> 6, k0 = (id2 & 63) * 8; const int nn = n & 511, hd = nn >> 6, j = nn & 63; const float* w = n < 512 ? wa : wx;
#pragma unroll
              for (int e = 0; e < 8; ++e) { const int k = k0 + e; f[e] = ((k >> 6) == hd) ? w[(hd * 64 + (k & 63)) * 64 + j] : 0.f; }
              *(u32x4*)(BL + (size_t)n * 512 + k0) = pack8(f);
          }
      } }
    rms_rows_phase(c, INF(I_X), INF(I_ELNMIX), (bf16*)(c.ws + WS_XN));
}

__device__ __forceinline__ void phase2(const Ctx& c, const Args& a) {
    const bf16* P = (const bf16*)(c.ws + WS_PROJ); bf16* XC = (bf16*)(c.ws + WS_XC); bf16* A2 = (bf16*)(c.ws + WS_A2);
    const int c0 = 8 * c.lane;
    float cw[4][8], cb[8], mu[8];
#pragma unroll
    for (int j = 0; j < 4; ++j)
#pragma unroll
        for (int e = 0; e < 8; ++e) cw[j][e] = INF(I_CONVW)[j * 512 + c0 + e];
#pragma unroll
    for (int e = 0; e < 8; ++e) { cb[e] = INF(I_CONVB)[c0 + e]; mu[e] = INF(I_MU)[1536 + ((8 * c.lane) & 255) + e]; }
    for (int m = c.gw; m < M; m += c.ngw) {
        const int t = m & (T - 1);
        float acc[8];
#pragma unroll
        for (int e = 0; e < 8; ++e) acc[e] = cb[e];
#pragma unroll
        for (int j = 0; j < 4; ++j) { if (t - 3 + j >= 0) { float x[8]; unpack8(*(const u32x4*)(P + (size_t)(m - 3 + j) * EIN + c0), x);
#pragma unroll
                for (int e = 0; e < 8; ++e) acc[e] += cw[j][e] * x[e]; } }
        *(u32x4*)(XC + (size_t)m * 512 + c0) = pack8(acc);
        if (c.lane < 32) { const int col = 1024 + 1536 + 8 * c.lane; float p[8], pp[8], o[8];
            unpack8(*(const u32x4*)(P + (size_t)m * EIN + col), p);
            if (t > 0) unpack8(*(const u32x4*)(P + (size_t)(m - 1) * EIN + col), pp); else {
#pragma unroll
                for (int e = 0; e < 8; ++e) pp[e] = 0.f; }
#pragma unroll
            for (int e = 0; e < 8; ++e) { const float s = p[e] + (pp[e] - p[e]) * mu[e]; o[e] = c.lane < 8 ? tanhf_(s) : (c.lane < 16 ? s : sigmoidf_(s)); }
            *(u32x4*)(A2 + (size_t)m * 256 + 8 * c.lane) = pack8(o); }
    }
}

template <int MODE> __device__ __forceinline__ void phase4(const Ctx& c, const Args& a) {
    const bf16* __restrict__ P = (const bf16*)(c.ws + WS_PROJ); const bf16* __restrict__ G1 = (const bf16*)(c.ws + WS_G1);
    float* __restrict__ R4 = (float*)(c.ws + WS_REC4); float* __restrict__ R2 = (float*)(c.ws + WS_REC2); float* __restrict__ BS = (float*)(c.ws + WS_BS);
    if (MODE != 2) {
        const int hd = c.lane >> 3, c8 = c.lane & 7, ch = 64 * hd + 4 * c8;
        float mur[8], muk[8], muv[8], w0[8], a0[8], kkw[8], kaw[8], rkw[8];
#pragma unroll
        for (int e = 0; e < 8; ++e) { const int cc = ch + (e & 3) + 32 * (e >> 2); mur[e] = INF(I_MU)[cc]; muk[e] = INF(I_MU)[512 + cc]; muv[e] = INF(I_MU)[1024 + cc]; w0[e] = INF(I_W0)[cc]; a0[e] = INF(I_A0)[cc];
            kkw[e] = INF(I_KK)[cc]; kaw[e] = INF(I_KA)[cc]; rkw[e] = INF(I_RK)[cc]; }
        for (int m0 = c.gw; m0 < M; m0 += 2 * c.ngw) {
            u32x2 lr[2][2], lk[2][2], lv[2][2], lrp[2][2], lkp[2][2], lvp[2][2], lw[2][2], la[2][2];
#pragma unroll
            for (int u = 0; u < 2; ++u) { const int m = m0 + u * c.ngw; const int t = m & (T - 1); const bf16* pr = P + (size_t)m * EIN + 1024 + ch; const bf16* g1 = G1 + (size_t)m * 1536 + ch;
#pragma unroll
                for (int h2 = 0; h2 < 2; ++h2) { lr[u][h2] = *(const u32x2*)(pr + 32 * h2); lk[u][h2] = *(const u32x2*)(pr + 512 + 32 * h2); lv[u][h2] = *(const u32x2*)(pr + 1024 + 32 * h2);
                    lw[u][h2] = *(const u32x2*)(g1 + 32 * h2); la[u][h2] = *(const u32x2*)(g1 + 512 + 32 * h2);
                    if (t > 0) { lrp[u][h2] = *(const u32x2*)(pr - EIN + 32 * h2); lkp[u][h2] = *(const u32x2*)(pr - EIN + 512 + 32 * h2); lvp[u][h2] = *(const u32x2*)(pr - EIN + 1024 + 32 * h2); }
                    else { lrp[u][h2] = (u32x2){0u, 0u}; lkp[u][h2] = (u32x2){0u, 0u}; lvp[u][h2] = (u32x2){0u, 0u}; } } }
#pragma unroll
            for (int u = 0; u < 2; ++u) { const int m = m0 + u * c.ngw; const int t = m & (T - 1), b = m >> 13;
                float r[8], k[8], v[8], dec[8], kk[8], bb[8], k2[8]; float n2 = 0.f, bon = 0.f;
#pragma unroll
                for (int e = 0; e < 8; ++e) { const int h2 = e >> 2, p = (e >> 1) & 1, od = e & 1;
#define UNP_(L) (od ? bfhi(p ? L[u][h2].y : L[u][h2].x) : bflo(p ? L[u][h2].y : L[u][h2].x))
                    const float r0 = UNP_(lr), k0 = UNP_(lk), v0 = UNP_(lv), rp = UNP_(lrp), kp = UNP_(lkp), vp = UNP_(lvp), wpre = UNP_(lw), apre = UNP_(la);
#undef UNP_
                    r[e] = r0 + (rp - r0) * mur[e]; k[e] = k0 + (kp - k0) * muk[e]; v[e] = v0 + (vp - v0) * muv[e];
                    const float z = w0[e] + wpre;
                    const float wlog = -__logf(1.0f + __expf(-z)) - 0.5f;
                    dec[e] = __expf(-__expf(wlog));
                    const float av = sigmoidf_(a0[e] + apre);
                    kk[e] = k[e] * kkw[e]; n2 += kk[e] * kk[e];
                    k2[e] = k[e] * (1.0f + (av - 1.0f) * kaw[e]);
                    bb[e] = av;
                    bon += r[e] * k2[e] * rkw[e];
                }
                n2 += __shfl_xor(n2, 1); n2 += __shfl_xor(n2, 2); n2 += __shfl_xor(n2, 4);
                bon += __shfl_xor(bon, 1); bon += __shfl_xor(bon, 2); bon += __shfl_xor(bon, 4);
                const float inv = 1.0f / fmaxf(sqrtf(n2), 1e-12f);
#pragma unroll
                for (int e = 0; e < 8; ++e) { kk[e] *= inv; bb[e] *= kk[e]; }
                const size_t rec = ((size_t)(b * 8 + hd) * T + t);
                float* q4 = R4 + rec * 256 + 4 * c8; float* q2 = R2 + rec * 128 + 4 * c8;
                *(f32x4*)(q4) = (f32x4){dec[0], dec[1], dec[2], dec[3]}; *(f32x4*)(q4 + 32) = (f32x4){dec[4], dec[5], dec[6], dec[7]};
                *(f32x4*)(q4 + 64) = (f32x4){kk[0], kk[1], kk[2], kk[3]}; *(f32x4*)(q4 + 96) = (f32x4){kk[4], kk[5], kk[6], kk[7]};
                *(f32x4*)(q4 + 128) = (f32x4){bb[0], bb[1], bb[2], bb[3]}; *(f32x4*)(q4 + 160) = (f32x4){bb[4], bb[5], bb[6], bb[7]};
                *(f32x4*)(q4 + 192) = (f32x4){k2[0], k2[1], k2[2], k2[3]}; *(f32x4*)(q4 + 224) = (f32x4){k2[4], k2[5], k2[6], k2[7]};
                *(f32x4*)(q2) = (f32x4){r[0], r[1], r[2], r[3]}; *(f32x4*)(q2 + 32) = (f32x4){r[4], r[5], r[6], r[7]};
                *(f32x4*)(q2 + 64) = (f32x4){v[0], v[1], v[2], v[3]}; *(f32x4*)(q2 + 96) = (f32x4){v[4], v[5], v[6], v[7]};
                if (c8 == 0) BS[(size_t)m * 8 + hd] = bon;
            }
        }
    }
    if (MODE != 1) {
        const bf16* __restrict__ G2 = (const bf16*)(c.ws + WS_G2); const bf16* __restrict__ XC = (const bf16*)(c.ws + WS_XC);
        bf16* __restrict__ HL = (bf16*)(c.ws + WS_LA); bf16* __restrict__ CP = (bf16*)(c.ws + WS_LU); float* __restrict__ LSA = (float*)(c.ws + WS_LSA); float* __restrict__ LSH = (float*)(c.ws + WS_LSH);
        for (int item = c.gw; item < M / 8; item += c.ngw) {
            const int tile = item >> 1, ch = 256 * (item & 1) + 4 * c.lane;
            float ba[4], bxb[4], sp[4];
#pragma unroll
            for (int e = 0; e < 4; ++e) { ba[e] = INF(I_GAB)[ch + e]; bxb[e] = INF(I_GXB)[ch + e]; sp[e] = log1pf(__expf(-INF(I_LAM)[ch + e])); }
            float h[4], sl[4];
#pragma unroll
            for (int e = 0; e < 4; ++e) { h[e] = 0.f; sl[e] = 0.f; }
#pragma unroll 4
            for (int tt = 0; tt < 16; ++tt) { const size_t m = (size_t)tile * 16 + tt;
                const u32x2 gaq = *(const u32x2*)(G2 + m * 1024 + ch), gxq = *(const u32x2*)(G2 + m * 1024 + 512 + ch), xcq = *(const u32x2*)(XC + m * 512 + ch);
                const float ga[4] = {bflo(gaq.x), bfhi(gaq.x), bflo(gaq.y), bfhi(gaq.y)}, gx[4] = {bflo(gxq.x), bfhi(gxq.x), bflo(gxq.y), bfhi(gxq.y)}, xc[4] = {bflo(xcq.x), bfhi(xcq.x), bflo(xcq.y), bfhi(xcq.y)};
                float ho[4], co[4];
#pragma unroll
                for (int e = 0; e < 4; ++e) {
                    const float la = -8.0f * sigmoidf_(ga[e] + ba[e]) * sp[e];
                    const float x2 = 2.0f * la;
                    const float em = x2 < -0.5f ? 1.0f - __expf(x2) : -x2 * (1.0f + x2 * (0.5f + x2 * (0.16666667f + x2 * (0.041666668f + x2 * (0.0083333338f + x2 * 0.0013888889f)))));
                    const float u = sqrtf(fmaxf(em, 0.f)) * sigmoidf_(gx[e] + bxb[e]) * xc[e];
                    h[e] = __expf(la) * h[e] + u; sl[e] += la; ho[e] = h[e]; co[e] = __expf(sl[e]); }
                *(u32x2*)(HL + m * 512 + ch) = (u32x2){cvt_pk_bf16(ho[0], ho[1]), cvt_pk_bf16(ho[2], ho[3])}; *(u32x2*)(CP + m * 512 + ch) = (u32x2){cvt_pk_bf16(co[0], co[1]), cvt_pk_bf16(co[2], co[3])}; }
            *(f32x4*)(LSA + (size_t)tile * 512 + ch) = (f32x4){sl[0], sl[1], sl[2], sl[3]};
            *(f32x4*)(LSH + (size_t)tile * 512 + ch) = (f32x4){h[0], h[1], h[2], h[3]};
        }
    }
}

__device__ __forceinline__ float quad_sum(float v) {
    v += __builtin_bit_cast(float, __builtin_amdgcn_update_dpp(0, __builtin_bit_cast(int, v), 0xB1, 0xF, 0xF, true));
    v += __builtin_bit_cast(float, __builtin_amdgcn_update_dpp(0, __builtin_bit_cast(int, v), 0x4E, 0xF, 0xF, true));
    return v;
}
constexpr int SC_STEPS = 8, SC_TASK_BYTES = SC_STEPS * 1536, SC_BUF_BYTES = 4 * SC_TASK_BYTES;
__device__ __forceinline__ void scan_issue(const Ctx& c, int task0, int s) {
    const float* R4 = (const float*)(c.ws + WS_REC4); const float* R2 = (const float*)(c.ws + WS_REC2);
#pragma unroll
    for (int i = 0; i < 6; ++i) { const int id = c.wave * 6 + i, tk = id / 12, rem = id % 12; const int task = task0 + tk, bh = task >> 6, t0 = (task & 63) * 128 + s * SC_STEPS;
        const unsigned dst = (unsigned)((s & 1) * SC_BUF_BYTES + tk * SC_TASK_BYTES);
        if (rem < 8) __builtin_amdgcn_global_load_lds((const unsigned*)(R4 + ((size_t)bh * T + t0 + rem) * 256 + c.lane * 4), (LAS unsigned*)(c.lds + dst + rem * 1024), 16, 0, 0);
        else __builtin_amdgcn_global_load_lds((const unsigned*)(R2 + ((size_t)bh * T + t0 + 2 * (rem - 8)) * 128 + c.lane * 4), (LAS unsigned*)(c.lds + dst + 8192 + (rem - 8) * 1024), 16, 0, 0); }
}
#define LDS4(p) (*(const LAS f32x4*)(p))
__device__ __forceinline__ float oct_sum(float v) {
    v += __builtin_bit_cast(float, __builtin_amdgcn_update_dpp(0, __builtin_bit_cast(int, v), 0xB1, 0xF, 0xF, true));
    v += __builtin_bit_cast(float, __builtin_amdgcn_update_dpp(0, __builtin_bit_cast(int, v), 0x4E, 0xF, 0xF, true));
    v += __builtin_bit_cast(float, __builtin_amdgcn_update_dpp(0, __builtin_bit_cast(int, v), 0x141, 0xF, 0xF, true));
    return v;
}
struct ScanOps5 { f32x4 w[2], kk[2], bb[2], kp[2], rr[2], vv; };
__device__ __forceinline__ void scan_load5(ScanOps5& o, const LAS unsigned char* r4, const LAS unsigned char* r2r, const LAS unsigned char* r2v) {
    o.w[0] = LDS4(r4); o.w[1] = LDS4(r4 + 16); o.kk[0] = LDS4(r4 + 256); o.kk[1] = LDS4(r4 + 272); o.bb[0] = LDS4(r4 + 512); o.bb[1] = LDS4(r4 + 528); o.kp[0] = LDS4(r4 + 768); o.kp[1] = LDS4(r4 + 784);
    o.rr[0] = LDS4(r2r); o.rr[1] = LDS4(r2r + 16); o.vv = LDS4(r2v);
}
template <int MODE> __device__ __forceinline__ void phase5(const Ctx& c, float* __restrict__ YZ) {
    float* PL = (float*)(c.ws + WS_PL);
    const int tk = c.wave >> 1, half = c.wave & 1, rg = c.lane >> 3, q = c.lane & 7;
    for (int tg = c.bx; tg < 256; tg += c.G) {
        const int task0 = tg * 4;
        f32x2 Sp[4][4], Sl[4][4];
#pragma unroll
        for (int j = 0; j < 4; ++j)
#pragma unroll
            for (int i = 0; i < 4; ++i) { Sp[j][i] = (f32x2){(8 * q + 2 * i == 32 * half + 4 * rg + j) ? 1.f : 0.f, (8 * q + 2 * i + 1 == 32 * half + 4 * rg + j) ? 1.f : 0.f}; Sl[j][i] = (f32x2){0.f, 0.f}; }
        if (MODE != 2) scan_issue(c, task0, 0);
        asm volatile("s_waitcnt vmcnt(0)" ::: "memory"); __syncthreads();
        for (int s = 0; s < 16; ++s) {
            if (MODE != 2) { if (s + 1 < 16) scan_issue(c, task0, s + 1); }
            if (MODE != 1) {
            const LAS unsigned char* base = c.lds + (s & 1) * SC_BUF_BYTES + tk * SC_TASK_BYTES;
            const LAS unsigned char* r4b = base + q * 32; const LAS unsigned char* r2rb = base + 8192 + q * 32; const LAS unsigned char* r2b = base + 8192 + 256 + (32 * half + 4 * rg) * 4;
            float* yzp = YZ + ((size_t)((task0 + tk) >> 6) * T + ((task0 + tk) & 63) * 128 + s * SC_STEPS) * 128 + 32 * half + 4 * rg;
            ScanOps5 cur, nxt; scan_load5(cur, r4b, r2rb, r2b);
#pragma unroll 2
            for (int st = 0; st < SC_STEPS; ++st) {
                if (st + 1 < SC_STEPS) scan_load5(nxt, r4b + (st + 1) * 1024, r2rb + (st + 1) * 512, r2b + (st + 1) * 512);
                __builtin_amdgcn_sched_barrier(0);
                const f32x2 w2[4] = {cur.w[0].xy, cur.w[0].zw, cur.w[1].xy, cur.w[1].zw}, kk2[4] = {cur.kk[0].xy, cur.kk[0].zw, cur.kk[1].xy, cur.kk[1].zw};
                const f32x2 bb2[4] = {cur.bb[0].xy, cur.bb[0].zw, cur.bb[1].xy, cur.bb[1].zw}, kp2[4] = {cur.kp[0].xy, cur.kp[0].zw, cur.kp[1].xy, cur.kp[1].zw};
                float sp[4], sl[4];
#pragma unroll
                for (int j = 0; j < 4; ++j) { f32x2 a0 = Sp[j][0] * kk2[0], a1 = Sl[j][0] * kk2[0];
#pragma unroll
                    for (int i = 1; i < 4; ++i) { a0 = __builtin_elementwise_fma(Sp[j][i], kk2[i], a0); a1 = __builtin_elementwise_fma(Sl[j][i], kk2[i], a1); }
                    sp[j] = -oct_sum(a0.x + a0.y); sl[j] = -oct_sum(a1.x + a1.y); }
#pragma unroll
                for (int j = 0; j < 4; ++j) { const f32x2 vj = {cur.vv[j], cur.vv[j]}, spj = {sp[j], sp[j]}, slj = {sl[j], sl[j]};
#pragma unroll
                    for (int i = 0; i < 4; ++i) { Sp[j][i] = __builtin_elementwise_fma(Sp[j][i], w2[i], spj * bb2[i]);
                        Sl[j][i] = __builtin_elementwise_fma(Sl[j][i], w2[i], __builtin_elementwise_fma(slj, bb2[i], vj * kp2[i])); } }
                { const f32x2 rr2[4] = {cur.rr[0].xy, cur.rr[0].zw, cur.rr[1].xy, cur.rr[1].zw}; f32x4 yv, zv;
#pragma unroll
                  for (int j = 0; j < 4; ++j) { f32x2 a0 = Sp[j][0] * rr2[0], a1 = Sl[j][0] * rr2[0];
#pragma unroll
                      for (int i = 1; i < 4; ++i) { a0 = __builtin_elementwise_fma(Sp[j][i], rr2[i], a0); a1 = __builtin_elementwise_fma(Sl[j][i], rr2[i], a1); }
                      yv[j] = oct_sum(a0.x + a0.y); zv[j] = oct_sum(a1.x + a1.y); }
                  if (q == 0) { *(f32x4*)(yzp + (size_t)st * 128) = yv; *(f32x4*)(yzp + (size_t)st * 128 + 64) = zv; } }
                __builtin_amdgcn_sched_barrier(0);
                if (st + 1 < SC_STEPS) cur = nxt;
            }
            }
            asm volatile("s_waitcnt vmcnt(0)" ::: "memory"); __syncthreads();
        }
        float* o = PL + (size_t)(task0 + tk) * 8192 + (32 * half + 4 * rg) * 64 + 8 * q;
#pragma unroll
        for (int j = 0; j < 4; ++j) {
            *(f32x4*)(o + j * 64) = (f32x4){Sp[j][0].x, Sp[j][0].y, Sp[j][1].x, Sp[j][1].y}; *(f32x4*)(o + j * 64 + 4) = (f32x4){Sp[j][2].x, Sp[j][2].y, Sp[j][3].x, Sp[j][3].y};
            *(f32x4*)(o + 4096 + j * 64) = (f32x4){Sl[j][0].x, Sl[j][0].y, Sl[j][1].x, Sl[j][1].y}; *(f32x4*)(o + 4096 + j * 64 + 4) = (f32x4){Sl[j][2].x, Sl[j][2].y, Sl[j][3].x, Sl[j][3].y}; }
    }
}
struct ScanRaw { u32x2 r, k, v, rp, kp, vp, w, a; };
__device__ __forceinline__ void scan_raw_load(ScanRaw& o, const bf16* __restrict__ pr, const bf16* __restrict__ g1, bool first) {
    o.r = *(const u32x2*)(pr); o.k = *(const u32x2*)(pr + 512); o.v = *(const u32x2*)(pr + 1024); o.w = *(const u32x2*)(g1); o.a = *(const u32x2*)(g1 + 512);
    if (!first) { o.rp = *(const u32x2*)(pr - EIN); o.kp = *(const u32x2*)(pr - EIN + 512); o.vp = *(const u32x2*)(pr - EIN + 1024); }
    else { o.rp = (u32x2){0u, 0u}; o.kp = (u32x2){0u, 0u}; o.vp = (u32x2){0u, 0u}; }
}
__device__ __forceinline__ float row16_sum(float v) { v += __shfl_xor(v, 1); v += __shfl_xor(v, 2); v += __shfl_xor(v, 4); v += __shfl_xor(v, 8); return v; }
__device__ __forceinline__ float scan_produce(const ScanRaw& x, const LAS unsigned char* prm, LAS unsigned char* rec4, LAS unsigned char* rec2, int c4) {
    const f32x4 mur = LDS4(prm + c4 * 16), muk = LDS4(prm + 256 + c4 * 16), muv = LDS4(prm + 512 + c4 * 16), w0 = LDS4(prm + 768 + c4 * 16), a0 = LDS4(prm + 1024 + c4 * 16);
    const f32x4 kkw = LDS4(prm + 1280 + c4 * 16), kaw = LDS4(prm + 1536 + c4 * 16), rkw = LDS4(prm + 1792 + c4 * 16);
    f32x4 r, v, dec, kk, bb, k2; float n2 = 0.f, bon = 0.f;
#pragma unroll
    for (int e = 0; e < 4; ++e) { const int p = e >> 1, od = e & 1;
#define UNP_(L) (od ? bfhi(p ? x.L.y : x.L.x) : bflo(p ? x.L.y : x.L.x))
        const float r0 = UNP_(r), k0 = UNP_(k), v0 = UNP_(v), rp = UNP_(rp), kp = UNP_(kp), vp = UNP_(vp), wpre = UNP_(w), apre = UNP_(a);
#undef UNP_
        r[e] = r0 + (rp - r0) * mur[e]; const float k = k0 + (kp - k0) * muk[e]; v[e] = v0 + (vp - v0) * muv[e];
        const float z = w0[e] + wpre;
        dec[e] = __expf(-0.6065306597126334f * sigmoidf_(z));
        const float av = sigmoidf_(a0[e] + apre);
        kk[e] = k * kkw[e]; n2 += kk[e] * kk[e];
        k2[e] = k * (1.0f + (av - 1.0f) * kaw[e]);
        bb[e] = av;
        bon += r[e] * k2[e] * rkw[e];
    }
    n2 = row16_sum(n2); bon = row16_sum(bon);
    const float inv = 1.0f / fmaxf(sqrtf(n2), 1e-12f);
#pragma unroll
    for (int e = 0; e < 4; ++e) { kk[e] *= inv; bb[e] *= kk[e]; }
    *(LAS f32x4*)(rec4 + c4 * 16) = dec; *(LAS f32x4*)(rec4 + 256 + c4 * 16) = kk; *(LAS f32x4*)(rec4 + 512 + c4 * 16) = bb; *(LAS f32x4*)(rec4 + 768 + c4 * 16) = k2;
    *(LAS f32x4*)(rec2 + c4 * 16) = r; *(LAS f32x4*)(rec2 + 256 + c4 * 16) = v;
    return bon;
}
__device__ __forceinline__ void phase5f(const Ctx& c, const Args& a, float* __restrict__ YZ) {
    float* PL = (float*)(c.ws + WS_PL); float* __restrict__ BS = (float*)(c.ws + WS_BS);
    const bf16* __restrict__ P = (const bf16*)(c.ws + WS_PROJ); const bf16* __restrict__ G1 = (const bf16*)(c.ws + WS_G1);
    const int tk = c.wave >> 1, half = c.wave & 1, rg = c.lane >> 3, q = c.lane & 7, tl = c.lane >> 4, c4 = c.lane & 15;
    LAS unsigned char* prm = c.lds + 2 * SC_BUF_BYTES + tk * 2048;
    for (int tg = c.bx; tg < 256; tg += c.G) {
        const int task0 = tg * 4, task = task0 + tk, bh = task >> 6, chunk = task & 63, hd = bh & 7;
        const size_t mrow0 = (size_t)(bh >> 3) * T + chunk * 128;
        const bf16* pr0 = P + (mrow0 + 4 * half + tl) * EIN + 1024 + hd * 64 + 4 * c4; const bf16* g10 = G1 + (mrow0 + 4 * half + tl) * 1536 + hd * 64 + 4 * c4;
        float* bsp = BS + (mrow0 + 4 * half + tl) * 8 + hd;
        f32x2 Sp[4][4], Sl[4][4];
#pragma unroll
        for (int j = 0; j < 4; ++j)
#pragma unroll
            for (int i = 0; i < 4; ++i) { Sp[j][i] = (f32x2){(8 * q + 2 * i == 32 * half + 4 * rg + j) ? 1.f : 0.f, (8 * q + 2 * i + 1 == 32 * half + 4 * rg + j) ? 1.f : 0.f}; Sl[j][i] = (f32x2){0.f, 0.f}; }
        {
            const int arr = 4 * half + tl; const int cc = hd * 64 + 4 * c4;
            const float* src = arr == 0 ? INF(I_MU) + cc : arr == 1 ? INF(I_MU) + 512 + cc : arr == 2 ? INF(I_MU) + 1024 + cc : arr == 3 ? INF(I_W0) + cc : arr == 4 ? INF(I_A0) + cc : arr == 5 ? INF(I_KK) + cc : arr == 6 ? INF(I_KA) + cc : INF(I_RK) + cc;
            *(LAS f32x4*)(prm + arr * 256 + c4 * 16) = *(const f32x4*)src; }
        ScanRaw raw; scan_raw_load(raw, pr0, g10, chunk == 0 && half == 0 && tl == 0);
        __syncthreads();
        { const float bon = scan_produce(raw, prm, c.lds + tk * SC_TASK_BYTES + (4 * half + tl) * 1024, c.lds + tk * SC_TASK_BYTES + 8192 + (4 * half + tl) * 512, c4); if (c4 == 0) bsp[0] = bon; }
        scan_raw_load(raw, pr0 + (size_t)8 * EIN, g10 + (size_t)8 * 1536, false);
        __syncthreads();
#pragma unroll 1
        for (int s = 0; s < 16; ++s) {
            if (s + 1 < 16) { LAS unsigned char* nb = c.lds + ((s + 1) & 1) * SC_BUF_BYTES + tk * SC_TASK_BYTES;
                const float bon = scan_produce(raw, prm, nb + (4 * half + tl) * 1024, nb + 8192 + (4 * half + tl) * 512, c4); if (c4 == 0) bsp[(size_t)(s + 1) * 64] = bon;
                if (s + 2 < 16) scan_raw_load(raw, pr0 + (size_t)(s + 2) * 8 * EIN, g10 + (size_t)(s + 2) * 8 * 1536, false); }
            const LAS unsigned char* base = c.lds + (s & 1) * SC_BUF_BYTES + tk * SC_TASK_BYTES;
            const LAS unsigned char* r4b = base + q * 32; const LAS unsigned char* r2rb = base + 8192 + q * 32; const LAS unsigned char* r2b = base + 8192 + 256 + (32 * half + 4 * rg) * 4;
            float* yzp = YZ + ((size_t)((task0 + tk) >> 6) * T + ((task0 + tk) & 63) * 128 + s * SC_STEPS) * 128 + 32 * half + 4 * rg;
            ScanOps5 cur, nxt; scan_load5(cur, r4b, r2rb, r2b);
#pragma unroll 2
            for (int st = 0; st < SC_STEPS; ++st) {
                if (st + 1 < SC_STEPS) scan_load5(nxt, r4b + (st + 1) * 1024, r2rb + (st + 1) * 512, r2b + (st + 1) * 512);
                __builtin_amdgcn_sched_barrier(0);
                const f32x2 w2[4] = {cur.w[0].xy, cur.w[0].zw, cur.w[1].xy, cur.w[1].zw}, kk2[4] = {cur.kk[0].xy, cur.kk[0].zw, cur.kk[1].xy, cur.kk[1].zw};
                const f32x2 bb2[4] = {cur.bb[0].xy, cur.bb[0].zw, cur.bb[1].xy, cur.bb[1].zw}, kp2[4] = {cur.kp[0].xy, cur.kp[0].zw, cur.kp[1].xy, cur.kp[1].zw};
                float sp[4], sl[4];
#pragma unroll
                for (int j = 0; j < 4; ++j) { f32x2 a0 = Sp[j][0] * kk2[0], a1 = Sl[j][0] * kk2[0];
#pragma unroll
                    for (int i = 1; i < 4; ++i) { a0 = __builtin_elementwise_fma(Sp[j][i], kk2[i], a0); a1 = __builtin_elementwise_fma(Sl[j][i], kk2[i], a1); }
                    sp[j] = -oct_sum(a0.x + a0.y); sl[j] = -oct_sum(a1.x + a1.y); }
#pragma unroll
                for (int j = 0; j < 4; ++j) { const f32x2 vj = {cur.vv[j], cur.vv[j]}, spj = {sp[j], sp[j]}, slj = {sl[j], sl[j]};
#pragma unroll
                    for (int i = 0; i < 4; ++i) { Sp[j][i] = __builtin_elementwise_fma(Sp[j][i], w2[i], spj * bb2[i]);
                        Sl[j][i] = __builtin_elementwise_fma(Sl[j][i], w2[i], __builtin_elementwise_fma(slj, bb2[i], vj * kp2[i])); } }
                { const f32x2 rr2[4] = {cur.rr[0].xy, cur.rr[0].zw, cur.rr[1].xy, cur.rr[1].zw}; f32x4 yv, zv;
#pragma unroll
                  for (int j = 0; j < 4; ++j) { f32x2 a0 = Sp[j][0] * rr2[0], a1 = Sl[j][0] * rr2[0];
#pragma unroll
                      for (int i = 1; i < 4; ++i) { a0 = __builtin_elementwise_fma(Sp[j][i], rr2[i], a0); a1 = __builtin_elementwise_fma(Sl[j][i], rr2[i], a1); }
                      yv[j] = oct_sum(a0.x + a0.y); zv[j] = oct_sum(a1.x + a1.y); }
                  if (q == 0) { *(f32x4*)(yzp + (size_t)st * 128) = yv; *(f32x4*)(yzp + (size_t)st * 128 + 64) = zv; } }
                __builtin_amdgcn_sched_barrier(0);
                if (st + 1 < SC_STEPS) cur = nxt;
            }
            __syncthreads();
        }
        float* o = PL + (size_t)(task0 + tk) * 8192 + (32 * half + 4 * rg) * 64 + 8 * q;
#pragma unroll
        for (int j = 0; j < 4; ++j) {
            *(f32x4*)(o + j * 64) = (f32x4){Sp[j][0].x, Sp[j][0].y, Sp[j][1].x, Sp[j][1].y}; *(f32x4*)(o + j * 64 + 4) = (f32x4){Sp[j][2].x, Sp[j][2].y, Sp[j][3].x, Sp[j][3].y};
            *(f32x4*)(o + 4096 + j * 64) = (f32x4){Sl[j][0].x, Sl[j][0].y, Sl[j][1].x, Sl[j][1].y}; *(f32x4*)(o + 4096 + j * 64 + 4) = (f32x4){Sl[j][2].x, Sl[j][2].y, Sl[j][3].x, Sl[j][3].y}; }
    }
}
__device__ __forceinline__ void dma16(const void* gsrc, unsigned lds_dst) { unsigned keep;
    asm volatile("s_mov_b32 %0, m0\n\ts_mov_b32 m0, %2\n\ts_nop 0\n\tglobal_load_lds_dwordx4 %1, off\n\ts_mov_b32 m0, %0" : "=&s"(keep) : "v"(gsrc), "s"(lds_dst) : "memory"); }
__device__ __forceinline__ void dma4(const void* gsrc, unsigned lds_dst) { unsigned keep;
    asm volatile("s_mov_b32 %0, m0\n\ts_mov_b32 m0, %2\n\ts_nop 0\n\tglobal_load_lds_dword %1, off\n\ts_mov_b32 m0, %0" : "=&s"(keep) : "v"(gsrc), "s"(lds_dst) : "memory"); }
__device__ __forceinline__ void phase6(const Ctx& c, const Args& a) {
    const float* __restrict__ PL = (const float*)(c.ws + WS_PL); float* __restrict__ SI = (float*)(c.ws + WS_SINIT);
    constexpr int NB6 = 5, SLOT6 = 16384 + 4096, SB_OFF = NB6 * SLOT6, SB_BYTES = 16 * 65 * 4;
    for (int blk = c.bx; blk < 96; blk += c.G) {
        if (blk < 64) {
            const int bh = blk >> 2, rg = blk & 3;
            const unsigned lds0 = (unsigned)(uintptr_t)c.lds;
            const float* Pb = PL + (size_t)(bh * 64) * 8192;
            const int hw = c.wave - 4, nt = c.wave, j = c.lane & 15, q = c.lane >> 4;
#define P6_ISSUE(cc, slot) do { const float* pc_ = Pb + (size_t)(cc) * 8192; const unsigned d_ = lds0 + (unsigned)(slot) * SLOT6; \
            _Pragma("unroll") for (int i_ = 0; i_ < 4; ++i_) dma16(pc_ + (4 * hw + i_) * 256 + c.lane * 4, (unsigned)__builtin_amdgcn_readfirstlane(d_ + (4 * hw + i_) * 1024)); \
            dma16(pc_ + 4096 + (16 * rg) * 64 + hw * 256 + c.lane * 4, (unsigned)__builtin_amdgcn_readfirstlane(d_ + 16384 + hw * 1024)); } while (0)
            asm volatile("s_waitcnt vmcnt(0) lgkmcnt(0)\n\ts_barrier" ::: "memory");
            if (c.wave >= 4) {
#pragma unroll
                for (int cc = 0; cc < NB6 - 1; ++cc) P6_ISSUE(cc, cc);
            } else {
#pragma unroll
                for (int r = 0; r < 4; ++r) *(LAS float*)(c.lds + SB_OFF + ((4 * q + r) * 65 + 16 * nt + j) * 4) = 0.f;
            }
            f32x4 st = {0.f, 0.f, 0.f, 0.f};
            int slot = 0, islot = NB6 - 1;
#pragma unroll 1
            for (int cc = 0; cc < 64; ++cc) {
                if (c.wave >= 4) asm volatile("s_waitcnt vmcnt(15)" ::: "memory");
                asm volatile("s_waitcnt lgkmcnt(0)\n\ts_barrier" ::: "memory");
                if (c.wave >= 4) { const int nc = cc + NB6 - 1 < 64 ? cc + NB6 - 1 : 63; P6_ISSUE(nc, islot); }
                else {
                    float* sip = SI + ((size_t)(bh * 64 + cc) * 64 + 16 * rg + 4 * q) * 64 + 16 * nt + j;
#pragma unroll
                    for (int r = 0; r < 4; ++r) sip[r * 64] = st[r];
                    const LAS unsigned char* sl = c.lds + slot * SLOT6;
                    const LAS unsigned char* sa = c.lds + SB_OFF + (cc & 1) * SB_BYTES + (j * 65 + q) * 4;
                    const LAS unsigned char* sb = sl + (q * 64 + 16 * nt + j) * 4;
                    f32x4 a0, a1 = {0.f, 0.f, 0.f, 0.f};
#pragma unroll
                    for (int r = 0; r < 4; ++r) a0[r] = *(const LAS float*)(sl + 16384 + ((4 * q + r) * 64 + 16 * nt + j) * 4);
#pragma unroll
                    for (int ks = 0; ks < 16; ks += 2) {
                        a0 = __builtin_amdgcn_mfma_f32_16x16x4f32(*(const LAS float*)(sa + ks * 16), *(const LAS float*)(sb + ks * 1024), a0, 0, 0, 0);
                        a1 = __builtin_amdgcn_mfma_f32_16x16x4f32(*(const LAS float*)(sa + (ks + 1) * 16), *(const LAS float*)(sb + (ks + 1) * 1024), a1, 0, 0, 0); }
                    st = a0 + a1;
#pragma unroll
                    for (int r = 0; r < 4; ++r) *(LAS float*)(c.lds + SB_OFF + ((cc + 1) & 1) * SB_BYTES + ((4 * q + r) * 65 + 16 * nt + j) * 4) = st[r];
                }
                slot = slot + 1 == NB6 ? 0 : slot + 1; islot = islot + 1 == NB6 ? 0 : islot + 1;
            }
            asm volatile("s_waitcnt vmcnt(0) lgkmcnt(0)\n\ts_barrier" ::: "memory");
#undef P6_ISSUE
        } else {
            const int q6 = blk - 64, b = q6 >> 4, chl = c.tid & 31, ch = (q6 & 15) * 32 + chl, seg = c.tid >> 5;
            const float* __restrict__ LSA = (const float*)(c.ws + WS_LSA); const float* __restrict__ LSH = (const float*)(c.ws + WS_LSH); float* __restrict__ LC = (float*)(c.ws + WS_LC);
            const unsigned t0 = (unsigned)(b * 512 + seg * 32) * 512u + (unsigned)ch;
            float sa[32], sh[32];
#pragma unroll
            for (int i = 0; i < 32; ++i) { sa[i] = __expf(LSA[t0 + (unsigned)i * 512u]); sh[i] = LSH[t0 + (unsigned)i * 512u]; }
            float A = 1.f, H = 0.f;
#pragma unroll
            for (int i = 0; i < 32; ++i) { H = sa[i] * H + sh[i]; A *= sa[i]; }
            LAS float* ex = (LAS float*)c.lds;
            asm volatile("s_waitcnt lgkmcnt(0)\n\ts_barrier" ::: "memory");
            ex[(seg * 32 + chl) * 2] = A; ex[(seg * 32 + chl) * 2 + 1] = H;
            asm volatile("s_waitcnt lgkmcnt(0)\n\ts_barrier" ::: "memory");
            float h = 0.f;
            for (int s2 = 0; s2 < seg; ++s2) h = ex[(s2 * 32 + chl) * 2] * h + ex[(s2 * 32 + chl) * 2 + 1];
#pragma unroll
            for (int i = 0; i < 32; ++i) { LC[t0 + (unsigned)i * 512u] = h; h = sa[i] * h + sh[i]; }
            asm volatile("s_waitcnt lgkmcnt(0)\n\ts_barrier" ::: "memory");
        }
    }
    if (c.G > P6_BUSY && c.bx >= P6_BUSY) { const int gw6 = (c.bx - P6_BUSY) * NWAVES + c.wave, ngw6 = (c.G - P6_BUSY) * NWAVES; convert_rest(c, a, gw6, ngw6); moe_convert(c, a, 0, 0, P6_MOE_E, gw6, ngw6); if (P6_MOE_U > 0) moe_convert(c, a, 1, 0, P6_MOE_U, gw6, ngw6); }
}
__device__ __forceinline__ void phase7(const Ctx& c, const float* __restrict__ YZ) {
    const float* __restrict__ SI = (const float*)(c.ws + WS_SINIT); float* __restrict__ OR = (float*)(c.ws + WS_ORAW);
    LAS float* Yl = (LAS float*)c.lds;
    const int v = c.tid & 63, tq = c.wave;
    for (int task = c.bx; task < 1024; task += c.G) {
        const int bh = task >> 6, cc = task & 63; const size_t tb = (size_t)bh * T + cc * 128;
        LAS float* Sl = Yl + 16384;
#pragma unroll
        for (int i = 0; i < 2; ++i) { const int idx = c.tid + 512 * i, row = idx >> 4, c4 = idx & 15; *(LAS f32x4*)(Sl + row * 68 + 4 * c4) = *(const f32x4*)(SI + ((size_t)task * 64 + row) * 64 + 4 * c4); }
#pragma unroll
        for (int i = 0; i < 4; ++i) { const int idx = c.tid + 512 * i, tt = idx >> 4, c4 = idx & 15; *(LAS f32x4*)(Yl + tt * 64 + 4 * c4) = *(const f32x4*)(YZ + (tb + tt) * 128 + 4 * c4); }
#pragma unroll
        for (int i = 0; i < 4; ++i) { const int idx = c.tid + 512 * i, tt = idx >> 4, c4 = idx & 15; *(LAS f32x4*)(Yl + 8192 + tt * 64 + 4 * c4) = *(const f32x4*)(YZ + (tb + tt) * 128 + 64 + 4 * c4); }
        __syncthreads();
        f32x4 sr[16];
#pragma unroll
        for (int i = 0; i < 16; ++i) sr[i] = *(const LAS f32x4*)(Sl + v * 68 + 4 * i);
        float* orow = OR + ((size_t)(bh >> 3) * T + cc * 128) * 512 + (bh & 7) * 64 + v;
#pragma unroll 2
        for (int i = 0; i < 16; ++i) { const int tt = 16 * tq + i; float acc = Yl[8192 + tt * 64 + v]; f32x4 a4 = {0.f, 0.f, 0.f, 0.f};
#pragma unroll
            for (int k4 = 0; k4 < 16; ++k4) { const f32x4 y4 = *(const LAS f32x4*)(Yl + tt * 64 + 4 * k4); a4 += sr[k4] * y4; }
            acc += (a4[0] + a4[1]) + (a4[2] + a4[3]);
            orow[(size_t)tt * 512] = acc; }
        __syncthreads();
    }
}
template <int MODE> __device__ __forceinline__ void phase8(const Ctx& c, const Args& a) {
    const bf16* __restrict__ P = (const bf16*)(c.ws + WS_PROJ); bf16* __restrict__ Y = (bf16*)(c.ws + WS_Y);
    const float* __restrict__ OR = (const float*)(c.ws + WS_ORAW); const float* __restrict__ BS = (const float*)(c.ws + WS_BS);
    const bf16* __restrict__ G1 = (const bf16*)(c.ws + WS_G1);
    const bf16* __restrict__ HL = (const bf16*)(c.ws + WS_LA); const bf16* __restrict__ CP = (const bf16*)(c.ws + WS_LU); const float* __restrict__ LC = (const float*)(c.ws + WS_LC);
    const int hd = c.lane >> 3, ch = 64 * hd + 8 * (c.lane & 7);
    float gw[8], gb[8], muv[8];
#pragma unroll
    for (int e = 0; e < 8; ++e) { gw[e] = INF(I_GNW)[ch + e]; gb[e] = INF(I_GNB)[ch + e]; muv[e] = INF(I_MU)[1024 + ch + e]; }
    for (int m = c.gw; m < M; m += c.ngw) { const int t = m & (T - 1);
        const f32x4 oa = *(const f32x4*)(OR + (size_t)m * 512 + ch), ob = *(const f32x4*)(OR + (size_t)m * 512 + ch + 4);
        const u32x4 vq = *(const u32x4*)(P + (size_t)m * EIN + 2048 + ch); u32x4 vpq = {0u, 0u, 0u, 0u}; if (t > 0) vpq = *(const u32x4*)(P + (size_t)(m - 1) * EIN + 2048 + ch);
        const float bon = BS[(size_t)m * 8 + hd];
        const u32x4 gq = *(const u32x4*)(G1 + (size_t)m * 1536 + 1024 + ch);
        const u32x4 hq = *(const u32x4*)(HL + (size_t)m * 512 + ch), cq = *(const u32x4*)(CP + (size_t)m * 512 + ch), lq = *(const u32x4*)(P + (size_t)m * EIN + 512 + ch);
        const f32x4 ca = *(const f32x4*)(LC + (size_t)(m >> 4) * 512 + ch), cb = *(const f32x4*)(LC + (size_t)(m >> 4) * 512 + ch + 4);
        float o[8] = {oa[0], oa[1], oa[2], oa[3], ob[0], ob[1], ob[2], ob[3]};
        float s = 0.f;
#pragma unroll
        for (int e = 0; e < 8; ++e) s += o[e];
        s += __shfl_xor(s, 1); s += __shfl_xor(s, 2); s += __shfl_xor(s, 4);
        const float mean = s * (1.0f / 64.0f); float q = 0.f;
#pragma unroll
        for (int e = 0; e < 8; ++e) { o[e] -= mean; q += o[e] * o[e]; }
        q += __shfl_xor(q, 1); q += __shfl_xor(q, 2); q += __shfl_xor(q, 4);
        const float rstd = rsqrtf(q * (1.0f / 64.0f) + 64e-5f);
        float v[8]; { float v0[8], vp[8]; unpack8(vq, v0); unpack8(vpq, vp);
#pragma unroll
            for (int e = 0; e < 8; ++e) v[e] = v0[e] + (vp[e] - v0[e]) * muv[e]; }
        float g[8]; unpack8(gq, g);
        float y[8];
#pragma unroll
        for (int e = 0; e < 8; ++e) y[e] = (o[e] * rstd * gw[e] + gb[e] + bon * v[e]) * g[e];
        *(u32x4*)(Y + (size_t)m * 1024 + 512 + ch) = pack8(y);
        float hl[8], cp[8], lg[8]; unpack8(hq, hl); unpack8(cq, cp); unpack8(lq, lg);
        const float lc[8] = {ca[0], ca[1], ca[2], ca[3], cb[0], cb[1], cb[2], cb[3]};
#pragma unroll
        for (int e = 0; e < 8; ++e) y[e] = gelu_tanh(lg[e]) * (hl[e] + cp[e] * lc[e]);
        *(u32x4*)(Y + (size_t)m * 1024 + ch) = pack8(y);
    }
}
__device__ __forceinline__ void phase15(const Ctx& c, const Args& a) {
    bf16* Q = (bf16*)(c.ws + WS_Q); bf16* Kb = (bf16*)(c.ws + WS_K); const int* pos = (const int*)a.in[I_POS];
    const int d0 = 16 * (c.lane & 3);
    float qg[16], kg[16];
#pragma unroll
    for (int e = 0; e < 16; ++e) { qg[e] = INF(I_QNORM)[d0 + e] * (0.125f*1.4426950408889634f); kg[e] = INF(I_KNORM)[d0 + e]; }
    const float inv_l = powf(500000.0f, -(float)(2 * (c.lane & 7)) / 16.0f);
    for (int m = c.gw; m < M; m += c.ngw) {
        const float p = (float)pos[m];
        float cs[8], sn[8];
        { float sl, cl; sincosf(p * inv_l, &sl, &cl);
#pragma unroll
          for (int i = 0; i < 8; ++i) { cs[i] = __builtin_bit_cast(float, __builtin_amdgcn_readlane(__builtin_bit_cast(int, cl), i)); sn[i] = __builtin_bit_cast(float, __builtin_amdgcn_readlane(__builtin_bit_cast(int, sl), i)); } }
#pragma unroll
        for (int which = 0; which < 2; ++which) {
            bf16* row = (which ? Kb : Q) + (size_t)m * 1024 + 16 * c.lane;
            float x[16]; { float lo[8], hi[8]; unpack8(*(const u32x4*)row, lo); unpack8(*(const u32x4*)(row + 8), hi);
#pragma unroll
                for (int e = 0; e < 8; ++e) { x[e] = lo[e]; x[8 + e] = hi[e]; } }
            float s = 0.f;
#pragma unroll
            for (int e = 0; e < 16; ++e) s += x[e] * x[e];
            s += __shfl_xor(s, 1); s += __shfl_xor(s, 2);
            const float r = rsqrtf(s * (1.0f / 64.0f) + 1e-6f);
#pragma unroll
            for (int e = 0; e < 16; ++e) x[e] = x[e] * r * (which ? kg[e] : qg[e]);
            if ((c.lane & 3) == 0) {
#pragma unroll
                for (int i = 0; i < 8; ++i) { const float x1 = x[i], x2 = x[8 + i]; x[i] = x1 * cs[i] - x2 * sn[i]; x[8 + i] = x2 * cs[i] + x1 * sn[i]; } }
            float lo[8], hi[8];
#pragma unroll
            for (int e = 0; e < 8; ++e) { lo[e] = x[e]; hi[e] = x[8 + e]; }
            *(u32x4*)row = pack8(lo); *(u32x4*)(row + 8) = pack8(hi);
        }
    }
}
__device__ __forceinline__ void phase17(const Ctx& c, const Args& a) {
    const bf16* O0 = (const bf16*)(c.ws + WS_OA0); const bf16* O1 = (const bf16*)(c.ws + WS_OA1); bf16* AO = (bf16*)(c.ws + WS_AO);
    const float lam_init = 0.8f - 0.6f * 0.7408182206817179f;
    const float d1 = wave_sum(INF(I_LQ1)[c.lane] * INF(I_LK1)[c.lane]), d2 = wave_sum(INF(I_LQ2)[c.lane] * INF(I_LK2)[c.lane]);
    const float lam = __expf(d1) - __expf(d2) + lam_init;
    const int d0 = 16 * (c.lane & 7);
    float sg[16];
#pragma unroll
    for (int e = 0; e < 16; ++e) sg[e] = INF(I_SUBLN)[d0 + e] * (1.0f - lam_init);
    for (int m = c.gw; m < M; m += c.ngw) {
        const size_t off = (size_t)m * 1024 + 16 * c.lane;
        float x0[8], x1[8], y0[8], y1[8], d[16];
        unpack8(*(const u32x4*)(O0 + off), x0); unpack8(*(const u32x4*)(O0 + off + 8), x1); unpack8(*(const u32x4*)(O1 + off), y0); unpack8(*(const u32x4*)(O1 + off + 8), y1);
        float s = 0.f;
#pragma unroll
        for (int e = 0; e < 8; ++e) { d[e] = x0[e] - lam * y0[e]; d[8 + e] = x1[e] - lam * y1[e]; s += d[e] * d[e] + d[8 + e] * d[8 + e]; }
        s += __shfl_xor(s, 1); s += __shfl_xor(s, 2); s += __shfl_xor(s, 4);
        const float r = rsqrtf(s * (1.0f / 128.0f) + 1e-6f);
        float lo[8], hi[8];
#pragma unroll
        for (int e = 0; e < 8; ++e) { lo[e] = d[e] * r * sg[e]; hi[e] = d[8 + e] * r * sg[8 + e]; }
        *(u32x4*)(AO + off) = pack8(lo); *(u32x4*)(AO + off + 8) = pack8(hi);
    }
}
template <class XT> __device__ __forceinline__ void phase19(const Ctx& c, const Args& a, const XT* x3) {
    unsigned char* XNM = (unsigned char*)(c.ws + WS_XNM);       unsigned* cntw = (unsigned*)(c.ws + WS_CTL) + CW_CNT; int* LIST = (int*)(c.ws + WS_LIST); int* TOKI = (int*)(c.ws + WS_TOKI); float* TOKG = (float*)(c.ws + WS_TOKG);
    const float* g = INF(I_OLNFFN); const float* rt = INF(I_ROUTER);
    f32x4 gv[4]; f32x4 rw[4][4][2];
#pragma unroll
    for (int j = 0; j < 4; ++j) { gv[j] = ((const f32x4*)g)[c.lane + 64 * j];
#pragma unroll
        for (int i = 0; i < 4; ++i) { const float* rp = rt + (size_t)(256 * j + 4 * c.lane + i) * 8; rw[j][i][0] = *(const f32x4*)rp; rw[j][i][1] = *(const f32x4*)(rp + 4); } }
    for (int m = c.gw; m < M; m += c.ngw) {
        f32x4 v[4]; float s = 0.f;
#pragma unroll
        for (int j = 0; j < 4; ++j) { v[j] = ld_x4(x3 + (size_t)m * D, c.lane + 64 * j); s += (v[j].x * v[j].x + v[j].y * v[j].y) + (v[j].z * v[j].z + v[j].w * v[j].w); }
        const float r = rsqrtf(wave_sum(s) * (1.0f / 1024.0f) + 1e-6f);
        f32x4 l0 = {0.f, 0.f, 0.f, 0.f}, l1 = {0.f, 0.f, 0.f, 0.f};
#pragma unroll
        for (int j = 0; j < 4; ++j) { const f32x4 o = v[j] * r * gv[j];
            ((unsigned*)(XNM + (size_t)m * D))[c.lane + 64 * j] = pg8::pk4_fp8(o.x, o.y, o.z, o.w);
#pragma unroll
            for (int i = 0; i < 4; ++i) { l0 += rw[j][i][0] * o[i]; l1 += rw[j][i][1] * o[i]; } }
        float lg[8];
#pragma unroll
        for (int e = 0; e < 4; ++e) { lg[e] = wave_sum(l0[e]); lg[4 + e] = wave_sum(l1[e]); }
        int i1 = 0; float v1 = lg[0];
#pragma unroll
        for (int e = 1; e < 8; ++e) if (lg[e] > v1) { v1 = lg[e]; i1 = e; }
        int i2 = (i1 + 1) & 7; float v2 = -INFINITY;
#pragma unroll
        for (int e = 0; e < 8; ++e) if (e != i1 && lg[e] > v2) { v2 = lg[e]; i2 = e; }
        if (c.lane == 0) {
            const float g2 = 1.0f / (1.0f + __expf(v1 - v2)), g1 = 1.0f - g2;
            const int s1 = (int)__hip_atomic_fetch_add(cntw + 64 * i1, 1u, __ATOMIC_RELAXED, __HIP_MEMORY_SCOPE_AGENT);
            const int s2 = (int)__hip_atomic_fetch_add(cntw + 64 * i2, 1u, __ATOMIC_RELAXED, __HIP_MEMORY_SCOPE_AGENT);
            LIST[i1 * 16384 + s1] = m; LIST[i2 * 16384 + s2] = m;
            *(int4*)(TOKI + (size_t)m * 4) = make_int4(i1, s1, i2, s2); *(f32x2*)(TOKG + (size_t)m * 2) = (f32x2){g1, g2};
        }
    }
}
template <class XT> __device__ __forceinline__ void phase22(const Ctx& c, const XT* x3, float* out) {
    const bf16* Y2 = (const bf16*)(c.ws + WS_Y2); unsigned* cntw = (unsigned*)(c.ws + WS_CTL) + CW_CNT; const int* TOKI = (const int*)(c.ws + WS_TOKI); const float* TOKG = (const float*)(c.ws + WS_TOKG);
    int toff[8]; { int acc = 0;
#pragma unroll
        for (int e = 0; e < 8; ++e) { toff[e] = acc; acc += ((int)__hip_atomic_load(cntw + 64 * e, __ATOMIC_RELAXED, __HIP_MEMORY_SCOPE_AGENT) + 255) >> 8; } }
    for (int m = c.gw; m < M; m += c.ngw) {
        int4 ti; f32x2 tg;
        ti.x = __hip_atomic_load(TOKI + (size_t)m * 4 + 0, __ATOMIC_RELAXED, __HIP_MEMORY_SCOPE_AGENT); ti.y = __hip_atomic_load(TOKI + (size_t)m * 4 + 1, __ATOMIC_RELAXED, __HIP_MEMORY_SCOPE_AGENT);
        ti.z = __hip_atomic_load(TOKI + (size_t)m * 4 + 2, __ATOMIC_RELAXED, __HIP_MEMORY_SCOPE_AGENT); ti.w = __hip_atomic_load(TOKI + (size_t)m * 4 + 3, __ATOMIC_RELAXED, __HIP_MEMORY_SCOPE_AGENT);
        tg.x = __hip_atomic_load(TOKG + (size_t)m * 2 + 0, __ATOMIC_RELAXED, __HIP_MEMORY_SCOPE_AGENT); tg.y = __hip_atomic_load(TOKG + (size_t)m * 2 + 1, __ATOMIC_RELAXED, __HIP_MEMORY_SCOPE_AGENT);
        int b1 = 0, b2 = 0;
#pragma unroll
        for (int e = 0; e < 8; ++e) { if (ti.x == e) b1 = toff[e]; if (ti.z == e) b2 = toff[e]; }
        const bf16* y1 = Y2 + (size_t)(b1 * 256 + ti.y) * 1024; const bf16* y2 = Y2 + (size_t)(b2 * 256 + ti.w) * 1024;
#pragma unroll
        for (int j = 0; j < 4; ++j) { const u32x2 w1 = ((const u32x2*)y1)[c.lane + 64 * j], w2 = ((const u32x2*)y2)[c.lane + 64 * j];
            f32x4* op = (f32x4*)(out + (size_t)m * D) + c.lane + 64 * j; f32x4 o = ld_x4(x3 + (size_t)m * D, c.lane + 64 * j);
            o.x += tg.x * bflo(w1.x) + tg.y * bflo(w2.x); o.y += tg.x * bfhi(w1.x) + tg.y * bfhi(w2.x); o.z += tg.x * bflo(w1.y) + tg.y * bflo(w2.y); o.w += tg.x * bfhi(w1.y) + tg.y * bfhi(w2.y);
            *op = o; }
    }
}

__global__ void __launch_bounds__(NTHR, 2) fwd(Args a) {
    extern __shared__ __attribute__((aligned(16))) unsigned char lds_raw[];
    Ctx c; c.lds = (LAS unsigned char*)lds_raw; c.ws = a.ws;
    c.tid = threadIdx.x; c.lane = c.tid & 63; c.wave = __builtin_amdgcn_readfirstlane(c.tid >> 6);
    c.G = gridDim.x; c.bx = blockIdx.x; c.vcu = (c.G % 8 == 0) ? (c.bx % 8) * (c.G / 8) + c.bx / 8 : c.bx;
    c.gw = c.vcu * NWAVES + c.wave; c.ngw = c.G * NWAVES;
    volatile LAS unsigned* MISC = (volatile LAS unsigned*)(c.lds + MISC_OFF);
    for (int u = c.tid; u < (LDS_BYTES - RING_BYTES) / 4; u += NTHR) ((LAS unsigned*)(c.lds + RING_BYTES))[u] = 0u;
    __syncthreads();
    unsigned* ctl = (unsigned*)(a.ws + WS_CTL);
    const int lo = a.ph_lo, hi = a.ph_hi;
    XcdBarrier bar; bar.bar = ctl + CW_BAR; bar.x = 0; bar.st = MISC + 8;
    unsigned bar_gen = 0u; (void)bar_gen;
    if (FLAT_BAR != 1 && hi - lo > 1) bar = xcd_barrier_post(ctl + CW_BAR, MISC + 8);
#ifndef PHMASK
#define PHMASK 0x7fffffu
#endif
#define IN(k) ((((PHMASK) >> (k)) & 1u) && lo <= (k) && (k) < hi)
#ifndef REPMASK
#define REPMASK 0u
#endif
#if PROBE_BUILD
#define NREP(k) ((((REPMASK) >> (k)) & 1u) ? ((int)((a.repmask >> (k)) & 1u) + 1) : 1)
#else
#define NREP(k) 1
#endif
#define SEAM(k) do { if (IN(k) && IN((k) + 1)) { GRID_BARRIER(bar); } } while (0)
    float* out = a.out; unsigned char* ws = a.ws;
    bf16* XN = (bf16*)(ws + WS_XN); bf16* XR = (bf16*)(ws + WS_XR);

    if (IN(0)) {
#pragma unroll 1
        for (int rep_ = 0; rep_ < NREP(0); ++rep_) { { phase0(c, a); }
        if (rep_ + 1 < NREP(0)) GRID_BARRIER(bar); } }
    SEAM(0);
    if (IN(1)) {
#pragma unroll 1
        for (int rep_ = 0; rep_ < NREP(1); ++rep_) { { { pg8::Gemm g{XN, (const bf16*)(ws + WS_WIN), D, 0}; pg8::StaticOrder S; S.init(M, EIN, c.G, c.bx); pg8::EpiStore E{(bf16*)(ws + WS_PROJ), EIN, 0, 0};
        pg8::gemm_phase<pg8::EpiStore, pg8::StaticOrder, false>(c.lds, g, S, E); } }
        if (rep_ + 1 < NREP(1)) GRID_BARRIER(bar); } }
    SEAM(1);
    if (IN(2)) {
#pragma unroll 1
        for (int rep_ = 0; rep_ < NREP(2); ++rep_) { { phase2(c, a); }
        if (rep_ + 1 < NREP(2)) GRID_BARRIER(bar); } }
    SEAM(2);
    if (IN(3)) {
#pragma unroll 1
        for (int rep_ = 0; rep_ < NREP(3); ++rep_) { { {
        { pg8::Gemm g{(const bf16*)(ws + WS_A2), (const bf16*)(ws + WS_B2T), 128, 0, 256}; pg8::StaticOrderT<1> S; S.init(M, 1536, c.G, c.bx); pg8::EpiStore E{(bf16*)(ws + WS_G1), 1536, 0, 0};
          pg8::gemm_phase<pg8::EpiStore, pg8::StaticOrderT<1>, false>(c.lds, g, S, E); }
        { pg8::Gemm g{(const bf16*)(ws + WS_XC), (const bf16*)(ws + WS_BLRU), 256, 0, 512}; pg8::StaticOrderT<2> S; S.init(M, 1024, c.G, c.bx); pg8::EpiStore E{(bf16*)(ws + WS_G2), 1024, 0, 0};
          pg8::gemm_phase<pg8::EpiStore, pg8::StaticOrderT<2>, false>(c.lds, g, S, E); } } }
        if (rep_ + 1 < NREP(3)) GRID_BARRIER(bar); } }
    SEAM(3);
#if defined(PROBE_P4MODE)
    if (IN(4)) { phase4<PROBE_P4MODE>(c, a); GRID_BARRIER(bar); }
#endif
    if (IN(4)) {
#pragma unroll 1
        for (int rep_ = 0; rep_ < NREP(4); ++rep_) { { }
        if (rep_ + 1 < NREP(4)) GRID_BARRIER(bar); } }
#if defined(PROBE_P5MODE)
    if (IN(5)) { phase5<PROBE_P5MODE>(c, out); GRID_BARRIER(bar); }
#endif
    if (IN(5)) {
#pragma unroll 1
        for (int rep_ = 0; rep_ < NREP(5); ++rep_) { { phase4<2>(c, a); phase5f(c, a, out); }
        if (rep_ + 1 < NREP(5)) GRID_BARRIER(bar); } }
    SEAM(5);
#if defined(PROBE_P6)
    if (IN(6)) { phase6(c, a); GRID_BARRIER(bar); }
#endif
    if (IN(6)) {
#pragma unroll 1
        for (int rep_ = 0; rep_ < NREP(6); ++rep_) { { phase6(c, a); }
        if (rep_ + 1 < NREP(6)) GRID_BARRIER(bar); } }
    SEAM(6);
    if (IN(7)) {
#pragma unroll 1
        for (int rep_ = 0; rep_ < NREP(7); ++rep_) { { phase7(c, out); }
        if (rep_ + 1 < NREP(7)) GRID_BARRIER(bar); } }
    SEAM(7);
#if defined(PROBE_P8MODE)
    if (IN(8)) { phase8<PROBE_P8MODE>(c, a); GRID_BARRIER(bar); }
#endif
    if (IN(8)) {
#pragma unroll 1
        for (int rep_ = 0; rep_ < NREP(8); ++rep_) { { phase8<0>(c, a); }
        if (rep_ + 1 < NREP(8)) GRID_BARRIER(bar); } }
    SEAM(8);
    if (IN(9)) {
#pragma unroll 1
        for (int rep_ = 0; rep_ < NREP(9); ++rep_) { { { pg8::Gemm g{(const bf16*)(ws + WS_Y), (const bf16*)(ws + WS_WOUT), D, 0}; pg8::StaticOrder S; S.init(M, D, c.G, c.bx); pg8::EpiResidB E{INF(I_X), nullptr, XR, D, (float*)(ws + WS_RS1)};
        pg8::gemm_phase<pg8::EpiResidB, pg8::StaticOrder, false>(c.lds, g, S, E); } }
        if (rep_ + 1 < NREP(9)) GRID_BARRIER(bar); } }
    SEAM(9);
    if (IN(10)) {
#pragma unroll 1
        for (int rep_ = 0; rep_ < NREP(10); ++rep_) { { }
        if (rep_ + 1 < NREP(10)) GRID_BARRIER(bar); } }
    if (IN(11)) {
#pragma unroll 1
        for (int rep_ = 0; rep_ < NREP(11); ++rep_) { { { pg8::Gemm g{XR, (const bf16*)(ws + WS_WGU), D, 0}; pg8::StaticOrder S; S.init(M, 2 * FFN, c.G, c.bx); pg8::RowScaled<pg8::EpiSwiGLU> E{{(bf16*)(ws + WS_PROJ), FFN}, (const float*)(ws + WS_RS1)};
        pg8::gemm_phase<pg8::RowScaled<pg8::EpiSwiGLU>, pg8::StaticOrder, false>(c.lds, g, S, E);
        if (c.G == 256 && c.bx >= 128) moe_convert(c, a, 1, 0, P11_MOE_U, (c.bx - 128) * NWAVES + c.wave, 128 * NWAVES); } }
        if (rep_ + 1 < NREP(11)) GRID_BARRIER(bar); } }
    SEAM(11);
    if (IN(12)) {
#pragma unroll 1
        for (int rep_ = 0; rep_ < NREP(12); ++rep_) { { { pg8::Gemm g{(const bf16*)(ws + WS_PROJ), (const bf16*)(ws + WS_WDN), FFN, 0}; pg8::StaticOrder S; S.init(M, D, c.G, c.bx); pg8::EpiResidB E{nullptr, XR, XR, D, (float*)(ws + WS_RS2)};
        pg8::gemm_phase<pg8::EpiResidB, pg8::StaticOrder, false>(c.lds, g, S, E); } }
        if (rep_ + 1 < NREP(12)) GRID_BARRIER(bar); } }
    SEAM(12);
    if (IN(13)) {
#pragma unroll 1
        for (int rep_ = 0; rep_ < NREP(13); ++rep_) { { }
        if (rep_ + 1 < NREP(13)) GRID_BARRIER(bar); } }
    if (IN(14)) {
#pragma unroll 1
        for (int rep_ = 0; rep_ < NREP(14); ++rep_) { { { pg8::Gemm g{XR, (const bf16*)(ws + WS_WQKV), D, 0}; pg8::StaticOrder S; S.init(M, 3072, c.G, c.bx); pg8::RowScaled<pg8::EpiStore> E{{(bf16*)(ws + WS_Q), D, 1024, (size_t)(WS_K - WS_Q) / 2}, (const float*)(ws + WS_RS2)};
        pg8::gemm_phase<pg8::RowScaled<pg8::EpiStore>, pg8::StaticOrder, false>(c.lds, g, S, E); } }
        if (rep_ + 1 < NREP(14)) GRID_BARRIER(bar); } }
    SEAM(14);
    if (IN(15)) {
#pragma unroll 1
        for (int rep_ = 0; rep_ < NREP(15); ++rep_) { { { phase15(c, a); moe_convert(c, a, 1, c.G == 256 ? P11_MOE_U : 0, NE); } }
        if (rep_ + 1 < NREP(15)) GRID_BARRIER(bar); } }
    SEAM(15);
    if (IN(16)) {
#pragma unroll 1
        for (int rep_ = 0; rep_ < NREP(16); ++rep_) { { { const attn_body::AttnTensors AT{(const attn_body::bf16*)(ws + WS_Q), (const attn_body::bf16*)(ws + WS_K), (const attn_body::bf16*)(ws + WS_V), (attn_body::bf16*)(ws + WS_OA0)};
        const attn_body::StaticOrder S((int)c.G, (int)blockIdx.x); attn_body::attn_phase<attn_body::StaticOrder>((char*)lds_raw, AT, S); } }
        if (rep_ + 1 < NREP(16)) GRID_BARRIER(bar); } }
    SEAM(16);
    if (IN(17)) {
#pragma unroll 1
        for (int rep_ = 0; rep_ < NREP(17); ++rep_) { { { phase17(c, a); moe_convert(c, a, 2, 0, P17_MOE_D); } }
        if (rep_ + 1 < NREP(17)) GRID_BARRIER(bar); } }
    SEAM(17);
    if (IN(18)) {
#pragma unroll 1
        for (int rep_ = 0; rep_ < NREP(18); ++rep_) { { { pg8::Gemm g{(const bf16*)(ws + WS_AO), (const bf16*)(ws + WS_WO), D, 0}; pg8::StaticOrder S; S.init(M, D, c.G, c.bx); pg8::EpiResidB E{nullptr, XR, XR, D, nullptr};
        pg8::gemm_phase<pg8::EpiResidB, pg8::StaticOrder, false>(c.lds, g, S, E); } }
        if (rep_ + 1 < NREP(18)) GRID_BARRIER(bar); } }
    SEAM(18);
    if (IN(19)) {
#pragma unroll 1
        for (int rep_ = 0; rep_ < NREP(19); ++rep_) { { phase19(c, a, XR); if (c.G > P6_BUSY) moe_convert(c, a, 0, P6_MOE_E, NE); else moe_convert(c, a, 0); }
        if (rep_ + 1 < NREP(19)) GRID_BARRIER(bar); } }
    SEAM(19);
#if defined(PROBE_P20)
    if (IN(20)) { { pg8::Gemm g{(const bf16*)(ws + WS_XNM), (const bf16*)(ws + WS_WGUM), D / 2, MOE_GU_E8M0}; pg8::MoeOrder S; S.init(ctl + CW_CNT, 2 * ED / 256, c.G, c.bx, (const int*)(ws + WS_LIST));
        pg8::EpiSwiGLU8 E{(unsigned char*)(ws + WS_HM2), ED, MOE_H_SCALE};
        pg8::gemm_phase<pg8::EpiSwiGLU8, pg8::MoeOrder, true, true>(c.lds, g, S, E); } GRID_BARRIER(bar); }
#endif
    if (IN(20)) {
#pragma unroll 1
        for (int rep_ = 0; rep_ < NREP(20); ++rep_) { { { pg8::Gemm g{(const bf16*)(ws + WS_XNM), (const bf16*)(ws + WS_WGUM), D / 2, MOE_GU_E8M0}; pg8::MoeOrder S; S.init(ctl + CW_CNT, 2 * ED / 256, c.G, c.bx, (const int*)(ws + WS_LIST));
        pg8::EpiSwiGLU8 E{(unsigned char*)(ws + WS_HM2), ED, MOE_H_SCALE};
        pg8::gemm_phase<pg8::EpiSwiGLU8, pg8::MoeOrder, true, true>(c.lds, g, S, E);
        { const int cut = S.nwg % (int)c.G;
          if (cut == 0) moe_convert(c, a, 2, P17_MOE_D, NE);
          else if ((int)c.bx >= cut) moe_convert(c, a, 2, P17_MOE_D, NE, ((int)c.bx - cut) * NWAVES + c.wave, ((int)c.G - cut) * NWAVES); } } }
        if (rep_ + 1 < NREP(20)) GRID_BARRIER(bar); } }
    SEAM(20);
#if defined(PROBE_P21)
    if (IN(21)) { { pg8::Gemm g{(const bf16*)(ws + WS_HM2), (const bf16*)(ws + WS_WDM), ED / 2, MOE_DN_E8M0}; pg8::MoeOrder S; S.init(ctl + CW_CNT, D / 256, c.G, c.bx, (const int*)(ws + WS_LIST));
        pg8::EpiStore E{(bf16*)(ws + WS_Y2), D, 0, 0};
        pg8::gemm_phase<pg8::EpiStore, pg8::MoeOrder, false, true>(c.lds, g, S, E); } GRID_BARRIER(bar); }
#endif
    if (IN(21)) {
#pragma unroll 1
        for (int rep_ = 0; rep_ < NREP(21); ++rep_) { { { pg8::Gemm g{(const bf16*)(ws + WS_HM2), (const bf16*)(ws + WS_WDM), ED / 2, MOE_DN_E8M0}; pg8::MoeOrder S; S.init(ctl + CW_CNT, D / 256, c.G, c.bx, (const int*)(ws + WS_LIST));
        const int rtail = S.nwg % (int)c.G; const bool split = P21_SPLIT_EN && rtail > 0 && rtail * pg8::EpiSplitK::SK <= (int)c.G && rtail <= 36;
        if (split) S.lim = S.nwg - rtail;
        pg8::EpiStore E{(bf16*)(ws + WS_Y2), D, 0, 0};
        pg8::gemm_phase<pg8::EpiStore, pg8::MoeOrder, false, true>(c.lds, g, S, E);
        if (P21_TAIL_EN && split && (int)c.bx < rtail * pg8::EpiSplitK::SK) {
            const int tu = (int)c.bx / pg8::EpiSplitK::SK, ks = (int)c.bx % pg8::EpiSplitK::SK;
            pg8::TailOrder TS; pg8::order_map(S.lim + tu, S.nwg, S.t8, S.nN, TS.u0.pm, TS.u0.pn); TS.u0.pb = S.expert_of(TS.u0.pm) * S.nN + TS.u0.pn;
            constexpr int KS = ED / 2 / pg8::EpiSplitK::SK;
            pg8::Gemm g2{(const bf16*)(ws + WS_HM2) + ks * KS, (const bf16*)(ws + WS_WDM) + ks * KS, KS, MOE_DN_E8M0, ED / 2};
            pg8::EpiSplitK E2{(float*)(ws + WS_PART) + (size_t)tu * pg8::EpiSplitK::SK * 65536, ks, ctl + CW_SPL + 16 * tu + P21_CNT_OFF, (bf16*)(ws + WS_Y2), D};
            pg8::gemm_phase<pg8::EpiSplitK, pg8::TailOrder, false, true>(c.lds, g2, TS, E2); } } }
        if (rep_ + 1 < NREP(21)) GRID_BARRIER(bar); } }
    SEAM(21);
    if (IN(22)) {
#pragma unroll 1
        for (int rep_ = 0; rep_ < NREP(22); ++rep_) { { phase22(c, XR, out); }
        if (rep_ + 1 < NREP(22)) GRID_BARRIER(bar); } }
#undef IN
#undef SEAM
}

extern "C" void kernel_launch(void* const* d_in, const int* in_sizes, int n_in, void* d_out, int out_size, void* d_ws, size_t ws_size, hipStream_t stream) {
    static int grid = 0;
    if (grid == 0) {
        if (n_in != 42 || in_sizes[0] != M * D || out_size != M * D || ws_size < WS_END) { fprintf(stderr, "kernel_launch: unexpected shapes (n_in %d, in0 %d, out %d, ws %zu)\n", n_in, n_in > 0 ? in_sizes[0] : -1, out_size, ws_size); grid = -1; return; }
        int dev = 0, cus = 0, per_cu = 0;
        if (hipGetDevice(&dev) != hipSuccess || hipDeviceGetAttribute(&cus, hipDeviceAttributeMultiprocessorCount, dev) != hipSuccess) { grid = -1; return; }
        if (hipFuncSetAttribute((const void*)fwd, hipFuncAttributeMaxDynamicSharedMemorySize, LDS_BYTES) != hipSuccess) { fprintf(stderr, "kernel_launch: hipFuncSetAttribute failed\n"); grid = -1; return; }
        if (hipOccupancyMaxActiveBlocksPerMultiprocessor(&per_cu, (const void*)fwd, NTHR, LDS_BYTES) != hipSuccess || per_cu < 1) fprintf(stderr, "kernel_launch: occupancy query says %d\n", per_cu);
        (void)hipGetLastError();
        grid = cus;
    }
    if (grid < 0) return;
    (void)hipMemsetAsync((char*)d_ws + WS_CTL, 0, CTL_ZERO_BYTES, stream);
    Args a{};
    for (int i = 0; i < 42; ++i) a.in[i] = d_in[i];
    a.out = (float*)d_out; a.ws = (unsigned char*)d_ws;
#if PROBE_BUILD
#ifdef PROBE_ZERO
    a.repmask = 0; a.pad = 0;
#else
    a.repmask = REPMASK; a.pad = 0;
#endif
#endif
#if ONE_LAUNCH
    a.ph_lo = 0; a.ph_hi = LAST_PHASE + 1;
    hipLaunchKernelGGL(fwd, dim3(grid), dim3(NTHR), LDS_BYTES, stream, a);
#else
    for (int p = 0; p <= LAST_PHASE; ++p) { a.ph_lo = p; a.ph_hi = p + 1; hipLaunchKernelGGL(fwd, dim3(grid), dim3(NTHR), LDS_BYTES, stream, a); }
#endif
}
```

```cpp
#include <hip/hip_runtime.h>
#include <hip/hip_bf16.h>
#include <cstdio>
#include <cstdint>
#include <cmath>

#define LAS __attribute__((address_space(3)))
#define GAS __attribute__((address_space(1)))
typedef unsigned short bf16;
typedef short bf16x8 __attribute__((ext_vector_type(8)));
typedef float f32x4 __attribute__((ext_vector_type(4)));
typedef float f32x2 __attribute__((ext_vector_type(2)));
typedef unsigned u32x4 __attribute__((ext_vector_type(4)));
typedef unsigned u32x2 __attribute__((ext_vector_type(2)));
typedef GAS unsigned gu32;

__device__ __forceinline__ unsigned cvt_pk_bf16(float lo, float hi) { unsigned r; asm volatile("v_cvt_pk_bf16_f32 %0, %1, %2" : "=v"(r) : "v"(lo), "v"(hi)); return r; }
__device__ __forceinline__ float bflo(unsigned w) { return __builtin_bit_cast(float, w << 16); }
__device__ __forceinline__ float bfhi(unsigned w) { return __builtin_bit_cast(float, w & 0xffff0000u); }
__device__ __forceinline__ float bf1(bf16 b) { return __builtin_bit_cast(float, (unsigned)b << 16); }
__device__ __forceinline__ bf16 f2bf(float f) { return (bf16)(cvt_pk_bf16(f, 0.f) & 0xffffu); }
__device__ __forceinline__ float rbf(float f) { return bflo(cvt_pk_bf16(f, 0.f)); }
__device__ __forceinline__ void unpack8(u32x4 w, float (&f)[8]) { f[0] = bflo(w.x); f[1] = bfhi(w.x); f[2] = bflo(w.y); f[3] = bfhi(w.y); f[4] = bflo(w.z); f[5] = bfhi(w.z); f[6] = bflo(w.w); f[7] = bfhi(w.w); }
__device__ __forceinline__ u32x4 pack8(const float (&f)[8]) { u32x4 w; w.x = cvt_pk_bf16(f[0], f[1]); w.y = cvt_pk_bf16(f[2], f[3]); w.z = cvt_pk_bf16(f[4], f[5]); w.w = cvt_pk_bf16(f[6], f[7]); return w; }
__device__ __forceinline__ float wave_sum(float v) {
#pragma unroll
    for (int o = 1; o < 64; o <<= 1) v += __shfl_xor(v, o);
    return v;
}
__device__ __forceinline__ float sigmoidf_(float x) { return __builtin_amdgcn_rcpf(1.0f + __expf(-x)); }
__device__ __forceinline__ float tanhf_(float x) { const float e = __expf(2.0f * x); return 1.0f - 2.0f * __builtin_amdgcn_rcpf(e + 1.0f); }
__device__ __forceinline__ float gelu_tanh(float x) { return 0.5f * x * (1.0f + tanhf_(0.7978845608028654f * (x + 0.044715f * x * x * x))); }
__device__ __forceinline__ float silu_(float x) { return x * __builtin_amdgcn_rcpf(1.0f + __expf(-x)); }
#define ONE_LAUNCH 1
namespace pg8 {
typedef unsigned short bf16_t;
constexpr int BM = 256, BK = 64, HALF = 128, HTB = HALF * BK * 2  , STAGE_BYTES = 8 * HTB, NXCD = 8, WGM = 8;
__host__ __device__ __forceinline__ int lds_byte(int r, int c) { const int st = (r >> 4) * 2 + (c >> 5), rr = r & 15, cc = c & 31, ob = rr * 64 + cc * 2; return st * 1024 + (ob ^ (((ob >> 9) & 1) << 5)); }
__host__ __device__ __forceinline__ void stage_rc(int b, int& R, int& C) { const int st = b / 1024, sb = b % 1024, swz = sb ^ (((sb >> 9) & 1) << 5); R = (st >> 1) * 16 + swz / 64; C = (st & 1) * 32 + (swz % 64) / 2; }
__host__ __device__ __forceinline__ int perm32(int rho) { const int n = rho >> 4, i = rho & 15; return 8 * (i >> 2) + 4 * n + (i & 3); }

struct Unit { int pm, pn, pb; };
struct Gemm { const bf16_t* A; const bf16_t* Bt; int K; int scale; int ld; };
typedef int i32x4_t __attribute__((ext_vector_type(4))); typedef int i32x8_t __attribute__((ext_vector_type(8)));

__device__ __forceinline__ void order_map(int L, int nwg, int nM, int nN, int& pm, int& pn) {
    int wgid = L; { const int q = nwg / NXCD, r = nwg % NXCD, xcd = wgid % NXCD, off = wgid / NXCD; wgid = (xcd < r ? xcd * (q + 1) : r * (q + 1) + (xcd - r) * q) + off; }
    const int nig = WGM * nN, gid = wgid / nig, fm = gid * WGM, gsz = (nM - fm) < WGM ? (nM - fm) : WGM;
    pm = fm + ((wgid % nig) % gsz); pn = (wgid % nig) / gsz;
}
template <int KMODE> struct StaticOrderT {
    int nM, nN, nwg, G, c;
    __device__ __forceinline__ void init(int M, int N, int G_, int c_) { nM = M / BM; nN = N / BM; nwg = nM * nN; G = G_; c = c_; }
    __device__ __forceinline__ int koff(const Unit& u) const { return KMODE == 1 ? (u.pn >= 4 ? 128 : 0) : KMODE == 2 ? (u.pn & 1) * 256 : 0; }
    __device__ __forceinline__ bool next(int i, Unit& u) const {
        const long L = (long)i * G + c; if (L >= nwg) return false;
        order_map((int)L, nwg, nM, nN, u.pm, u.pn); u.pb = u.pn; return true;
    }
    __device__ __forceinline__ int gather(const Unit&, int) const { return 0; }
    __device__ __forceinline__ const int* gather_ptr(const Unit&, int) const { return nullptr; }
};
typedef StaticOrderT<0> StaticOrder;
struct MoeOrder {
    int t1, t2, t3, t4, t5, t6, t7, t8;
    int c0, c1, c2, c3, c4, c5, c6, c7;
    int nN, nwg, lim, G, c; const int* list;
    __device__ __forceinline__ void init(const unsigned* cntw, int nN_, int G_, int c_, const int* list_) {
        c0 = (int)__builtin_amdgcn_readfirstlane(__hip_atomic_load(cntw + 0 * 64, __ATOMIC_RELAXED, __HIP_MEMORY_SCOPE_AGENT));
        c1 = (int)__builtin_amdgcn_readfirstlane(__hip_atomic_load(cntw + 1 * 64, __ATOMIC_RELAXED, __HIP_MEMORY_SCOPE_AGENT));
        c2 = (int)__builtin_amdgcn_readfirstlane(__hip_atomic_load(cntw + 2 * 64, __ATOMIC_RELAXED, __HIP_MEMORY_SCOPE_AGENT));
        c3 = (int)__builtin_amdgcn_readfirstlane(__hip_atomic_load(cntw + 3 * 64, __ATOMIC_RELAXED, __HIP_MEMORY_SCOPE_AGENT));
        c4 = (int)__builtin_amdgcn_readfirstlane(__hip_atomic_load(cntw + 4 * 64, __ATOMIC_RELAXED, __HIP_MEMORY_SCOPE_AGENT));
        c5 = (int)__builtin_amdgcn_readfirstlane(__hip_atomic_load(cntw + 5 * 64, __ATOMIC_RELAXED, __HIP_MEMORY_SCOPE_AGENT));
        c6 = (int)__builtin_amdgcn_readfirstlane(__hip_atomic_load(cntw + 6 * 64, __ATOMIC_RELAXED, __HIP_MEMORY_SCOPE_AGENT));
        c7 = (int)__builtin_amdgcn_readfirstlane(__hip_atomic_load(cntw + 7 * 64, __ATOMIC_RELAXED, __HIP_MEMORY_SCOPE_AGENT));
        t1 = (c0 + 255) >> 8; t2 = t1 + ((c1 + 255) >> 8); t3 = t2 + ((c2 + 255) >> 8); t4 = t3 + ((c3 + 255) >> 8);
        t5 = t4 + ((c4 + 255) >> 8); t6 = t5 + ((c5 + 255) >> 8); t7 = t6 + ((c6 + 255) >> 8); t8 = t7 + ((c7 + 255) >> 8);
        nN = nN_; nwg = t8 * nN_; lim = nwg; G = G_; c = c_; list = list_;
    }
    __device__ __forceinline__ int koff(const Unit&) const { return 0; }
    __device__ __forceinline__ int expert_of(int pm) const { return (pm >= t1) + (pm >= t2) + (pm >= t3) + (pm >= t4) + (pm >= t5) + (pm >= t6) + (pm >= t7); }
    __device__ __forceinline__ bool next(int i, Unit& u) const {
        const long L = (long)i * G + c; if (L >= lim) return false;
        order_map((int)L, nwg, t8, nN, u.pm, u.pn); u.pb = expert_of(u.pm) * nN + u.pn; return true;
    }
    __device__ __forceinline__ int gather(const Unit& u, int r) const {
        const int e = expert_of(u.pm);
        const int tb = e == 0 ? 0 : e == 1 ? t1 : e == 2 ? t2 : e == 3 ? t3 : e == 4 ? t4 : e == 5 ? t5 : e == 6 ? t6 : t7;
        const int ce = e == 0 ? c0 : e == 1 ? c1 : e == 2 ? c2 : e == 3 ? c3 : e == 4 ? c4 : e == 5 ? c5 : e == 6 ? c6 : c7;
        int slot = (u.pm - tb) * 256 + r; if (slot >= ce) slot = 0;
        return list[e * 16384 + slot];
    }
    __device__ __forceinline__ const int* gather_ptr(const Unit& u, int r) const {
        const int e = expert_of(u.pm);
        const int tb = e == 0 ? 0 : e == 1 ? t1 : e == 2 ? t2 : e == 3 ? t3 : e == 4 ? t4 : e == 5 ? t5 : e == 6 ? t6 : t7;
        const int ce = e == 0 ? c0 : e == 1 ? c1 : e == 2 ? c2 : e == 3 ? c3 : e == 4 ? c4 : e == 5 ? c5 : e == 6 ? c6 : c7;
        int slot = (u.pm - tb) * 256 + r; if (slot >= ce) slot = 0;
        return list + e * 16384 + slot;
    }
};

struct TailOrder {
    Unit u0;
    __device__ __forceinline__ int koff(const Unit&) const { return 0; }
    __device__ __forceinline__ bool next(int i, Unit& u) const { if (i != 0) return false; u = u0; return true; }
    __device__ __forceinline__ int gather(const Unit&, int) const { return 0; }
    __device__ __forceinline__ const int* gather_ptr(const Unit&, int) const { return nullptr; }
};

struct EpiStore {
    static constexpr bool PERM = true;
    bf16_t* O; int ldc; int split_cols; size_t split_stride;
    __device__ __forceinline__ void operator()(const f32x4 (&acc)[2][2][4][2], const Unit& u, int wr, int wc, int fr, int fq, const float* rowv = nullptr) const {
        const int row0 = u.pm * BM + wr * 64 + fr; int colt = u.pn * BM; bf16_t* base = O;
        if (split_cols) { const int t = colt / split_cols; base += (size_t)t * split_stride; colt -= t * split_cols; }
        const int col0 = colt + wc * 64 + 8 * fq;
#pragma unroll
        for (int ai = 0; ai < 2; ++ai)
#pragma unroll
            for (int m = 0; m < 4; ++m) { bf16_t* rowp = base + (size_t)(row0 + ai * HALF + m * 16) * ldc + col0; const float r = rowv ? rowv[ai * 4 + m] : 1.0f;
#pragma unroll
                for (int bj = 0; bj < 2; ++bj) { const f32x4 v0 = acc[ai][bj][m][0] * r, v1 = acc[ai][bj][m][1] * r;
                    u32x4 w; w.x = cvt_pk_bf16(v0[0], v0[1]); w.y = cvt_pk_bf16(v0[2], v0[3]); w.z = cvt_pk_bf16(v1[0], v1[1]); w.w = cvt_pk_bf16(v1[2], v1[3]);
                    *(u32x4*)(rowp + bj * 32) = w; } }
    }
};
struct EpiSplitK {
    static constexpr bool PERM = true; static constexpr int SK = 7, RW = 37;
    float* part; int ks; unsigned* cnt; bf16_t* O; int ldc;
    __device__ __forceinline__ void operator()(const f32x4 (&acc)[2][2][4][2], const Unit& u, int wr, int wc, int fr, int fq) const {
        float* P = part + (size_t)ks * (BM * BM);
        const int row0 = wr * 64 + fr, col0 = wc * 64 + 8 * fq;
#pragma unroll
        for (int ai = 0; ai < 2; ++ai)
#pragma unroll
            for (int m = 0; m < 4; ++m) { float* rowp = P + (row0 + ai * HALF + m * 16) * BM + col0;
#pragma unroll
                for (int bj = 0; bj < 2; ++bj) { *(f32x4*)(rowp + bj * 32) = acc[ai][bj][m][0]; *(f32x4*)(rowp + bj * 32 + 4) = acc[ai][bj][m][1]; } }
        asm volatile("s_waitcnt vmcnt(0)" ::: "memory");
        __syncthreads();
        if (threadIdx.x == 0) {
            __builtin_amdgcn_fence(__ATOMIC_RELEASE, "agent");
            (void)__hip_atomic_fetch_add(cnt, 1u, __ATOMIC_RELAXED, __HIP_MEMORY_SCOPE_AGENT);
            unsigned sp = 0u;
            while (__hip_atomic_load(cnt, __ATOMIC_RELAXED, __HIP_MEMORY_SCOPE_AGENT) < (unsigned)SK) { __builtin_amdgcn_s_sleep(1); if (++sp > (1u << 22)) break; }
            __builtin_amdgcn_fence(__ATOMIC_ACQUIRE, "agent");
        }
        __syncthreads();
        const int r0 = ks * RW, nr = (BM - r0) < RW ? (BM - r0) : RW;
        constexpr int NI = (RW * 64 + 511) / 512;
        f32x4 v[NI][SK];
#pragma unroll
        for (int i = 0; i < NI; ++i) { int f = (int)threadIdx.x + 512 * i; f = f < nr * 64 ? f : nr * 64 - 1;
            const float* src = part + (r0 + (f >> 6)) * BM + (f & 63) * 4;
#pragma unroll
            for (int k = 0; k < SK; ++k) v[i][k] = *(const f32x4*)(src + (size_t)k * (BM * BM)); }
#pragma unroll
        for (int i = 0; i < NI; ++i) { const int f = (int)threadIdx.x + 512 * i;
            f32x4 s = v[i][0];
#pragma unroll
            for (int k = 1; k < SK; ++k) s += v[i][k];
            u32x2 w; w.x = cvt_pk_bf16(s[0], s[1]); w.y = cvt_pk_bf16(s[2], s[3]);
            if (f < nr * 64) *(u32x2*)(O + (size_t)(u.pm * BM + r0 + (f >> 6)) * ldc + u.pn * BM + (f & 63) * 4) = w; }
    }
};
struct EpiSwiGLU {
    static constexpr bool PERM = true;
    bf16_t* H; int ldh;
    __device__ __forceinline__ void operator()(const f32x4 (&acc)[2][2][4][2], const Unit& u, int wr, int wc, int fr, int fq, const float* rowv = nullptr) const {
        const int row0 = u.pm * BM + wr * 64 + fr; const int col0 = u.pn * HALF + wc * 32 + 8 * fq;
#pragma unroll
        for (int ai = 0; ai < 2; ++ai)
#pragma unroll
            for (int m = 0; m < 4; ++m) { bf16_t* rowp = H + (size_t)(row0 + ai * HALF + m * 16) * ldh + col0; const float r = rowv ? rowv[ai * 4 + m] : 1.0f;
                const f32x4 g0 = acc[ai][0][m][0] * r, g1 = acc[ai][0][m][1] * r, u0 = acc[ai][1][m][0] * r, u1 = acc[ai][1][m][1] * r;
                u32x4 w; w.x = cvt_pk_bf16(silu_(g0[0]) * u0[0], silu_(g0[1]) * u0[1]); w.y = cvt_pk_bf16(silu_(g0[2]) * u0[2], silu_(g0[3]) * u0[3]);
                w.z = cvt_pk_bf16(silu_(g1[0]) * u1[0], silu_(g1[1]) * u1[1]); w.w = cvt_pk_bf16(silu_(g1[2]) * u1[2], silu_(g1[3]) * u1[3]);
                *(u32x4*)rowp = w; }
    }
};
__device__ __forceinline__ unsigned pk4_fp8(float a, float b, float c, float d) { int v = 0; v = __builtin_amdgcn_cvt_pk_fp8_f32(a, b, v, false); v = __builtin_amdgcn_cvt_pk_fp8_f32(c, d, v, true); return (unsigned)v; }
struct EpiSwiGLU8 {
    static constexpr bool PERM = true;
    unsigned char* H; int ldh; float oscale;
    __device__ __forceinline__ void operator()(const f32x4 (&acc)[2][2][4][2], const Unit& u, int wr, int wc, int fr, int fq) const {
        const int row0 = u.pm * BM + wr * 64 + fr; const int col0 = u.pn * HALF + wc * 32 + 8 * fq;
#pragma unroll
        for (int ai = 0; ai < 2; ++ai)
#pragma unroll
            for (int m = 0; m < 4; ++m) { unsigned char* rowp = H + (size_t)(row0 + ai * HALF + m * 16) * ldh + col0;
                const f32x4 g0 = acc[ai][0][m][0], g1 = acc[ai][0][m][1], u0 = acc[ai][1][m][0] * oscale, u1 = acc[ai][1][m][1] * oscale;
                u32x2 w; w.x = pk4_fp8(silu_(g0[0]) * u0[0], silu_(g0[1]) * u0[1], silu_(g0[2]) * u0[2], silu_(g0[3]) * u0[3]);
                w.y = pk4_fp8(silu_(g1[0]) * u1[0], silu_(g1[1]) * u1[1], silu_(g1[2]) * u1[2], silu_(g1[3]) * u1[3]);
                *(u32x2*)rowp = w; }
    }
};
template <class Base> struct RowScaled : Base {
    const float* rsq;
    __device__ __forceinline__ void operator()(const f32x4 (&acc)[2][2][4][2], const Unit& u, int wr, int wc, int fr, int fq, const float (&ss)[8]) const {
        float rowv[8];
#pragma unroll
        for (int i = 0; i < 8; ++i) rowv[i] = rsqrtf(ss[i] * (1.0f / 1024.0f) + 1e-6f);
        Base::operator()(acc, u, wr, wc, fr, fq, rowv);
    }
};
template <class T> struct is_rowscaled { static constexpr bool value = false; };
template <class B> struct is_rowscaled<RowScaled<B>> { static constexpr bool value = true; };
constexpr int ROWS_OFF = STAGE_BYTES + 1024;
struct EpiResid {
    static constexpr bool PERM = false;
    const float* resid; float* out; int ldc;
    __device__ __forceinline__ void operator()(const f32x4 (&acc)[2][2][4][2], const Unit& u, int wr, int wc, int fr, int fq) const {
        const int col0 = u.pn * BM + wc * 32 + 4 * fq;
#pragma unroll
        for (int ai = 0; ai < 2; ++ai)
#pragma unroll
            for (int m = 0; m < 4; ++m) { const size_t off = (size_t)(u.pm * BM + ai * HALF + wr * 64 + m * 16 + fr) * ldc + col0;
                f32x4 rs[2][2];
#pragma unroll
                for (int bj = 0; bj < 2; ++bj)
#pragma unroll
                    for (int n = 0; n < 2; ++n) rs[bj][n] = *(const f32x4*)(resid + off + bj * HALF + n * 16);
#pragma unroll
                for (int bj = 0; bj < 2; ++bj)
#pragma unroll
                    for (int n = 0; n < 2; ++n) *(f32x4*)(out + off + bj * HALF + n * 16) = rs[bj][n] + acc[ai][bj][m][n];
                if (m & 1) asm volatile("" ::: "memory"); }
    }
};

struct EpiResidB {
    static constexpr bool PERM = true;
    const float* rf; const bf16_t* rb; bf16_t* O; int ldc; float* rsq;
    __device__ __forceinline__ void operator()(const f32x4 (&acc)[2][2][4][2], const Unit& u, int wr, int wc, int fr, int fq) const {
        const int col0 = u.pn * BM + wc * 64 + 8 * fq;
#pragma unroll
        for (int ai = 0; ai < 2; ++ai)
#pragma unroll
            for (int m = 0; m < 4; ++m) { const size_t off = (size_t)(u.pm * BM + ai * HALF + wr * 64 + m * 16 + fr) * ldc + col0;
                f32x4 rs[2][2];
#pragma unroll
                for (int bj = 0; bj < 2; ++bj) {
                    if (rf) { rs[bj][0] = *(const f32x4*)(rf + off + bj * 32); rs[bj][1] = *(const f32x4*)(rf + off + bj * 32 + 4); }
                    else { const u32x4 w = *(const u32x4*)(rb + off + bj * 32); rs[bj][0] = (f32x4){bflo(w.x), bfhi(w.x), bflo(w.y), bfhi(w.y)}; rs[bj][1] = (f32x4){bflo(w.z), bfhi(w.z), bflo(w.w), bfhi(w.w)}; } }
                float ss = 0.f;
#pragma unroll
                for (int bj = 0; bj < 2; ++bj) { const f32x4 v0 = rs[bj][0] + acc[ai][bj][m][0], v1 = rs[bj][1] + acc[ai][bj][m][1];
                    ss += (v0[0] * v0[0] + v0[1] * v0[1]) + (v0[2] * v0[2] + v0[3] * v0[3]) + (v1[0] * v1[0] + v1[1] * v1[1]) + (v1[2] * v1[2] + v1[3] * v1[3]);
                    u32x4 w; w.x = cvt_pk_bf16(v0[0], v0[1]); w.y = cvt_pk_bf16(v0[2], v0[3]); w.z = cvt_pk_bf16(v1[0], v1[1]); w.w = cvt_pk_bf16(v1[2], v1[3]);
                    *(u32x4*)(O + off + bj * 32) = w; }
                if (rsq) { ss += __shfl_xor(ss, 16); ss += __shfl_xor(ss, 32);
                    ss = rintf(ss * 256.0f) * (1.0f / 256.0f);
                    if (fq == 0) (void)__hip_atomic_fetch_add(rsq + u.pm * BM + ai * HALF + wr * 64 + m * 16 + fr, ss, __ATOMIC_RELAXED, __HIP_MEMORY_SCOPE_AGENT); }
                if (m & 1) asm volatile("" ::: "memory"); }
    }
};

#ifndef PG8_ALIGN_DEFAULT
#define PG8_ALIGN_DEFAULT true
#endif
template <class Epi, class Sched, bool GATHER, bool FP8 = false, bool ALIGN_EPI = PG8_ALIGN_DEFAULT>
__device__ __forceinline__ void gemm_phase(LAS unsigned char* lds, const Gemm g, const Sched& S, const Epi& E) {
    const int tid = threadIdx.x, wid = __builtin_amdgcn_readfirstlane(tid >> 6), lane = tid & 63, wr = wid >> 2, wc = wid & 3, fr = lane & 15, fq = lane >> 4;
    const int K = g.ld ? g.ld : g.K; int nt = g.K / BK; asm volatile("" : "+s"(nt));
    const size_t kstep = (size_t)(BK * 2);
    const size_t hstep = (size_t)HALF * K * 2;
    const size_t tstep = 2 * hstep;
    int sR[2], sC[2];
    unsigned voffB[2];
    const size_t bstep = Epi::PERM ? (size_t)32 * K * 2 : hstep;
#pragma unroll
    for (int i = 0; i < 2; ++i) { stage_rc(tid * 16 + i * 8192, sR[i], sC[i]);
        const int Rb0 = Epi::PERM ? (64 * (sR[i] >> 5) + perm32(sR[i] & 31)) : sR[i];
        voffB[i] = (unsigned)(Rb0 * K + sC[i]) * 2u; }
    const unsigned ldsw = (unsigned)wid * 1024u;
    const int aoff = lds_byte(wr * 64 + fr, fq * 8), boff = lds_byte(wc * 32 + fr, fq * 8);
#define PG8_SA(b, h) (((b) * 2 + (h)) * HTB)
#define PG8_SB(b, h) ((4 + (b) * 2 + (h)) * HTB)
#define PG8_STAGE(bufoff, gbase, voff) do { _Pragma("unroll") for (int _i = 0; _i < 2; ++_i) \
        __builtin_amdgcn_global_load_lds((const unsigned*)((const char*)(gbase) + (voff)[_i]), (LAS unsigned*)(lds + (bufoff) + ldsw + _i * 8192), 16, 0, 0); } while (0)
#define PG8_STAGEA(bufoff, gbase, o0, o1) do { \
        __builtin_amdgcn_global_load_lds((const unsigned*)((const char*)(gbase) + (o0)), (LAS unsigned*)(lds + (bufoff) + ldsw), 16, 0, 0); \
        __builtin_amdgcn_global_load_lds((const unsigned*)((const char*)(gbase) + (o1)), (LAS unsigned*)(lds + (bufoff) + ldsw + 8192), 16, 0, 0); } while (0)
#define PG8_LDA(dst, b, h) do { _Pragma("unroll") for (int m = 0; m < 4; ++m) _Pragma("unroll") for (int k = 0; k < 2; ++k) dst[m][k] = *(const LAS bf16x8*)(lds + PG8_SA(b, h) + aoff + m * 2048 + k * 1024); } while (0)
#define PG8_LDB(dst, b, h) do { _Pragma("unroll") for (int n = 0; n < 2; ++n) _Pragma("unroll") for (int k = 0; k < 2; ++k) dst[n][k] = *(const LAS bf16x8*)(lds + PG8_SB(b, h) + boff + n * 2048 + k * 1024); } while (0)
#define PG8_CAT(x) __builtin_shufflevector(__builtin_bit_cast(i32x4_t, x[0]), __builtin_bit_cast(i32x4_t, x[1]), 0, 1, 2, 3, 4, 5, 6, 7)
#define PG8_MMA(ai, bj, At, Bt) do { __builtin_amdgcn_s_setprio(1); \
        if constexpr (FP8) { _Pragma("unroll") for (int m = 0; m < 4; ++m) _Pragma("unroll") for (int n = 0; n < 2; ++n) \
            { const i32x8_t b8_ = PG8_CAT(Bt[n]), a8_ = PG8_CAT(At[m]); asm volatile("v_mfma_scale_f32_16x16x128_f8f6f4 %0, %1, %2, %0, %3, %4 op_sel_hi:[0,0,0]" : "+v"(acc[ai][bj][m][n]) : "v"(b8_), "v"(a8_), "v"(sc_w), "v"(sc_a)); } } \
        else { _Pragma("unroll") for (int m = 0; m < 4; ++m) _Pragma("unroll") for (int n = 0; n < 2; ++n) _Pragma("unroll") for (int k = 0; k < 2; ++k) \
            acc[ai][bj][m][n] = __builtin_amdgcn_mfma_f32_16x16x32_bf16(Bt[n][k], At[m][k], acc[ai][bj][m][n], 0, 0, 0); } \
        __builtin_amdgcn_s_setprio(0); } while (0)
#define PG8_WAIT_V(n) asm volatile("s_waitcnt vmcnt(" #n ")" ::: "memory")
#define PG8_WAIT_L(n) asm volatile("s_waitcnt lgkmcnt(" #n ")" ::: "memory")
#define PG8_BAR __builtin_amdgcn_s_barrier()
#define PG8_SCHED __builtin_amdgcn_sched_barrier(0)
    Unit cur, nxt; int ui = 0;
    if (!S.next(0, cur)) return;
    constexpr bool ROWS = is_rowscaled<Epi>::value;
    int rsl = 0; (void)rsl;
#define PG8_ROWDMA(unit, slot) do { if constexpr (ROWS) { if (wid < 4) __builtin_amdgcn_global_load_lds((const unsigned*)(E.rsq + (size_t)(unit).pm * BM + wid * 64 + lane), \
        (LAS unsigned*)(lds + ROWS_OFF + (slot) * 1024 + wid * 256), 4, 0, 0); } } while (0)
    PG8_ROWDMA(cur, 0);
    int sc_w = g.scale, sc_a = 0x7f7f7f7f; asm volatile("" : "+v"(sc_w), "+v"(sc_a));
    (void)sc_w; (void)sc_a;
    unsigned oC00, oC01, oC10, oC11, oN00, oN01, oN10, oN11;
    if constexpr (GATHER) {
        oC00 = (unsigned)(S.gather(cur, sR[0]) * K + sC[0]) * 2u; oC01 = (unsigned)(S.gather(cur, sR[1]) * K + sC[1]) * 2u;
        oC10 = (unsigned)(S.gather(cur, 128 + sR[0]) * K + sC[0]) * 2u; oC11 = (unsigned)(S.gather(cur, 128 + sR[1]) * K + sC[1]) * 2u;
    } else {
        oC00 = (unsigned)(sR[0] * K + sC[0]) * 2u; oC01 = (unsigned)(sR[1] * K + sC[1]) * 2u; oC10 = oC00 + (unsigned)hstep; oC11 = oC01 + (unsigned)hstep;
    }
    oN00 = oC00; oN01 = oC01; oN10 = oC10; oN11 = oC11;
    int tkN0 = 0, tkN1 = 0, tkN2 = 0, tkN3 = 0; bool gnext = false; (void)tkN0; (void)tkN1; (void)tkN2; (void)tkN3; (void)gnext;
    f32x4 acc[2][2][4][2];
#pragma unroll
    for (int a = 0; a < 2; ++a)
#pragma unroll
        for (int b = 0; b < 2; ++b)
#pragma unroll
            for (int m = 0; m < 4; ++m)
#pragma unroll
                for (int n = 0; n < 2; ++n) acc[a][b][m][n] = (f32x4){0.f, 0.f, 0.f, 0.f};
    bf16x8 At[4][2], B0[2][2], B1[2][2];
    const char* cA = (const char*)g.A + (GATHER ? (size_t)0 : (size_t)cur.pm * tstep) + S.koff(cur) * 2; const char* cB = (const char*)g.Bt + (size_t)cur.pb * tstep + S.koff(cur) * 2;
    PG8_STAGE(PG8_SB(0, 0), cB, voffB); PG8_STAGE(PG8_SB(0, 1), cB + bstep, voffB); PG8_STAGEA(PG8_SA(0, 0), cA, oC00, oC01); PG8_STAGEA(PG8_SA(0, 1), cA, oC10, oC11);
    if (wr == 1) PG8_BAR;
    PG8_WAIT_V(2); PG8_BAR;
    PG8_STAGE(PG8_SB(1, 0), cB + kstep, voffB); PG8_STAGEA(PG8_SA(1, 0), cA + kstep, oC00, oC01); PG8_STAGE(PG8_SB(1, 1), cB + bstep + kstep, voffB);
    PG8_WAIT_V(6); PG8_BAR;
    for (;;) {
        const bool has_next = S.next(ui + 1, nxt);
        const char* nA = has_next ? (const char*)g.A + (GATHER ? (size_t)0 : (size_t)nxt.pm * tstep) + S.koff(nxt) * 2 : cA; const char* nB = has_next ? (const char*)g.Bt + (size_t)nxt.pb * tstep + S.koff(nxt) * 2 : cB;
        if (has_next) PG8_ROWDMA(nxt, rsl == 2 ? 0 : rsl + 1);
        if constexpr (GATHER) {
            if (has_next) { const int* p0 = S.gather_ptr(nxt, sR[0]); const int* p1 = S.gather_ptr(nxt, sR[1]); const int* p2 = S.gather_ptr(nxt, 128 + sR[0]); const int* p3 = S.gather_ptr(nxt, 128 + sR[1]);
                asm volatile("global_load_dword %0, %4, off\n\tglobal_load_dword %1, %5, off\n\tglobal_load_dword %2, %6, off\n\tglobal_load_dword %3, %7, off"
                             : "=&v"(tkN0), "=&v"(tkN1), "=&v"(tkN2), "=&v"(tkN3) : "v"(p0), "v"(p1), "v"(p2), "v"(p3) : "memory"); gnext = true;
            } else gnext = false;
        }
        for (int t = 0; t < nt; t += 2) {
            const bool last = (t == nt - 2);
            const char* a1 = cA + (size_t)(t + 1) * kstep;
            const char* a2 = last ? nA : cA + (size_t)(t + 2) * kstep; const char* b2 = last ? nB : cB + (size_t)(t + 2) * kstep;
            const char* a3 = a2 + kstep; const char* b3 = b2 + kstep;
            unsigned o00 = oC00, o01 = oC01, o10 = oC10, o11 = oC11;
            if constexpr (GATHER) { if (last) { asm volatile("" : "+v"(tkN0), "+v"(tkN1), "+v"(tkN2), "+v"(tkN3));
                if (gnext) { oN00 = (unsigned)(tkN0 * K + sC[0]) * 2u; oN01 = (unsigned)(tkN1 * K + sC[1]) * 2u; oN10 = (unsigned)(tkN2 * K + sC[0]) * 2u; oN11 = (unsigned)(tkN3 * K + sC[1]) * 2u; }
                else { oN00 = oC00; oN01 = oC01; oN10 = oC10; oN11 = oC11; }
                o00 = oN00; o01 = oN01; o10 = oN10; o11 = oN11; } }
            PG8_LDB(B0, 0, 0); PG8_LDB(B1, 0, 1); PG8_SCHED; PG8_LDA(At, 0, 0); PG8_STAGEA(PG8_SA(1, 1), a1, oC10, oC11);
            PG8_WAIT_V(8); PG8_WAIT_L(0); PG8_BAR; PG8_MMA(0, 0, At, B0); PG8_MMA(0, 1, At, B1); PG8_BAR; PG8_SCHED;
            PG8_LDA(At, 0, 1); PG8_STAGE(PG8_SB(0, 0), b2, voffB); PG8_STAGE(PG8_SB(0, 1), b2 + bstep, voffB); PG8_STAGEA(PG8_SA(0, 0), a2, o00, o01);
            PG8_WAIT_V(8); PG8_WAIT_L(0); PG8_BAR; PG8_MMA(1, 0, At, B0); PG8_MMA(1, 1, At, B1); PG8_BAR; PG8_SCHED;
            PG8_LDB(B0, 1, 0); PG8_LDB(B1, 1, 1); PG8_SCHED; PG8_LDA(At, 1, 0); PG8_STAGEA(PG8_SA(0, 1), a2, o10, o11);
            PG8_WAIT_V(8); PG8_WAIT_L(0); PG8_BAR; PG8_MMA(0, 0, At, B0); PG8_MMA(0, 1, At, B1); PG8_BAR; PG8_SCHED;
            PG8_LDA(At, 1, 1); PG8_STAGE(PG8_SB(1, 0), b3, voffB); PG8_STAGE(PG8_SB(1, 1), b3 + bstep, voffB); PG8_STAGEA(PG8_SA(1, 0), a3, o00, o01);
            PG8_WAIT_V(8); PG8_WAIT_L(0); PG8_BAR; PG8_MMA(1, 0, At, B0); PG8_MMA(1, 1, At, B1); PG8_BAR; PG8_SCHED;
        }
        if constexpr (ALIGN_EPI) { if (wr == 0) PG8_BAR; }
        if constexpr (FP8) asm volatile("s_nop 15\n\ts_nop 15" ::: "memory");
        if constexpr (ROWS) { float ssv[8];
#pragma unroll
            for (int i = 0; i < 8; ++i) ssv[i] = *(const LAS float*)(lds + ROWS_OFF + rsl * 1024 + (wr * 64 + fr + (i >> 2) * HALF + (i & 3) * 16) * 4);
            E(acc, cur, wr, wc, fr, fq, ssv); rsl = rsl == 2 ? 0 : rsl + 1; }
        else E(acc, cur, wr, wc, fr, fq);
        if (!has_next) break;
#pragma unroll
        for (int a = 0; a < 2; ++a)
#pragma unroll
            for (int b = 0; b < 2; ++b)
#pragma unroll
                for (int m = 0; m < 4; ++m)
#pragma unroll
                    for (int n = 0; n < 2; ++n) acc[a][b][m][n] = (f32x4){0.f, 0.f, 0.f, 0.f};
        cur = nxt; cA = nA; cB = nB; ++ui;
        oC00 = oN00; oC01 = oN01; oC10 = oN10; oC11 = oN11;
        if constexpr (ALIGN_EPI) { if (wr == 1) PG8_BAR; }
    }
    PG8_WAIT_V(0);
    if constexpr (!ALIGN_EPI) { if (wr == 0) PG8_BAR; }
    PG8_BAR;
#undef PG8_ROWDMA
#undef PG8_SA
#undef PG8_SB
#undef PG8_STAGE
#undef PG8_STAGEA
#undef PG8_LDA
#undef PG8_LDB
#undef PG8_MMA
#undef PG8_CAT
#undef PG8_WAIT_V
#undef PG8_WAIT_L
#undef PG8_BAR
#undef PG8_SCHED
}
}
namespace attn_body {
using bf16=__hip_bfloat16;
using bf16x8=__attribute__((ext_vector_type(8)))short;
using s16x4=__attribute__((ext_vector_type(4)))short;
using f32x16=__attribute__((ext_vector_type(16)))float;
using u32x4=__attribute__((ext_vector_type(4)))unsigned;
constexpr int BATCH=2,NHEAD=16,SEQ=8192,D=64,DM=NHEAD*D;
constexpr int NW=8,QBLK=32,QB=QBLK*NW,KVBLK=64,NQB=SEQ/QB;
constexpr int ATTN_PITCH=DM, ATTN_UNIT_ROWS=QB;
__device__ __forceinline__ int crow(int r,int hi){return (r&3)+8*(r>>2)+4*hi;}
#define SBAR() __builtin_amdgcn_sched_barrier(0)
__device__ __forceinline__ void cmask(f32x16&p0,f32x16&p1,int jb,int qrel,int hi){
  const float NEG=-INFINITY; int kb=64*jb+4*hi;
  #pragma unroll
  for(int r=0;r<16;++r){int kv=kb+(r&3)+8*(r>>2); if(kv>qrel)p0[r]=NEG; if(kv+32>qrel)p1[r]=NEG;}
}

constexpr int NSLOT=3, SLOTB=8192;
constexpr int LDS_K=0, LDS_V=NSLOT*SLOTB, LDS_WS=3*NSLOT*SLOTB, LDS_OST=LDS_WS+NW*64*4, LDS_BYTES=LDS_OST+NW*4096;
constexpr float C2=0.125f*1.4426950408889634f;
__device__ __forceinline__ void glds16(const void*gsrc,unsigned lds_dst){unsigned keep;
  asm volatile("s_mov_b32 %0, m0\n\ts_mov_b32 m0, %2\n\ts_nop 0\n\tglobal_load_lds_dwordx4 %1, off\n\ts_mov_b32 m0, %0":"=&s"(keep):"v"(gsrc),"s"(lds_dst):"memory");}
__device__ __forceinline__ float max3f(float a,float b,float c){float r;asm("v_max3_f32 %0, %1, %2, %3":"=v"(r):"v"(a),"v"(b),"v"(c));return r;}
__device__ __forceinline__ float max2f(float a,float b){float r;asm("v_max_f32_e32 %0, %1, %2":"=v"(r):"v"(a),"v"(b));return r;}
__device__ __forceinline__ float fadd_s(float a,float b){float r;asm("v_add_f32_e32 %0, %1, %2":"=v"(r):"v"(a),"v"(b));return r;}
__device__ __forceinline__ float fsub_s(float a,float b){float r;asm("v_sub_f32_e32 %0, %1, %2":"=v"(r):"v"(a),"v"(b));return r;}
typedef float f32x2_t __attribute__((ext_vector_type(2))); typedef __bf16 bf16x2_t __attribute__((ext_vector_type(2)));
__device__ __forceinline__ unsigned cvtpk_s(float lo,float hi){f32x2_t v={lo,hi};bf16x2_t b=__builtin_convertvector(v,bf16x2_t);return __builtin_bit_cast(unsigned,b);}
#define WAIT_BAR(N) asm volatile("s_waitcnt vmcnt(" #N ") lgkmcnt(0)\n\ts_barrier":::"memory")

__device__ __forceinline__ void qkt(f32x16&p0,f32x16&p1,const char*Kslot,const bf16x8*qr,const f32x16&negm,int r32,int hi){
  const char*kb=Kslot+hi*1024+r32*16;
  #pragma unroll
  for(int d0=0;d0<4;++d0){
    const bf16x8 b0=*reinterpret_cast<const bf16x8*>(kb+d0*2048);
    const bf16x8 b1=*reinterpret_cast<const bf16x8*>(kb+d0*2048+512);
    if(d0==0){p0=__builtin_amdgcn_mfma_f32_32x32x16_bf16(b0,qr[0],negm,0,0,0);p1=__builtin_amdgcn_mfma_f32_32x32x16_bf16(b1,qr[0],negm,0,0,0);}
    else{p0=__builtin_amdgcn_mfma_f32_32x32x16_bf16(b0,qr[d0],p0,0,0,0);p1=__builtin_amdgcn_mfma_f32_32x32x16_bf16(b1,qr[d0],p1,0,0,0);}}
}
typedef __attribute__((address_space(3))) const char* lds_cptr;
typedef short v4i16_t __attribute__((ext_vector_type(4)));
__device__ __forceinline__ void kload8(bf16x8*kf,lds_cptr kp){
  kf[0]=*(const __attribute__((address_space(3))) bf16x8*)(kp);      kf[1]=*(const __attribute__((address_space(3))) bf16x8*)(kp+512);
  kf[2]=*(const __attribute__((address_space(3))) bf16x8*)(kp+2048); kf[3]=*(const __attribute__((address_space(3))) bf16x8*)(kp+2560);
  kf[4]=*(const __attribute__((address_space(3))) bf16x8*)(kp+4096); kf[5]=*(const __attribute__((address_space(3))) bf16x8*)(kp+4608);
  kf[6]=*(const __attribute__((address_space(3))) bf16x8*)(kp+6144); kf[7]=*(const __attribute__((address_space(3))) bf16x8*)(kp+6656);
}
__device__ __forceinline__ void kload2(bf16x8*kf,lds_cptr kp,int j){ kf[2*j]=*(const __attribute__((address_space(3))) bf16x8*)(kp+j*2048); kf[2*j+1]=*(const __attribute__((address_space(3))) bf16x8*)(kp+j*2048+512); }
__device__ __forceinline__ s16x4 vtr(lds_cptr p){ return __builtin_bit_cast(s16x4,__builtin_amdgcn_ds_read_tr16_b64_v4i16((__attribute__((address_space(3))) v4i16_t*)p)); }
__device__ __forceinline__ float rowmax(const f32x16&p0,const f32x16&p1){
  float a=max3f(p0[0],p0[1],p1[0]),b=max3f(p0[2],p0[3],p1[1]);a=max3f(a,p1[2],p1[3]);
  #pragma unroll
  for(int r=4;r<16;r+=4){a=max3f(a,p0[r],p0[r+1]);b=max3f(b,p0[r+2],p0[r+3]);a=max3f(a,p1[r],p1[r+1]);b=max3f(b,p1[r+2],p1[r+3]);}
  const float m=max2f(a,b);
  auto rr=__builtin_amdgcn_permlane32_swap(__float_as_uint(m),__float_as_uint(m),false,false);
  return max2f(__uint_as_float(rr[0]),__uint_as_float(rr[1]));
}
__device__ __forceinline__ void pv(f32x16*o,int vb,bf16x8 pa0,bf16x8 pa1,bf16x8 pa2,bf16x8 pa3){
  #pragma unroll
  for(int d0=0;d0<4;++d0){s16x4 lo[4],hi[4];
    #pragma unroll
    for(int ks=0;ks<4;++ks){
      asm volatile("ds_read_b64_tr_b16 %0,%1 offset:%c2":"=&v"(lo[ks]):"v"(vb),"i"(d0*4096+ks*1024):"memory");
      asm volatile("ds_read_b64_tr_b16 %0,%1 offset:%c2":"=&v"(hi[ks]):"v"(vb),"i"(d0*4096+ks*1024+512):"memory");}
    asm volatile("s_waitcnt lgkmcnt(0)":::"memory");SBAR();
    #define PK(k) (bf16x8){lo[k][0],lo[k][1],lo[k][2],lo[k][3],hi[k][0],hi[k][1],hi[k][2],hi[k][3]}
    o[d0]=__builtin_amdgcn_mfma_f32_32x32x16_bf16(pa0,PK(0),o[d0],0,0,0);
    o[d0]=__builtin_amdgcn_mfma_f32_32x32x16_bf16(pa1,PK(1),o[d0],0,0,0);
    o[d0]=__builtin_amdgcn_mfma_f32_32x32x16_bf16(pa2,PK(2),o[d0],0,0,0);
    o[d0]=__builtin_amdgcn_mfma_f32_32x32x16_bf16(pa3,PK(3),o[d0],0,0,0);
    #undef PK
  }
}

#ifndef ATTN_STORE16
#define ATTN_STORE16(p,v) (*(u32x4*)(p)=(v))
#endif
template<int THRL> __device__ __forceinline__ void attn_unit(int b,int hq,int hv,int qb,const bf16*Q,const bf16*__restrict__ K,const bf16*__restrict__ V,bf16*O,char*shm){
  const int tid=threadIdx.x,lane=tid&63,r32=lane&31,hi=lane>>5; const int wid=__builtin_amdgcn_readfirstlane(tid>>6);
  const long rowbase=(long)b*SEQ; const int q0=qb*QB;
  const bf16*Qw=Q+(rowbase+q0+wid*QBLK)*DM+hq*D;
  const bf16*Kh=K+rowbase*DM+hq*D,*Vh=V+rowbase*DM+hv*D;
  const unsigned lds0=(unsigned)(uintptr_t)shm;
  float*wsf=(float*)(shm+LDS_WS)+wid*64;
  const bf16*ksrc=Kh+(long)lane*DM+wid*8;
  const bf16*vsrc=Vh+(long)(16*(wid&3)+(lane>>2))*DM+(wid>>2)*32+(lane&3)*8;
  const unsigned kdst=lds0+LDS_K+wid*1024, vdst=lds0+LDS_V+wid*1024;
  #define DMA_K(t,slot) glds16(ksrc+(long)(t)*KVBLK*DM,(unsigned)__builtin_amdgcn_readfirstlane(kdst+(slot)))
  #define DMA_V(t,slot) do{ glds16(vsrc+(long)(t)*KVBLK*DM,(unsigned)__builtin_amdgcn_readfirstlane(vdst+2*(slot))); glds16(vsrc+64+(long)(t)*KVBLK*DM,(unsigned)__builtin_amdgcn_readfirstlane(vdst+8192+2*(slot))); }while(0)
  const int vb0=(int)(lds0+LDS_V)+((lane>>4)&1)*32+(lane&3)*8+(4*hi+((lane&15)>>2))*64;
  const char*Kbase=shm+LDS_K; bf16x8 kf[8];
  const lds_cptr shm3=(lds_cptr)shm; const lds_cptr kp0=shm3+LDS_K+hi*1024+r32*16; const lds_cptr vp0=shm3+LDS_V+((lane>>4)&1)*32+(lane&3)*8+(4*hi+((lane&15)>>2))*64;
  if(__builtin_amdgcn_readfirstlane(wid)>=4)__builtin_amdgcn_s_setprio(1);
  const int NT=(q0+QB)/KVBLK;
  DMA_K(0,0);DMA_V(0,0);DMA_K(1,SLOTB);
  bf16x8 qr[4];
  #pragma unroll
  for(int d0=0;d0<4;++d0)qr[d0]=*reinterpret_cast<const bf16x8*>(&Qw[(long)r32*DM+d0*16+hi*8]);
  typedef __attribute__((address_space(3))) bf16x8 lds_bf16x8;
  { __attribute__((address_space(3))) char* qst=(__attribute__((address_space(3))) char*)shm+LDS_OST+wid*4096+lane*16;
    #pragma unroll
    for(int d0=0;d0<4;++d0)*(lds_bf16x8*)(qst+d0*1024)=qr[d0]; }
  const lds_cptr qp0=(lds_cptr)shm+LDS_OST+wid*4096+lane*16;
  #define QL(d) (*(const lds_bf16x8*)(qp0+(d)*1024))
  float mhat=0.f,l_reg=0.f;f32x16 o[4];o[0]=f32x16{};o[1]=f32x16{};o[2]=f32x16{};o[3]=f32x16{};f32x16 negm=f32x16{};asm volatile("":"+v"(negm));
  const int qrel=wid*QBLK+r32;
  #define CMASK(P0,P1,t) do{int jb_=(t)-(NT-4); if(jb_>=0)cmask(P0,P1,jb_,qrel,hi);}while(0)
  bool resc=false;
  #define START(P0,P1) do{ const float rm=rowmax(P0,P1); resc=false; \
    { const float dl=rm; mhat=fadd_s(mhat,dl); \
      _Pragma("unroll") for(int r=0;r<16;++r){P0[r]=fsub_s(P0[r],dl);P1[r]=fsub_s(P1[r],dl);} \
      _Pragma("unroll") for(int r=0;r<16;++r)negm[r]=-mhat; asm volatile("":"+v"(negm)); } \
    _Pragma("unroll") for(int r=0;r<16;++r)P0[r]=__builtin_amdgcn_exp2f(P0[r]); }while(0)
  #define RESC() do{ if(resc){ asm volatile("s_waitcnt lgkmcnt(0)":::"memory"); \
      _Pragma("unroll") for(int d_=0;d_<4;++d_) _Pragma("unroll") for(int r=0;r<16;++r)o[d_][r]*=wsf[crow(r,hi)]; } }while(0)
  f32x16 pA0,pA1,pB0,pB1;
  int sl_prev=0,sl_cur=0,sl_next=SLOTB;
  #define ROT() do{sl_prev=sl_cur;sl_cur=sl_next;sl_next=(sl_next==(NSLOT-1)*SLOTB)?0:sl_next+SLOTB;}while(0)
  DMA_K(2,2*SLOTB);
  WAIT_BAR(3);
  qkt(pA0,pA1,Kbase,qr,negm,r32,hi);asm volatile("s_nop 15\n\ts_nop 7":"+v"(pA0),"+v"(pA1));CMASK(pA0,pA1,0);
  START(pA0,pA1);
  _Pragma("unroll") for(int r=0;r<16;++r)pA1[r]=__builtin_amdgcn_exp2f(pA1[r]);
  WAIT_BAR(0);
  DMA_K(3,0);DMA_V(1,SLOTB);
  ROT();
  kload8(kf,kp0+sl_cur);
  WAIT_BAR(3);
  s16x4 fAlo,fAhi,fBlo,fBhi,fClo,fChi; u32x4 pw0,pw1,pw2,pw3;
  #define PKW(P,B) cvtpk_s(P[B],P[B+1])
  #define PAF(k) __builtin_bit_cast(bf16x8,pw##k)
  #define PIN(x) asm volatile("":"+v"(x))
  #define MX3(a,b,c) __builtin_fmaxf(__builtin_fmaxf((a),(b)),(c))
  #define GAPA(MF,A0,A1,A2,A3,W0,W1,PW) do{ MF; sacc+=A0; sacc+=A1; sacc+=A2; sacc+=A3; PIN(sacc); W0; W1; PIN(PW); SBAR(); }while(0)
  #define EX(v) __builtin_amdgcn_exp2f(v)
  #define GAPB(MF,X,B) do{ MF; X[B]=EX(X[B]); X[B+1]=EX(X[B+1]); PIN(X); SBAR(); }while(0)
  #define VRDF(F,n) do{ F##lo=vtr(vp_+(((n)&3)*4096+((n)>>2)*1024)); F##hi=vtr(vp_+(((n)&3)*4096+((n)>>2)*1024+512)); }while(0)
  #define VFRF(F) (bf16x8){F##lo[0],F##lo[1],F##lo[2],F##lo[3],F##hi[0],F##hi[1],F##hi[2],F##hi[3]}
  #define KRD(G,j) do{ if(G){ kload2(kf,kp0+sl_next,j); SBAR(); } }while(0)
  #define STEP(C0,C1,P0,P1,t,GK,GV,GL) do{ SBAR(); \
    const lds_cptr vp_=vp0+2*sl_prev; \
    const bf16x8 q0_=QL(0),q1_=QL(1),q2_=QL(2),q3_=QL(3); SBAR(); float sacc=(P0[0]+P0[1]); \
    GAPA(C0=__builtin_amdgcn_mfma_f32_32x32x16_bf16(kf[0],q0_,negm,0,0,0), P0[2],P0[3],P0[4],P0[5],     pw0[0]=PKW(P0,0), pw0[1]=PKW(P0,2), pw0); \
    GAPA(C1=__builtin_amdgcn_mfma_f32_32x32x16_bf16(kf[1],q0_,negm,0,0,0), P0[6],P0[7],P0[8],P0[9],     pw0[2]=PKW(P0,4), pw0[3]=PKW(P0,6), pw0); \
    GAPA(C0=__builtin_amdgcn_mfma_f32_32x32x16_bf16(kf[2],q1_,C0,0,0,0),   P0[10],P0[11],P0[12],P0[13], pw1[0]=PKW(P0,8), pw1[1]=PKW(P0,10), pw1); \
    GAPA(C1=__builtin_amdgcn_mfma_f32_32x32x16_bf16(kf[3],q1_,C1,0,0,0),   P0[14],P0[15],P1[0],P1[1],   pw1[2]=PKW(P0,12),pw1[3]=PKW(P0,14), pw1); \
    GAPA(C0=__builtin_amdgcn_mfma_f32_32x32x16_bf16(kf[4],q2_,C0,0,0,0),   P1[2],P1[3],P1[4],P1[5],     pw2[0]=PKW(P1,0), pw2[1]=PKW(P1,2), pw2); \
    GAPA(C1=__builtin_amdgcn_mfma_f32_32x32x16_bf16(kf[5],q2_,C1,0,0,0),   P1[6],P1[7],P1[8],P1[9],     pw2[2]=PKW(P1,4), pw2[3]=PKW(P1,6), pw2); \
    VRDF(fA,0); SBAR(); GAPA(C0=__builtin_amdgcn_mfma_f32_32x32x16_bf16(kf[6],q3_,C0,0,0,0),   P1[10],P1[11],P1[12],P1[13], pw3[0]=PKW(P1,8), pw3[1]=PKW(P1,10), pw3); \
    VRDF(fB,1); SBAR(); GAPA(C1=__builtin_amdgcn_mfma_f32_32x32x16_bf16(kf[7],q3_,C1,0,0,0),   P1[14],P1[15],0.f,0.f,       pw3[2]=PKW(P1,12),pw3[3]=PKW(P1,14), pw3); \
    l_reg+=sacc; \
    if(GK){DMA_K((t)+3,sl_cur);} if(GV){DMA_V((t)+1,sl_next);} \
    CMASK(C0,C1,t); \
    { float a=MX3(C0[0],C0[1],C1[0]),b=MX3(C0[2],C0[3],C1[1]); a=MX3(a,C1[2],C1[3]); \
      _Pragma("unroll") for(int r=4;r<16;r+=4){a=MX3(a,C0[r],C0[r+1]);b=MX3(b,C0[r+2],C0[r+3]);a=MX3(a,C1[r],C1[r+1]);b=MX3(b,C1[r+2],C1[r+3]);} \
      float rm=__builtin_fmaxf(a,b); { auto rr=__builtin_amdgcn_permlane32_swap(__float_as_uint(rm),__float_as_uint(rm),false,false); rm=__builtin_fmaxf(__uint_as_float(rr[0]),__uint_as_float(rr[1])); } \
      resc=false; \
      if(__builtin_expect(__any(rm>(float)THRL),0)){ const float dl=__builtin_fmaxf(rm,0.f); mhat+=dl; \
        _Pragma("unroll") for(int r=0;r<16;++r){C0[r]-=dl;C1[r]-=dl;} \
        _Pragma("unroll") for(int r=0;r<16;++r)negm[r]=-mhat; asm volatile("":"+v"(negm)); \
        const float f=__builtin_amdgcn_exp2f(-dl); l_reg*=f; if(hi==0)wsf[r32]=f; resc=true; } } \
    SBAR(); \
    VRDF(fC,2);  SBAR(); GAPB(o[0]=__builtin_amdgcn_mfma_f32_32x32x16_bf16(PAF(0),VFRF(fA),o[0],0,0,0), C0,0); \
    VRDF(fA,3);  SBAR(); GAPB(o[1]=__builtin_amdgcn_mfma_f32_32x32x16_bf16(PAF(0),VFRF(fB),o[1],0,0,0), C0,2); \
    VRDF(fB,4);  SBAR(); GAPB(o[2]=__builtin_amdgcn_mfma_f32_32x32x16_bf16(PAF(0),VFRF(fC),o[2],0,0,0), C0,4); \
    VRDF(fC,5);  SBAR(); GAPB(o[3]=__builtin_amdgcn_mfma_f32_32x32x16_bf16(PAF(0),VFRF(fA),o[3],0,0,0), C0,6); \
    VRDF(fA,6);  SBAR(); KRD(GL,0); GAPB(o[0]=__builtin_amdgcn_mfma_f32_32x32x16_bf16(PAF(1),VFRF(fB),o[0],0,0,0), C0,8); \
    VRDF(fB,7);  SBAR(); KRD(GL,1); GAPB(o[1]=__builtin_amdgcn_mfma_f32_32x32x16_bf16(PAF(1),VFRF(fC),o[1],0,0,0), C0,10); \
    VRDF(fC,8);  SBAR(); KRD(GL,2); GAPB(o[2]=__builtin_amdgcn_mfma_f32_32x32x16_bf16(PAF(1),VFRF(fA),o[2],0,0,0), C0,12); \
    VRDF(fA,9);  SBAR(); KRD(GL,3); GAPB(o[3]=__builtin_amdgcn_mfma_f32_32x32x16_bf16(PAF(1),VFRF(fB),o[3],0,0,0), C0,14); \
    VRDF(fB,10); SBAR(); GAPB(o[0]=__builtin_amdgcn_mfma_f32_32x32x16_bf16(PAF(2),VFRF(fC),o[0],0,0,0), C1,0); \
    VRDF(fC,11); SBAR(); GAPB(o[1]=__builtin_amdgcn_mfma_f32_32x32x16_bf16(PAF(2),VFRF(fA),o[1],0,0,0), C1,2); \
    VRDF(fA,12); SBAR(); GAPB(o[2]=__builtin_amdgcn_mfma_f32_32x32x16_bf16(PAF(2),VFRF(fB),o[2],0,0,0), C1,4); \
    VRDF(fB,13); SBAR(); GAPB(o[3]=__builtin_amdgcn_mfma_f32_32x32x16_bf16(PAF(2),VFRF(fC),o[3],0,0,0), C1,6); \
    VRDF(fC,14); SBAR(); GAPB(o[0]=__builtin_amdgcn_mfma_f32_32x32x16_bf16(PAF(3),VFRF(fA),o[0],0,0,0), C1,8); \
    VRDF(fA,15); SBAR(); GAPB(o[1]=__builtin_amdgcn_mfma_f32_32x32x16_bf16(PAF(3),VFRF(fB),o[1],0,0,0), C1,10); \
    GAPB(o[2]=__builtin_amdgcn_mfma_f32_32x32x16_bf16(PAF(3),VFRF(fC),o[2],0,0,0), C1,12); \
    GAPB(o[3]=__builtin_amdgcn_mfma_f32_32x32x16_bf16(PAF(3),VFRF(fA),o[3],0,0,0), C1,14); \
    }while(0)
  int t=1;
  #undef CMASK
  #define CMASK(P0,P1,t) do{}while(0)
  for(;t+5<NT;t+=2){
    STEP(pB0,pB1,pA0,pA1,t,true,true,true);     WAIT_BAR(3); RESC(); ROT();
    STEP(pA0,pA1,pB0,pB1,t+1,true,true,true);   WAIT_BAR(3); RESC(); ROT();
  }
  #undef CMASK
  #define CMASK(P0,P1,t) do{int jb_=(t)-(NT-4); if(jb_>=0)cmask(P0,P1,jb_,qrel,hi);}while(0)
  #define ENDW(tt) do{ if((tt)+3<NT){WAIT_BAR(3);} else if((tt)+2<NT){WAIT_BAR(2);} else {WAIT_BAR(0);} }while(0)
  for(;t+1<NT;t+=2){
    STEP(pB0,pB1,pA0,pA1,t,(t+3<NT),(t+1<NT),(t+1<NT));       ENDW(t);   RESC(); ROT();
    STEP(pA0,pA1,pB0,pB1,t+1,(t+4<NT),(t+2<NT),(t+2<NT));     ENDW(t+1); RESC(); ROT();
  }
  STEP(pB0,pB1,pA0,pA1,NT-1,false,false,false); RESC();
  { float sacc=pB0[0]+pB0[1]; _Pragma("unroll") for(int r=2;r<16;++r)sacc+=pB0[r]; _Pragma("unroll") for(int r=0;r<16;++r)sacc+=pB1[r]; l_reg+=sacc;
    pw0=(u32x4){PKW(pB0,0),PKW(pB0,2),PKW(pB0,4),PKW(pB0,6)};pw1=(u32x4){PKW(pB0,8),PKW(pB0,10),PKW(pB0,12),PKW(pB0,14)};pw2=(u32x4){PKW(pB1,0),PKW(pB1,2),PKW(pB1,4),PKW(pB1,6)};pw3=(u32x4){PKW(pB1,8),PKW(pB1,10),PKW(pB1,12),PKW(pB1,14)};
    SBAR(); pv(o,vb0+2*sl_cur,PAF(0),PAF(1),PAF(2),PAF(3)); }
  #undef PKW
  #undef PAF
  #undef VFRF
  #undef VRDF
  #undef PIN
  #undef MX3
  #undef GAPA
  #undef GAPB
  #undef EX
  #undef KRD
  #undef STEP
  #undef ENDW
  {auto rr=__builtin_amdgcn_permlane32_swap(__float_as_uint(l_reg),__float_as_uint(l_reg),false,false);l_reg=__uint_as_float(rr[0])+__uint_as_float(rr[1]);}
  if(hi==0)wsf[32+r32]=l_reg;asm volatile("s_waitcnt lgkmcnt(0)":::"memory");
  float rli[16];
  #pragma unroll
  for(int r=0;r<16;++r)rli[r]=__builtin_amdgcn_rcpf(wsf[32+crow(r,hi)]);
  bf16*Ow=O+(rowbase+q0+wid*QBLK)*DM+hv*D;
  { bf16*stg=(bf16*)(shm+LDS_OST)+wid*2048;
    #pragma unroll
    for(int pass=0;pass<2;++pass){
      #pragma unroll
      for(int r=0;r<16;++r){const int orow=crow(r,hi);
        #pragma unroll
        for(int d0=0;d0<2;++d0)stg[orow*64+d0*32+r32]=__float2bfloat16(o[2*pass+d0][r]*rli[r]);}
      asm volatile("s_waitcnt lgkmcnt(0)":::"memory");
      #pragma unroll
      for(int i=0;i<4;++i){const int row=i*8+(lane>>3),ch=lane&7; const u32x4 v=*(const u32x4*)(stg+row*64+ch*8); ATTN_STORE16(Ow+(long)row*DM+pass*64+ch*8,v);}
      asm volatile("s_waitcnt lgkmcnt(0)":::"memory"); } }
  __builtin_amdgcn_s_setprio(0);
  asm volatile("s_waitcnt lgkmcnt(0)\n\ts_barrier":::"memory");
  #undef DMA_K
  #undef DMA_V
  #undef CMASK
  #undef START
  #undef RESC
  #undef ROT
  #undef QL
}
constexpr int ATTN_LDS_BYTES=LDS_BYTES;
struct AttnTensors { const bf16* Q; const bf16* K; const bf16* V; bf16* O; };
struct AttnUnit { int bh; int qb; };
struct StaticOrder {
  int vcu;
  __device__ __forceinline__ explicit StaticOrder(int grid,int block):vcu((block%8)*(grid/8)+block/8){}
  __device__ __forceinline__ bool next(int i,AttnUnit&u)const{ if(i>=4)return false; const int s=vcu&7; u.bh=vcu>>3; u.qb=(i==0)?s:(i==1)?15-s:(i==2)?16+s:31-s; return true; }
  __device__ __forceinline__ void a_ready(const AttnUnit&)const{}
  __device__ __forceinline__ void done(const AttnUnit&)const{}
};
template<class Sched,int THRL=8> __device__ __forceinline__ void attn_phase(char*lds,const AttnTensors&T,const Sched&S){
  AttnUnit u;
  for(int i=0;S.next(i,u);++i){ S.a_ready(u); const int hq=u.bh&15, cm=hq&1; attn_unit<THRL>(u.bh>>4,hq,hq&~1,u.qb,T.Q,T.K,T.V,T.O+(size_t)cm*((size_t)16384*1024),lds); S.done(u); }
}
#undef SBAR
#undef WAIT_BAR
}
constexpr int NWAVES = 8, NTHR = 512;
constexpr int BATCH = 2, T = 8192, D = 1024, M = BATCH * T;
constexpr int EIN = 2816, FFN = 2816, NE = 8, ED = 3584;
constexpr int NPH = 23;
constexpr float MOE_WG_SCALE = 64.f, MOE_WD_SCALE = 128.f, MOE_H_SCALE = 8.f;
constexpr int MOE_GU_E8M0 = 0x79797979, MOE_DN_E8M0 = 0x75757575;
#ifndef LAST_PHASE
#define LAST_PHASE (NPH - 1)
#endif
#ifndef ONE_LAUNCH
#define ONE_LAUNCH 0
#endif

constexpr size_t KiB = 1024, MiB = 1u << 20;
constexpr size_t WS_CTL = 0, CTL_ZERO_BYTES = 192 * KiB;
constexpr size_t WS_WIN = 1 * MiB, WS_WOUT = WS_WIN + 5632 * KiB, WS_WGU = WS_WOUT + 2 * MiB, WS_WDN = WS_WGU + 11 * MiB, WS_WQKV = WS_WDN + 5632 * KiB, WS_WO = WS_WQKV + 6 * MiB;
static_assert(WS_WO + 2 * MiB == 33 * MiB, "weights map");
constexpr size_t WS_B2T = 33 * MiB, WS_BLRU = 34 * MiB;
constexpr size_t WS_XN = 35 * MiB;
constexpr size_t WS_LA = 35 * MiB, WS_LU = 51 * MiB;
constexpr size_t WS_PROJ = 67 * MiB;
constexpr size_t WS_Q = 67 * MiB, WS_K = 99 * MiB, WS_V = 131 * MiB;
constexpr size_t WS_XC = 155 * MiB;
constexpr size_t WS_SINIT = 155 * MiB;
constexpr size_t WS_A2 = 171 * MiB;
constexpr size_t WS_G1 = 179 * MiB;
constexpr size_t WS_G2 = 227 * MiB;
constexpr size_t WS_PL = 227 * MiB, WS_ORAW = 227 * MiB;
constexpr size_t WS_OA0 = 163 * MiB, WS_OA1 = 195 * MiB, WS_AO = 227 * MiB;
constexpr size_t WS_REC4 = 259 * MiB;
constexpr size_t WS_Y = 259 * MiB;
constexpr size_t WS_REC2 = 387 * MiB;
constexpr size_t WS_SMALL = 451 * MiB;
constexpr size_t WS_BS = WS_SMALL, WS_LSA = WS_SMALL + 1 * MiB, WS_LSH = WS_SMALL + 3 * MiB, WS_LC = WS_SMALL + 5 * MiB;
constexpr size_t WS_LIST = WS_SMALL, WS_TOKI = WS_SMALL + 512 * KiB, WS_TOKG = WS_SMALL + 1024 * KiB;
constexpr size_t WS_WGUM = 291 * MiB, WS_WDM = 347 * MiB;
constexpr size_t WS_XNM = 1 * MiB;
constexpr size_t WS_HM2 = 33 * MiB;
constexpr size_t WS_Y2 = 271 * MiB;
constexpr size_t WS_PART = 155 * MiB;
constexpr size_t WS_XR = WS_REC2;
constexpr size_t WS_RS1 = 65536, WS_RS2 = 131072;
constexpr size_t WS_END = 458 * MiB;
static_assert(WS_HM2 + (size_t)34816 * 3584 * 2 <= WS_WGUM && WS_WDM + (size_t)8 * 1024 * 3584 * 2 <= WS_SMALL && WS_Y2 + (size_t)34816 * 1024 * 2 <= WS_WDM, "MoE map");
constexpr int CW_BAR = 4096, CW_CNT = 8192, CW_SPL = 12288;
constexpr int RING_BYTES = 131072, MISC_OFF = RING_BYTES + 320, LDS_BYTES = 147456;

#define XB_TMO      128
#define XB_XCNT(j)  (256  + 64 * (j))
#define XB_XSUB(j)  (1280 + 64 * (j))
#define XB_XGEN(j)  (2304 + 64 * (j))
#define XB_TOP      3328
#define XB_TOPGEN   3392
#define XCD_BAR_WORDS 3456
#define XB_SPIN_CAP (1u << 18)
__device__ __forceinline__ unsigned xb_ld(unsigned* p)              { return __hip_atomic_load(p, __ATOMIC_RELAXED, __HIP_MEMORY_SCOPE_AGENT); }
__device__ __forceinline__ unsigned xb_add(unsigned* p, unsigned v) { return __hip_atomic_fetch_add(p, v, __ATOMIC_RELAXED, __HIP_MEMORY_SCOPE_AGENT); }
__device__ __forceinline__ unsigned xb_xcc_id() { return (unsigned)__builtin_amdgcn_s_getreg((3 << 11) | 20) & 0xFu; }
#define XB_SPIN(cond, bar) do { unsigned _sp = 0; while (cond) { __builtin_amdgcn_s_sleep(1); \
    if ((++_sp & 255u) == 0u) { if (xb_ld(&(bar)[XB_TMO])) break; if (_sp > XB_SPIN_CAP) { atomicAdd(&(bar)[XB_TMO], 1u); break; } } } } while (0)
struct XcdBarrier { unsigned* bar; unsigned x; volatile LAS unsigned* st; };
__device__ __forceinline__ XcdBarrier xcd_barrier_post(unsigned* bar, volatile LAS unsigned* st) {
    XcdBarrier b; b.bar = bar; b.x = xb_xcc_id(); b.st = st;
    if (threadIdx.x == 0) (void)xb_add(&bar[XB_XCNT(b.x)], 1u);
    return b;
}
__device__ __forceinline__ void xcd_barrier_complete(unsigned* bar, unsigned x, unsigned& nloc, unsigned& nx) {
    const unsigned G = gridDim.x * gridDim.y * gridDim.z;
    unsigned sum, cnt, mine, sp = 0u;
    for (;;) {
        sum = 0u; cnt = 0u; mine = 0u;
#pragma unroll
        for (unsigned j = 0; j < 16; ++j) { const unsigned c = xb_ld(&bar[XB_XCNT(j)]); sum += c; cnt += (c > 0u) ? 1u : 0u; mine = (j == x) ? c : mine; }
        if (sum == G) break;
        __builtin_amdgcn_s_sleep(1);
        if ((++sp & 255u) == 0u) { if (xb_ld(&bar[XB_TMO])) break; if (sp > XB_SPIN_CAP) { atomicAdd(&bar[XB_TMO], 1u); break; } }
    }
    nloc = mine > 0u ? mine : 1u; nx = cnt > 0u ? cnt : 1u;
}
__device__ __forceinline__ void xcd_barrier(const XcdBarrier& b) {
    asm volatile("s_waitcnt vmcnt(0)" ::: "memory");
    __syncthreads();
    if (threadIdx.x == 0) {
        unsigned* bar = b.bar;
        __builtin_amdgcn_s_waitcnt(0);
        unsigned nloc = b.st[0], nx = b.st[1];
        if (nloc == 0u) { xcd_barrier_complete(bar, b.x, nloc, nx); b.st[0] = nloc; b.st[1] = nx; }
        const unsigned old = xb_add(&bar[XB_XSUB(b.x)], 1u);
        const unsigned gen = old / nloc;
        if (old + 1u == (gen + 1u) * nloc) {
            __builtin_amdgcn_fence(__ATOMIC_RELEASE, "agent");
            asm volatile("s_waitcnt vmcnt(0)" ::: "memory");
            const unsigned og = xb_add(&bar[XB_TOP], 1u);
            const unsigned tg = og / nx;
            if (og + 1u == (tg + 1u) * nx) xb_add(&bar[XB_TOPGEN], 1u);
            else XB_SPIN(xb_ld(&bar[XB_TOPGEN]) == tg, bar);
            __builtin_amdgcn_fence(__ATOMIC_ACQUIRE, "agent");
            xb_add(&bar[XB_XGEN(b.x)], 1u);
            asm volatile("s_waitcnt vmcnt(0)" ::: "memory");
        } else {
            XB_SPIN(xb_ld(&bar[XB_XGEN(b.x)]) == gen, bar);
            __builtin_amdgcn_fence(__ATOMIC_ACQUIRE, "agent");
            asm volatile("s_waitcnt vmcnt(0)" ::: "memory");
        }
    }
    __syncthreads();
}

#ifndef FLAT_BAR
#define FLAT_BAR 0
#endif
constexpr int CW_SLOT = 14336;
__device__ __forceinline__ void flat_barrier(unsigned* slots, unsigned gen) {
    asm volatile("s_waitcnt vmcnt(0)" ::: "memory");
    __syncthreads();
    if (threadIdx.x < 64) {
        const unsigned G = gridDim.x, lane = threadIdx.x;
        if (lane == 0) { __builtin_amdgcn_fence(__ATOMIC_RELEASE, "agent"); __hip_atomic_store(&slots[blockIdx.x], gen, __ATOMIC_RELAXED, __HIP_MEMORY_SCOPE_AGENT); }
        unsigned sp = 0u;
        for (;;) {
            bool ok = true;
            for (unsigned i = lane; i < G; i += 64u) ok = ok && (__hip_atomic_load(&slots[i], __ATOMIC_RELAXED, __HIP_MEMORY_SCOPE_AGENT) >= gen);
            if (__all(ok)) break;
            __builtin_amdgcn_s_sleep(1);
            if (++sp > XB_SPIN_CAP) break;
        }
        __builtin_amdgcn_fence(__ATOMIC_ACQUIRE, "agent");
    }
    __syncthreads();
}
#define XB_XSLOT 3520
__device__ __forceinline__ void xcd_barrier2(const XcdBarrier& b) {
    asm volatile("s_waitcnt vmcnt(0)" ::: "memory");
    __syncthreads();
    if (threadIdx.x < 64) {
        unsigned* bar = b.bar; const unsigned lane = threadIdx.x;
        unsigned gen = 0u;
        if (lane == 0) {
            __builtin_amdgcn_s_waitcnt(0);
            unsigned nloc = b.st[0], nx = b.st[1];
            if (nloc == 0u) { xcd_barrier_complete(bar, b.x, nloc, nx); b.st[0] = nloc; b.st[1] = nx;
                unsigned mask = 0u;
#pragma unroll
                for (unsigned j = 0; j < 16; ++j) mask |= (xb_ld(&bar[XB_XCNT(j)]) > 0u) ? (1u << j) : 0u;
                b.st[2] = mask; }
            const unsigned old = xb_add(&bar[XB_XSUB(b.x)], 1u);
            const unsigned g0 = old / nloc; gen = g0 + 1u;
            if (old + 1u == gen * nloc) {
                __builtin_amdgcn_fence(__ATOMIC_RELEASE, "agent");
                asm volatile("s_waitcnt vmcnt(0)" ::: "memory");
                __hip_atomic_store(&bar[XB_XSLOT + b.x], gen, __ATOMIC_RELAXED, __HIP_MEMORY_SCOPE_AGENT);
            }
        }
        gen = __builtin_amdgcn_readfirstlane(gen);
        asm volatile("s_waitcnt lgkmcnt(0)" ::: "memory");
        const unsigned mask = b.st[2];
        const bool need = lane < 16u && ((mask >> lane) & 1u);
        unsigned sp = 0u;
        for (;;) {
            const bool ok = !need || xb_ld(&bar[XB_XSLOT + (lane & 15u)]) >= gen;
            if (__all(ok)) break;
            __builtin_amdgcn_s_sleep(1);
            if (++sp > XB_SPIN_CAP) break;
        }
        __builtin_amdgcn_fence(__ATOMIC_ACQUIRE, "agent");
    }
    __syncthreads();
}
#if FLAT_BAR == 2
#define GRID_BARRIER(b) xcd_barrier2(b)
#elif FLAT_BAR
#define GRID_BARRIER(b) flat_barrier(ctl + CW_SLOT, ++bar_gen)
#else
#define GRID_BARRIER(b) xcd_barrier(b)
#endif

#ifndef P21_SPLIT_EN
#define P21_SPLIT_EN 1
#endif
#define P21_CNT_OFF 0
#define P21_TAIL_EN 1
#ifndef PROBE_BUILD
#define PROBE_BUILD 0
#endif
#ifndef REPMASK
#define REPMASK 0u
#endif
#if PROBE_BUILD
struct Args { const void* in[42]; float* out; unsigned char* ws; int ph_lo, ph_hi; unsigned repmask; unsigned pad; };
#else
struct Args { const void* in[42]; float* out; unsigned char* ws; int ph_lo, ph_hi; };
#endif
struct Ctx { LAS unsigned char* lds; unsigned char* ws; int tid, lane, wave, G, bx, vcu, gw, ngw; };
#define INF(k) ((const float*)a.in[k])
enum { I_X = 0, I_POS, I_ELNMIX, I_EWIN, I_CONVW, I_CONVB, I_GAW, I_GAB, I_GXW, I_GXB, I_LAM, I_MU, I_W0, I_W2, I_A0, I_A2, I_G2, I_KK, I_KA, I_RK, I_GNW, I_GNB, I_EWOUT, I_ELNFFN,
       I_FFG, I_FFU, I_FFD, I_OLNMIX, I_WQKV, I_QNORM, I_KNORM, I_LQ1, I_LK1, I_LQ2, I_LK2, I_SUBLN, I_WO, I_OLNFFN, I_ROUTER, I_MOEG, I_MOEU, I_MOED };

__device__ __forceinline__ void transpose_item(const float* __restrict__ W, int K, int N, bf16* __restrict__ WT, int mode, LAS float* scr, int item, int lane, const float* __restrict__ ks = nullptr) {
    const int nblk = N / 32, kb = item / nblk, nb = item % nblk, k0 = 64 * kb, n0 = 32 * nb;
#pragma unroll 8
    for (int i = 0; i < 32; ++i) { const int kk = 2 * i + (lane >> 5); scr[kk * 33 + (lane & 31)] = W[(size_t)(k0 + kk) * N + n0 + (lane & 31)] * (ks ? ks[k0 + kk] : 1.0f); }
    asm volatile("s_waitcnt lgkmcnt(0)" ::: "memory");
    const int rb = mode == 0 ? n0 : (256 * (n0 >> 7) + 2 * (n0 & 127) + (mode == 2 ? 32 : 0));
    const int c = lane & 7;
#pragma unroll
    for (int j = 0; j < 4; ++j) { const int n = (lane >> 3) + 8 * j; const LAS float* s = scr + (8 * c) * 33 + n;
        u32x4 o; o.x = cvt_pk_bf16(s[0 * 33], s[1 * 33]); o.y = cvt_pk_bf16(s[2 * 33], s[3 * 33]); o.z = cvt_pk_bf16(s[4 * 33], s[5 * 33]); o.w = cvt_pk_bf16(s[6 * 33], s[7 * 33]);
        *(u32x4*)(WT + (size_t)(rb + n) * K + k0 + 8 * c) = o; }
    asm volatile("s_waitcnt lgkmcnt(0)" ::: "memory");
}
__device__ __forceinline__ void transpose_item8(const float* __restrict__ W, int K, int N, unsigned char* __restrict__ WT, int mode, float wscale, LAS float* scr, int item, int lane) {
    const int nblk = N / 32, kb = item / nblk, nb = item % nblk, k0 = 64 * kb, n0 = 32 * nb;
#pragma unroll 8
    for (int i = 0; i < 32; ++i) { const int kk = 2 * i + (lane >> 5); scr[kk * 33 + (lane & 31)] = W[(size_t)(k0 + kk) * N + n0 + (lane & 31)] * wscale; }
    asm volatile("s_waitcnt lgkmcnt(0)" ::: "memory");
    const int rb = mode == 0 ? n0 : (256 * (n0 >> 7) + 2 * (n0 & 127) + (mode == 2 ? 32 : 0));
    const int c = lane & 7;
#pragma unroll
    for (int j = 0; j < 4; ++j) { const int n = (lane >> 3) + 8 * j; const LAS float* s = scr + (8 * c) * 33 + n;
        u32x2 o; o.x = pg8::pk4_fp8(s[0 * 33], s[1 * 33], s[2 * 33], s[3 * 33]); o.y = pg8::pk4_fp8(s[4 * 33], s[5 * 33], s[6 * 33], s[7 * 33]);
        *(u32x2*)(WT + (size_t)(rb + n) * K + k0 + 8 * c) = o; }
    asm volatile("s_waitcnt lgkmcnt(0)" ::: "memory");
}
__device__ __forceinline__ f32x4 ld_x4(const float* row, int idx) { return ((const f32x4*)row)[idx]; }
__device__ __forceinline__ f32x4 ld_x4(const bf16* row, int idx) { const u32x2 w = ((const u32x2*)row)[idx]; return (f32x4){bflo(w.x), bfhi(w.x), bflo(w.y), bfhi(w.y)}; }
template <class XT> __device__ __forceinline__ void rms_row_bf16(const XT* __restrict__ xrow, const float* __restrict__ g, bf16* __restrict__ orow, int lane) {
    f32x4 v[4]; float s = 0.f;
#pragma unroll
    for (int j = 0; j < 4; ++j) { v[j] = ld_x4(xrow, lane + 64 * j); s += (v[j].x * v[j].x + v[j].y * v[j].y) + (v[j].z * v[j].z + v[j].w * v[j].w); }
    const float r = rsqrtf(wave_sum(s) * (1.0f / 1024.0f) + 1e-6f);
#pragma unroll
    for (int j = 0; j < 4; ++j) { const f32x4 gv = ((const f32x4*)g)[lane + 64 * j]; const f32x4 o = v[j] * r * gv;
        u32x2 w; w.x = cvt_pk_bf16(o.x, o.y); w.y = cvt_pk_bf16(o.z, o.w); ((u32x2*)orow)[lane + 64 * j] = w; }
}
__device__ __forceinline__ void rowstat_phase(const Ctx& c, const bf16* x, float* RS) {
    for (int m = c.gw; m < M; m += c.ngw) { float s = 0.f;
#pragma unroll
        for (int j = 0; j < 2; ++j) { float f[8]; unpack8(((const u32x4*)(x + (size_t)m * D))[c.lane + 64 * j], f);
#pragma unroll
            for (int e = 0; e < 8; ++e) s += f[e] * f[e]; }
        s = wave_sum(s);
        if (c.lane == 0) RS[m] = rsqrtf(s * (1.0f / 1024.0f) + 1e-6f); }
}
template <class XT> __device__ __forceinline__ void rms_rows_phase(const Ctx& c, const XT* x, const float* g, bf16* out) {
    for (int m = c.gw; m < M; m += c.ngw) rms_row_bf16(x + (size_t)m * D, g, out + (size_t)m * D, c.lane);
}
__device__ __forceinline__ void moe_convert(const Ctx& c, const Args& a, int which, int e_lo = 0, int e_hi = NE, int gw = -1, int ngw = 0) {
    if (gw < 0) { gw = c.gw; ngw = c.ngw; }
    LAS float* scr = (LAS float*)(c.lds + c.wave * 16384);
    unsigned char* WG = (unsigned char*)(c.ws + WS_WGUM); unsigned char* WD = (unsigned char*)(c.ws + WS_WDM);
    if (which < 2) { constexpr int IPE = (D / 64) * (ED / 32);
        const float* W = INF(which == 0 ? I_MOEG : I_MOEU);
        for (int it = e_lo * IPE + gw; it < e_hi * IPE; it += ngw) { const int e = it / IPE, r = it % IPE;
            transpose_item8(W + (size_t)e * D * ED, D, ED, WG + (size_t)e * 2 * ED * D, 1 + which, MOE_WG_SCALE, scr, r, c.lane); }
    } else { constexpr int IPE = (ED / 64) * (D / 32);
        const float* W = INF(I_MOED);
        for (int it = e_lo * IPE + gw; it < e_hi * IPE; it += ngw) { const int e = it / IPE, r = it % IPE;
            transpose_item8(W + (size_t)e * ED * D, ED, D, WD + (size_t)e * D * ED, 0, MOE_WD_SCALE, scr, r, c.lane); }
    }
}
constexpr int P6_BUSY = 96, P6_MOE_E = 5, P6_MOE_U = 0, P11_MOE_U = 4, P17_MOE_D = 4;
__device__ __forceinline__ void convert_rest(const Ctx& c, const Args& a, int gw, int ngw) {
    LAS float* scr = (LAS float*)(c.lds + c.wave * 16384);
    constexpr int I_SQ = (D / 64) * (D / 32), I_FF = (D / 64) * (FFN / 32), I_DN = (FFN / 64) * (D / 32), I_QKV = (D / 64) * (3072 / 32);
    constexpr int NITEMS = I_SQ + 2 * I_FF + I_DN + I_QKV + I_SQ;
    for (int it = gw; it < NITEMS; it += ngw) {
        int r = it;
        if (r < I_SQ) { transpose_item(INF(I_EWOUT), D, D, (bf16*)(c.ws + WS_WOUT), 0, scr, r, c.lane); continue; } r -= I_SQ;
        if (r < I_FF) { transpose_item(INF(I_FFG), D, FFN, (bf16*)(c.ws + WS_WGU), 1, scr, r, c.lane, INF(I_ELNFFN)); continue; } r -= I_FF;
        if (r < I_FF) { transpose_item(INF(I_FFU), D, FFN, (bf16*)(c.ws + WS_WGU), 2, scr, r, c.lane, INF(I_ELNFFN)); continue; } r -= I_FF;
        if (r < I_DN) { transpose_item(INF(I_FFD), FFN, D, (bf16*)(c.ws + WS_WDN), 0, scr, r, c.lane); continue; } r -= I_DN;
        if (r < I_QKV) { transpose_item(INF(I_WQKV), D, 3072, (bf16*)(c.ws + WS_WQKV), 0, scr, r, c.lane, INF(I_OLNMIX)); continue; } r -= I_QKV;
        transpose_item(INF(I_WO), D, D, (bf16*)(c.ws + WS_WO), 0, scr, r, c.lane);
    }
}
__device__ __forceinline__ void phase0(const Ctx& c, const Args& a) {
    LAS float* scr = (LAS float*)(c.lds + c.wave * 16384);
    constexpr int I_IN = (D / 64) * (EIN / 32);
    for (int it = c.gw; it < I_IN; it += c.ngw) transpose_item(INF(I_EWIN), D, EIN, (bf16*)(c.ws + WS_WIN), 0, scr, it, c.lane);
    if (c.G <= P6_BUSY) convert_rest(c, a, c.gw, c.ngw);
    { const float* w2 = INF(I_W2); const float* a2 = INF(I_A2); const float* g2 = INF(I_G2); const float* wa = INF(I_GAW); const float* wx = INF(I_GXW);
      bf16* B2 = (bf16*)(c.ws + WS_B2T); bf16* BL = (bf16*)(c.ws + WS_BLRU);
      constexpr int N1 = 1536 * 32, N2 = 1024 * 64;
      for (int id = c.bx * NTHR + c.tid; id < N1 + N2; id += c.G * NTHR) {
          float f[8];
          if (id < N1) { const int n = id >> 5, k0 = (id & 31) * 8;
#pragma unroll
              for (int e = 0; e < 8; ++e) { const int k = k0 + e; float v = 0.f;
                  if (n < 512) { if (k < 64) v = w2[k * 512 + n]; }
                  else if (n < 1024) { if (k >= 64 && k < 128) v = a2[(k - 64) * 512 + (n - 512)]; }
                  else { if (k >= 128) v = g2[(k - 128) * 512 + (n - 1024)]; }
                  f[e] = v; }
              *(u32x4*)(B2 + (size_t)n * 256 + k0) = pack8(f);
          } else { const int id2 = id - N1, n = id2 >> 6, k0 = (id2 & 63) * 8; const int nn = n & 511, hd = nn >> 6, j = nn & 63; const float* w = n < 512 ? wa : wx;
#pragma unroll
              for (int e = 0; e < 8; ++e) { const int k = k0 + e; f[e] = ((k >> 6) == hd) ? w[(hd * 64 + (k & 63)) * 64 + j] : 0.f; }
              *(u32x4*)(BL + (size_t)n * 512 + k0) = pack8(f);
          }
      } }
    rms_rows_phase(c, INF(I_X), INF(I_ELNMIX), (bf16*)(c.ws + WS_XN));
}

__device__ __forceinline__ void phase2(const Ctx& c, const Args& a) {
    const bf16* P = (const bf16*)(c.ws + WS_PROJ); bf16* XC = (bf16*)(c.ws + WS_XC); bf16* A2 = (bf16*)(c.ws + WS_A2);
    const int c0 = 8 * c.lane;
    float cw[4][8], cb[8], mu[8];
#pragma unroll
    for (int j = 0; j < 4; ++j)
#pragma unroll
        for (int e = 0; e < 8; ++e) cw[j][e] = INF(I_CONVW)[j * 512 + c0 + e];
#pragma unroll
    for (int e = 0; e < 8; ++e) { cb[e] = INF(I_CONVB)[c0 + e]; mu[e] = INF(I_MU)[1536 + ((8 * c.lane) & 255) + e]; }
    for (int m = c.gw; m < M; m += c.ngw) {
        const int t = m & (T - 1);
        float acc[8];
#pragma unroll
        for (int e = 0; e < 8; ++e) acc[e] = cb[e];
#pragma unroll
        for (int j = 0; j < 4; ++j) { if (t - 3 + j >= 0) { float x[8]; unpack8(*(const u32x4*)(P + (size_t)(m - 3 + j) * EIN + c0), x);
#pragma unroll
                for (int e = 0; e < 8; ++e) acc[e] += cw[j][e] * x[e]; } }
        *(u32x4*)(XC + (size_t)m * 512 + c0) = pack8(acc);
        if (c.lane < 32) { const int col = 1024 + 1536 + 8 * c.lane; float p[8], pp[8], o[8];
            unpack8(*(const u32x4*)(P + (size_t)m * EIN + col), p);
            if (t > 0) unpack8(*(const u32x4*)(P + (size_t)(m - 1) * EIN + col), pp); else {
#pragma unroll
                for (int e = 0; e < 8; ++e) pp[e] = 0.f; }
#pragma unroll
            for (int e = 0; e < 8; ++e) { const float s = p[e] + (pp[e] - p[e]) * mu[e]; o[e] = c.lane < 8 ? tanhf_(s) : (c.lane < 16 ? s : sigmoidf_(s)); }
            *(u32x4*)(A2 + (size_t)m * 256 + 8 * c.lane) = pack8(o); }
    }
}

template <int MODE> __device__ __forceinline__ void phase4(const Ctx& c, const Args& a) {
    const bf16* __restrict__ P = (const bf16*)(c.ws + WS_PROJ); const bf16* __restrict__ G1 = (const bf16*)(c.ws + WS_G1);
    float* __restrict__ R4 = (float*)(c.ws + WS_REC4); float* __restrict__ R2 = (float*)(c.ws + WS_REC2); float* __restrict__ BS = (float*)(c.ws + WS_BS);
    if (MODE != 2) {
        const int hd = c.lane >> 3, c8 = c.lane & 7, ch = 64 * hd + 4 * c8;
        float mur[8], muk[8], muv[8], w0[8], a0[8], kkw[8], kaw[8], rkw[8];
#pragma unroll
        for (int e = 0; e < 8; ++e) { const int cc = ch + (e & 3) + 32 * (e >> 2); mur[e] = INF(I_MU)[cc]; muk[e] = INF(I_MU)[512 + cc]; muv[e] = INF(I_MU)[1024 + cc]; w0[e] = INF(I_W0)[cc]; a0[e] = INF(I_A0)[cc];
            kkw[e] = INF(I_KK)[cc]; kaw[e] = INF(I_KA)[cc]; rkw[e] = INF(I_RK)[cc]; }
        for (int m0 = c.gw; m0 < M; m0 += 2 * c.ngw) {
            u32x2 lr[2][2], lk[2][2], lv[2][2], lrp[2][2], lkp[2][2], lvp[2][2], lw[2][2], la[2][2];
#pragma unroll
            for (int u = 0; u < 2; ++u) { const int m = m0 + u * c.ngw; const int t = m & (T - 1); const bf16* pr = P + (size_t)m * EIN + 1024 + ch; const bf16* g1 = G1 + (size_t)m * 1536 + ch;
#pragma unroll
                for (int h2 = 0; h2 < 2; ++h2) { lr[u][h2] = *(const u32x2*)(pr + 32 * h2); lk[u][h2] = *(const u32x2*)(pr + 512 + 32 * h2); lv[u][h2] = *(const u32x2*)(pr + 1024 + 32 * h2);
                    lw[u][h2] = *(const u32x2*)(g1 + 32 * h2); la[u][h2] = *(const u32x2*)(g1 + 512 + 32 * h2);
                    if (t > 0) { lrp[u][h2] = *(const u32x2*)(pr - EIN + 32 * h2); lkp[u][h2] = *(const u32x2*)(pr - EIN + 512 + 32 * h2); lvp[u][h2] = *(const u32x2*)(pr - EIN + 1024 + 32 * h2); }
                    else { lrp[u][h2] = (u32x2){0u, 0u}; lkp[u][h2] = (u32x2){0u, 0u}; lvp[u][h2] = (u32x2){0u, 0u}; } } }
#pragma unroll
            for (int u = 0; u < 2; ++u) { const int m = m0 + u * c.ngw; const int t = m & (T - 1), b = m >> 13;
                float r[8], k[8], v[8], dec[8], kk[8], bb[8], k2[8]; float n2 = 0.f, bon = 0.f;
#pragma unroll
                for (int e = 0; e < 8; ++e) { const int h2 = e >> 2, p = (e >> 1) & 1, od = e & 1;
#define UNP_(L) (od ? bfhi(p ? L[u][h2].y : L[u][h2].x) : bflo(p ? L[u][h2].y : L[u][h2].x))
                    const float r0 = UNP_(lr), k0 = UNP_(lk), v0 = UNP_(lv), rp = UNP_(lrp), kp = UNP_(lkp), vp = UNP_(lvp), wpre = UNP_(lw), apre = UNP_(la);
#undef UNP_
                    r[e] = r0 + (rp - r0) * mur[e]; k[e] = k0 + (kp - k0) * muk[e]; v[e] = v0 + (vp - v0) * muv[e];
                    const float z = w0[e] + wpre;
                    const float wlog = -__logf(1.0f + __expf(-z)) - 0.5f;
                    dec[e] = __expf(-__expf(wlog));
                    const float av = sigmoidf_(a0[e] + apre);
                    kk[e] = k[e] * kkw[e]; n2 += kk[e] * kk[e];
                    k2[e] = k[e] * (1.0f + (av - 1.0f) * kaw[e]);
                    bb[e] = av;
                    bon += r[e] * k2[e] * rkw[e];
                }
                n2 += __shfl_xor(n2, 1); n2 += __shfl_xor(n2, 2); n2 += __shfl_xor(n2, 4);
                bon += __shfl_xor(bon, 1); bon += __shfl_xor(bon, 2); bon += __shfl_xor(bon, 4);
                const float inv = 1.0f / fmaxf(sqrtf(n2), 1e-12f);
#pragma unroll
                for (int e = 0; e < 8; ++e) { kk[e] *= inv; bb[e] *= kk[e]; }
                const size_t rec = ((size_t)(b * 8 + hd) * T + t);
                float* q4 = R4 + rec * 256 + 4 * c8; float* q2 = R2 + rec * 128 + 4 * c8;
                *(f32x4*)(q4) = (f32x4){dec[0], dec[1], dec[2], dec[3]}; *(f32x4*)(q4 + 32) = (f32x4){dec[4], dec[5], dec[6], dec[7]};
                *(f32x4*)(q4 + 64) = (f32x4){kk[0], kk[1], kk[2], kk[3]}; *(f32x4*)(q4 + 96) = (f32x4){kk[4], kk[5], kk[6], kk[7]};
                *(f32x4*)(q4 + 128) = (f32x4){bb[0], bb[1], bb[2], bb[3]}; *(f32x4*)(q4 + 160) = (f32x4){bb[4], bb[5], bb[6], bb[7]};
                *(f32x4*)(q4 + 192) = (f32x4){k2[0], k2[1], k2[2], k2[3]}; *(f32x4*)(q4 + 224) = (f32x4){k2[4], k2[5], k2[6], k2[7]};
                *(f32x4*)(q2) = (f32x4){r[0], r[1], r[2], r[3]}; *(f32x4*)(q2 + 32) = (f32x4){r[4], r[5], r[6], r[7]};
                *(f32x4*)(q2 + 64) = (f32x4){v[0], v[1], v[2], v[3]}; *(f32x4*)(q2 + 96) = (f32x4){v[4], v[5], v[6], v[7]};
                if (c8 == 0) BS[(size_t)m * 8 + hd] = bon;
            }
        }
    }
    if (MODE != 1) {
        const bf16* __restrict__ G2 = (const bf16*)(c.ws + WS_G2); const bf16* __restrict__ XC = (const bf16*)(c.ws + WS_XC);
        bf16* __restrict__ HL = (bf16*)(c.ws + WS_LA); bf16* __restrict__ CP = (bf16*)(c.ws + WS_LU); float* __restrict__ LSA = (float*)(c.ws + WS_LSA); float* __restrict__ LSH = (float*)(c.ws + WS_LSH);
        for (int item = c.gw; item < M / 8; item += c.ngw) {
            const int tile = item >> 1, ch = 256 * (item & 1) + 4 * c.lane;
            float ba[4], bxb[4], sp[4];
#pragma unroll
            for (int e = 0; e < 4; ++e) { ba[e] = INF(I_GAB)[ch + e]; bxb[e] = INF(I_GXB)[ch + e]; sp[e] = log1pf(__expf(-INF(I_LAM)[ch + e])); }
            float h[4], sl[4];
#pragma unroll
            for (int e = 0; e < 4; ++e) { h[e] = 0.f; sl[e] = 0.f; }
#pragma unroll 4
            for (int tt = 0; tt < 16; ++tt) { const size_t m = (size_t)tile * 16 + tt;
                const u32x2 gaq = *(const u32x2*)(G2 + m * 1024 + ch), gxq = *(const u32x2*)(G2 + m * 1024 + 512 + ch), xcq = *(const u32x2*)(XC + m * 512 + ch);
                const float ga[4] = {bflo(gaq.x), bfhi(gaq.x), bflo(gaq.y), bfhi(gaq.y)}, gx[4] = {bflo(gxq.x), bfhi(gxq.x), bflo(gxq.y), bfhi(gxq.y)}, xc[4] = {bflo(xcq.x), bfhi(xcq.x), bflo(xcq.y), bfhi(xcq.y)};
                float ho[4], co[4];
#pragma unroll
                for (int e = 0; e < 4; ++e) {
                    const float la = -8.0f * sigmoidf_(ga[e] + ba[e]) * sp[e];
                    const float x2 = 2.0f * la;
                    const float em = x2 < -0.5f ? 1.0f - __expf(x2) : -x2 * (1.0f + x2 * (0.5f + x2 * (0.16666667f + x2 * (0.041666668f + x2 * (0.0083333338f + x2 * 0.0013888889f)))));
                    const float u = sqrtf(fmaxf(em, 0.f)) * sigmoidf_(gx[e] + bxb[e]) * xc[e];
                    h[e] = __expf(la) * h[e] + u; sl[e] += la; ho[e] = h[e]; co[e] = __expf(sl[e]); }
                *(u32x2*)(HL + m * 512 + ch) = (u32x2){cvt_pk_bf16(ho[0], ho[1]), cvt_pk_bf16(ho[2], ho[3])}; *(u32x2*)(CP + m * 512 + ch) = (u32x2){cvt_pk_bf16(co[0], co[1]), cvt_pk_bf16(co[2], co[3])}; }
            *(f32x4*)(LSA + (size_t)tile * 512 + ch) = (f32x4){sl[0], sl[1], sl[2], sl[3]};
            *(f32x4*)(LSH + (size_t)tile * 512 + ch) = (f32x4){h[0], h[1], h[2], h[3]};
        }
    }
}

__device__ __forceinline__ float quad_sum(float v) {
    v += __builtin_bit_cast(float, __builtin_amdgcn_update_dpp(0, __builtin_bit_cast(int, v), 0xB1, 0xF, 0xF, true));
    v += __builtin_bit_cast(float, __builtin_amdgcn_update_dpp(0, __builtin_bit_cast(int, v), 0x4E, 0xF, 0xF, true));
    return v;
}
constexpr int SC_STEPS = 8, SC_TASK_BYTES = SC_STEPS * 1536, SC_BUF_BYTES = 4 * SC_TASK_BYTES;
__device__ __forceinline__ void scan_issue(const Ctx& c, int task0, int s) {
    const float* R4 = (const float*)(c.ws + WS_REC4); const float* R2 = (const float*)(c.ws + WS_REC2);
#pragma unroll
    for (int i = 0; i < 6; ++i) { const int id = c.wave * 6 + i, tk = id / 12, rem = id % 12; const int task = task0 + tk, bh = task >> 6, t0 = (task & 63) * 128 + s * SC_STEPS;
        const unsigned dst = (unsigned)((s & 1) * SC_BUF_BYTES + tk * SC_TASK_BYTES);
        if (rem < 8) __builtin_amdgcn_global_load_lds((const unsigned*)(R4 + ((size_t)bh * T + t0 + rem) * 256 + c.lane * 4), (LAS unsigned*)(c.lds + dst + rem * 1024), 16, 0, 0);
        else __builtin_amdgcn_global_load_lds((const unsigned*)(R2 + ((size_t)bh * T + t0 + 2 * (rem - 8)) * 128 + c.lane * 4), (LAS unsigned*)(c.lds + dst + 8192 + (rem - 8) * 1024), 16, 0, 0); }
}
#define LDS4(p) (*(const LAS f32x4*)(p))
__device__ __forceinline__ float oct_sum(float v) {
    v += __builtin_bit_cast(float, __builtin_amdgcn_update_dpp(0, __builtin_bit_cast(int, v), 0xB1, 0xF, 0xF, true));
    v += __builtin_bit_cast(float, __builtin_amdgcn_update_dpp(0, __builtin_bit_cast(int, v), 0x4E, 0xF, 0xF, true));
    v += __builtin_bit_cast(float, __builtin_amdgcn_update_dpp(0, __builtin_bit_cast(int, v), 0x141, 0xF, 0xF, true));
    return v;
}
__device__ __forceinline__ void oct_sum8(float (&x)[8]) {
#define OS8_STEP(ctrl) \
    "v_add_f32_dpp %0, %0, %0 " ctrl " row_mask:0xf bank_mask:0xf\n\tv_add_f32_dpp %1, %1, %1 " ctrl " row_mask:0xf bank_mask:0xf\n\t" \
    "v_add_f32_dpp %2, %2, %2 " ctrl " row_mask:0xf bank_mask:0xf\n\tv_add_f32_dpp %3, %3, %3 " ctrl " row_mask:0xf bank_mask:0xf\n\t" \
    "v_add_f32_dpp %4, %4, %4 " ctrl " row_mask:0xf bank_mask:0xf\n\tv_add_f32_dpp %5, %5, %5 " ctrl " row_mask:0xf bank_mask:0xf\n\t" \
    "v_add_f32_dpp %6, %6, %6 " ctrl " row_mask:0xf bank_mask:0xf\n\tv_add_f32_dpp %7, %7, %7 " ctrl " row_mask:0xf bank_mask:0xf\n\t"
    asm volatile("s_nop 1\n\t" OS8_STEP("quad_perm:[1,0,3,2]") OS8_STEP("quad_perm:[2,3,0,1]") OS8_STEP("row_half_mirror")
                 : "+v"(x[0]), "+v"(x[1]), "+v"(x[2]), "+v"(x[3]), "+v"(x[4]), "+v"(x[5]), "+v"(x[6]), "+v"(x[7]));
#undef OS8_STEP
}
struct ScanOps5 { f32x4 w[2], kk[2], bb[2], kp[2], rr[2], vv; };
__device__ __forceinline__ void scan_load5(ScanOps5& o, const LAS unsigned char* r4, const LAS unsigned char* r2r, const LAS unsigned char* r2v) {
    o.w[0] = LDS4(r4); o.w[1] = LDS4(r4 + 16); o.kk[0] = LDS4(r4 + 256); o.kk[1] = LDS4(r4 + 272); o.bb[0] = LDS4(r4 + 512); o.bb[1] = LDS4(r4 + 528); o.kp[0] = LDS4(r4 + 768); o.kp[1] = LDS4(r4 + 784);
    o.rr[0] = LDS4(r2r); o.rr[1] = LDS4(r2r + 16); o.vv = LDS4(r2v);
}
template <int MODE> __device__ __forceinline__ void phase5(const Ctx& c, float* __restrict__ YZ) {
    float* PL = (float*)(c.ws + WS_PL);
    const int tk = c.wave >> 1, half = c.wave & 1, rg = c.lane >> 3, q = c.lane & 7;
    for (int tg = c.bx; tg < 256; tg += c.G) {
        const int task0 = tg * 4;
        f32x2 Sp[4][4], Sl[4][4];
#pragma unroll
        for (int j = 0; j < 4; ++j)
#pragma unroll
            for (int i = 0; i < 4; ++i) { Sp[j][i] = (f32x2){(8 * q + 2 * i == 32 * half + 4 * rg + j) ? 1.f : 0.f, (8 * q + 2 * i + 1 == 32 * half + 4 * rg + j) ? 1.f : 0.f}; Sl[j][i] = (f32x2){0.f, 0.f}; }
        if (MODE != 2) scan_issue(c, task0, 0);
        asm volatile("s_waitcnt vmcnt(0)" ::: "memory"); __syncthreads();
        for (int s = 0; s < 16; ++s) {
            if (MODE != 2) { if (s + 1 < 16) scan_issue(c, task0, s + 1); }
            if (MODE != 1) {
            const LAS unsigned char* base = c.lds + (s & 1) * SC_BUF_BYTES + tk * SC_TASK_BYTES;
            const LAS unsigned char* r4b = base + q * 32; const LAS unsigned char* r2rb = base + 8192 + q * 32; const LAS unsigned char* r2b = base + 8192 + 256 + (32 * half + 4 * rg) * 4;
            float* yzp = YZ + ((size_t)((task0 + tk) >> 6) * T + ((task0 + tk) & 63) * 128 + s * SC_STEPS) * 128 + 32 * half + 4 * rg;
            ScanOps5 cur, nxt; scan_load5(cur, r4b, r2rb, r2b);
#pragma unroll 2
            for (int st = 0; st < SC_STEPS; ++st) {
                if (st + 1 < SC_STEPS) scan_load5(nxt, r4b + (st + 1) * 1024, r2rb + (st + 1) * 512, r2b + (st + 1) * 512);
                __builtin_amdgcn_sched_barrier(0);
                const f32x2 w2[4] = {cur.w[0].xy, cur.w[0].zw, cur.w[1].xy, cur.w[1].zw}, kk2[4] = {cur.kk[0].xy, cur.kk[0].zw, cur.kk[1].xy, cur.kk[1].zw};
                const f32x2 bb2[4] = {cur.bb[0].xy, cur.bb[0].zw, cur.bb[1].xy, cur.bb[1].zw}, kp2[4] = {cur.kp[0].xy, cur.kp[0].zw, cur.kp[1].xy, cur.kp[1].zw};
                float sp[4], sl[4];
#pragma unroll
                for (int j = 0; j < 4; ++j) { f32x2 a0 = Sp[j][0] * kk2[0], a1 = Sl[j][0] * kk2[0];
#pragma unroll
                    for (int i = 1; i < 4; ++i) { a0 = __builtin_elementwise_fma(Sp[j][i], kk2[i], a0); a1 = __builtin_elementwise_fma(Sl[j][i], kk2[i], a1); }
                    sp[j] = -oct_sum(a0.x + a0.y); sl[j] = -oct_sum(a1.x + a1.y); }
#pragma unroll
                for (int j = 0; j < 4; ++j) { const f32x2 vj = {cur.vv[j], cur.vv[j]}, spj = {sp[j], sp[j]}, slj = {sl[j], sl[j]};
#pragma unroll
                    for (int i = 0; i < 4; ++i) { Sp[j][i] = __builtin_elementwise_fma(Sp[j][i], w2[i], spj * bb2[i]);
                        Sl[j][i] = __builtin_elementwise_fma(Sl[j][i], w2[i], __builtin_elementwise_fma(slj, bb2[i], vj * kp2[i])); } }
                { const f32x2 rr2[4] = {cur.rr[0].xy, cur.rr[0].zw, cur.rr[1].xy, cur.rr[1].zw}; f32x4 yv, zv;
#pragma unroll
                  for (int j = 0; j < 4; ++j) { f32x2 a0 = Sp[j][0] * rr2[0], a1 = Sl[j][0] * rr2[0];
#pragma unroll
                      for (int i = 1; i < 4; ++i) { a0 = __builtin_elementwise_fma(Sp[j][i], rr2[i], a0); a1 = __builtin_elementwise_fma(Sl[j][i], rr2[i], a1); }
                      yv[j] = oct_sum(a0.x + a0.y); zv[j] = oct_sum(a1.x + a1.y); }
                  if (q == 0) { *(f32x4*)(yzp + (size_t)st * 128) = yv; *(f32x4*)(yzp + (size_t)st * 128 + 64) = zv; } }
                __builtin_amdgcn_sched_barrier(0);
                if (st + 1 < SC_STEPS) cur = nxt;
            }
            }
            asm volatile("s_waitcnt vmcnt(0)" ::: "memory"); __syncthreads();
        }
        float* o = PL + (size_t)(task0 + tk) * 8192 + (32 * half + 4 * rg) * 64 + 8 * q;
#pragma unroll
        for (int j = 0; j < 4; ++j) {
            *(f32x4*)(o + j * 64) = (f32x4){Sp[j][0].x, Sp[j][0].y, Sp[j][1].x, Sp[j][1].y}; *(f32x4*)(o + j * 64 + 4) = (f32x4){Sp[j][2].x, Sp[j][2].y, Sp[j][3].x, Sp[j][3].y};
            *(f32x4*)(o + 4096 + j * 64) = (f32x4){Sl[j][0].x, Sl[j][0].y, Sl[j][1].x, Sl[j][1].y}; *(f32x4*)(o + 4096 + j * 64 + 4) = (f32x4){Sl[j][2].x, Sl[j][2].y, Sl[j][3].x, Sl[j][3].y}; }
    }
}
struct ScanRaw { u32x2 r, k, v, rp, kp, vp, w, a; };
__device__ __forceinline__ void scan_raw_load(ScanRaw& o, const bf16* __restrict__ pr, const bf16* __restrict__ g1, bool first) {
    o.r = *(const u32x2*)(pr); o.k = *(const u32x2*)(pr + 512); o.v = *(const u32x2*)(pr + 1024); o.w = *(const u32x2*)(g1); o.a = *(const u32x2*)(g1 + 512);
    if (!first) { o.rp = *(const u32x2*)(pr - EIN); o.kp = *(const u32x2*)(pr - EIN + 512); o.vp = *(const u32x2*)(pr - EIN + 1024); }
    else { o.rp = (u32x2){0u, 0u}; o.kp = (u32x2){0u, 0u}; o.vp = (u32x2){0u, 0u}; }
}
__device__ __forceinline__ float row16_sum(float v) { v += __shfl_xor(v, 1); v += __shfl_xor(v, 2); v += __shfl_xor(v, 4); v += __shfl_xor(v, 8); return v; }
__device__ __forceinline__ float scan_produce(const ScanRaw& x, const LAS unsigned char* prm, LAS unsigned char* rec4, LAS unsigned char* rec2, int c4) {
    const f32x4 mur = LDS4(prm + c4 * 16), muk = LDS4(prm + 256 + c4 * 16), muv = LDS4(prm + 512 + c4 * 16), w0 = LDS4(prm + 768 + c4 * 16), a0 = LDS4(prm + 1024 + c4 * 16);
    const f32x4 kkw = LDS4(prm + 1280 + c4 * 16), kaw = LDS4(prm + 1536 + c4 * 16), rkw = LDS4(prm + 1792 + c4 * 16);
    f32x4 r, v, dec, kk, bb, k2; float n2 = 0.f, bon = 0.f;
#pragma unroll
    for (int e = 0; e < 4; ++e) { const int p = e >> 1, od = e & 1;
#define UNP_(L) (od ? bfhi(p ? x.L.y : x.L.x) : bflo(p ? x.L.y : x.L.x))
        const float r0 = UNP_(r), k0 = UNP_(k), v0 = UNP_(v), rp = UNP_(rp), kp = UNP_(kp), vp = UNP_(vp), wpre = UNP_(w), apre = UNP_(a);
#undef UNP_
        r[e] = r0 + (rp - r0) * mur[e]; const float k = k0 + (kp - k0) * muk[e]; v[e] = v0 + (vp - v0) * muv[e];
        const float z = w0[e] + wpre;
        dec[e] = __expf(-0.6065306597126334f * sigmoidf_(z));
        const float av = sigmoidf_(a0[e] + apre);
        kk[e] = k * kkw[e]; n2 += kk[e] * kk[e];
        k2[e] = k * (1.0f + (av - 1.0f) * kaw[e]);
        bb[e] = av;
        bon += r[e] * k2[e] * rkw[e];
    }
    n2 = row16_sum(n2); bon = row16_sum(bon);
    const float inv = 1.0f / fmaxf(sqrtf(n2), 1e-12f);
#pragma unroll
    for (int e = 0; e < 4; ++e) { kk[e] *= inv; bb[e] *= kk[e]; }
    *(LAS f32x4*)(rec4 + c4 * 16) = dec; *(LAS f32x4*)(rec4 + 256 + c4 * 16) = kk; *(LAS f32x4*)(rec4 + 512 + c4 * 16) = bb; *(LAS f32x4*)(rec4 + 768 + c4 * 16) = k2;
    *(LAS f32x4*)(rec2 + c4 * 16) = r; *(LAS f32x4*)(rec2 + 256 + c4 * 16) = v;
    return bon;
}
__device__ __forceinline__ void phase5f(const Ctx& c, const Args& a, float* __restrict__ YZ) {
    float* PL = (float*)(c.ws + WS_PL); float* __restrict__ BS = (float*)(c.ws + WS_BS);
    const bf16* __restrict__ P = (const bf16*)(c.ws + WS_PROJ); const bf16* __restrict__ G1 = (const bf16*)(c.ws + WS_G1);
    const int tk = c.wave >> 1, half = c.wave & 1, rg = c.lane >> 3, q = c.lane & 7, tl = c.lane >> 4, c4 = c.lane & 15;
    LAS unsigned char* prm = c.lds + 2 * SC_BUF_BYTES + tk * 2048;
    for (int tg = c.bx; tg < 256; tg += c.G) {
        const int task0 = tg * 4, task = task0 + tk, bh = task >> 6, chunk = task & 63, hd = bh & 7;
        const size_t mrow0 = (size_t)(bh >> 3) * T + chunk * 128;
        const bf16* pr0 = P + (mrow0 + 4 * half + tl) * EIN + 1024 + hd * 64 + 4 * c4; const bf16* g10 = G1 + (mrow0 + 4 * half + tl) * 1536 + hd * 64 + 4 * c4;
        float* bsp = BS + (mrow0 + 4 * half + tl) * 8 + hd;
        f32x2 Sp[4][4], Sl[4][4];
#pragma unroll
        for (int j = 0; j < 4; ++j)
#pragma unroll
            for (int i = 0; i < 4; ++i) { Sp[j][i] = (f32x2){(8 * q + 2 * i == 32 * half + 4 * rg + j) ? 1.f : 0.f, (8 * q + 2 * i + 1 == 32 * half + 4 * rg + j) ? 1.f : 0.f}; Sl[j][i] = (f32x2){0.f, 0.f}; }
        {
            const int arr = 4 * half + tl; const int cc = hd * 64 + 4 * c4;
            const float* src = arr == 0 ? INF(I_MU) + cc : arr == 1 ? INF(I_MU) + 512 + cc : arr == 2 ? INF(I_MU) + 1024 + cc : arr == 3 ? INF(I_W0) + cc : arr == 4 ? INF(I_A0) + cc : arr == 5 ? INF(I_KK) + cc : arr == 6 ? INF(I_KA) + cc : INF(I_RK) + cc;
            *(LAS f32x4*)(prm + arr * 256 + c4 * 16) = *(const f32x4*)src; }
        ScanRaw raw; scan_raw_load(raw, pr0, g10, chunk == 0 && half == 0 && tl == 0);
        __syncthreads();
        { const float bon = scan_produce(raw, prm, c.lds + tk * SC_TASK_BYTES + (4 * half + tl) * 1024, c.lds + tk * SC_TASK_BYTES + 8192 + (4 * half + tl) * 512, c4); if (c4 == 0) bsp[0] = bon; }
        scan_raw_load(raw, pr0 + (size_t)8 * EIN, g10 + (size_t)8 * 1536, false);
        __syncthreads();
#pragma unroll 1
        for (int s = 0; s < 16; ++s) {
            if (s + 1 < 16) { LAS unsigned char* nb = c.lds + ((s + 1) & 1) * SC_BUF_BYTES + tk * SC_TASK_BYTES;
                const float bon = scan_produce(raw, prm, nb + (4 * half + tl) * 1024, nb + 8192 + (4 * half + tl) * 512, c4); if (c4 == 0) bsp[(size_t)(s + 1) * 64] = bon;
                if (s + 2 < 16) scan_raw_load(raw, pr0 + (size_t)(s + 2) * 8 * EIN, g10 + (size_t)(s + 2) * 8 * 1536, false); }
            const LAS unsigned char* base = c.lds + (s & 1) * SC_BUF_BYTES + tk * SC_TASK_BYTES;
            const LAS unsigned char* r4b = base + q * 32; const LAS unsigned char* r2rb = base + 8192 + q * 32; const LAS unsigned char* r2b = base + 8192 + 256 + (32 * half + 4 * rg) * 4;
            float* yzp = YZ + ((size_t)((task0 + tk) >> 6) * T + ((task0 + tk) & 63) * 128 + s * SC_STEPS) * 128 + 32 * half + 4 * rg;
#define P5_STEP(OP, ST) do { __builtin_amdgcn_sched_barrier(0); \
                const f32x2 w2[4] = {OP.w[0].xy, OP.w[0].zw, OP.w[1].xy, OP.w[1].zw}, kk2[4] = {OP.kk[0].xy, OP.kk[0].zw, OP.kk[1].xy, OP.kk[1].zw}; \
                const f32x2 bb2[4] = {OP.bb[0].xy, OP.bb[0].zw, OP.bb[1].xy, OP.bb[1].zw}, kp2[4] = {OP.kp[0].xy, OP.kp[0].zw, OP.kp[1].xy, OP.kp[1].zw}; \
                float sp[4], sl[4]; { float rd[8]; \
                _Pragma("unroll") for (int j = 0; j < 4; ++j) { f32x2 a0 = Sp[j][0] * kk2[0], a1 = Sl[j][0] * kk2[0]; \
                    _Pragma("unroll") for (int i = 1; i < 4; ++i) { a0 = __builtin_elementwise_fma(Sp[j][i], kk2[i], a0); a1 = __builtin_elementwise_fma(Sl[j][i], kk2[i], a1); } \
                    rd[2 * j] = a0.x + a0.y; rd[2 * j + 1] = a1.x + a1.y; } \
                oct_sum8(rd); \
                _Pragma("unroll") for (int j = 0; j < 4; ++j) { sp[j] = -rd[2 * j]; sl[j] = -rd[2 * j + 1]; } } \
                _Pragma("unroll") for (int j = 0; j < 4; ++j) { const f32x2 vj = {OP.vv[j], OP.vv[j]}, spj = {sp[j], sp[j]}, slj = {sl[j], sl[j]}; \
                    _Pragma("unroll") for (int i = 0; i < 4; ++i) { Sp[j][i] = __builtin_elementwise_fma(Sp[j][i], w2[i], spj * bb2[i]); \
                        Sl[j][i] = __builtin_elementwise_fma(Sl[j][i], w2[i], __builtin_elementwise_fma(slj, bb2[i], vj * kp2[i])); } } \
                { const f32x2 rr2[4] = {OP.rr[0].xy, OP.rr[0].zw, OP.rr[1].xy, OP.rr[1].zw}; f32x4 yv, zv; float rd[8]; \
                  _Pragma("unroll") for (int j = 0; j < 4; ++j) { f32x2 a0 = Sp[j][0] * rr2[0], a1 = Sl[j][0] * rr2[0]; \
                      _Pragma("unroll") for (int i = 1; i < 4; ++i) { a0 = __builtin_elementwise_fma(Sp[j][i], rr2[i], a0); a1 = __builtin_elementwise_fma(Sl[j][i], rr2[i], a1); } \
                      rd[2 * j] = a0.x + a0.y; rd[2 * j + 1] = a1.x + a1.y; } \
                  oct_sum8(rd); \
                  _Pragma("unroll") for (int j = 0; j < 4; ++j) { yv[j] = rd[2 * j]; zv[j] = rd[2 * j + 1]; } \
                  if (q == 0) { *(f32x4*)(yzp + (size_t)(ST) * 128) = yv; *(f32x4*)(yzp + (size_t)(ST) * 128 + 64) = zv; } } \
                __builtin_amdgcn_sched_barrier(0); } while (0)
            ScanOps5 opA, opB; scan_load5(opA, r4b, r2rb, r2b);
#pragma unroll 1
            for (int st = 0; st < SC_STEPS; st += 2) {
                scan_load5(opB, r4b + (st + 1) * 1024, r2rb + (st + 1) * 512, r2b + (st + 1) * 512);
                P5_STEP(opA, st);
                if (st + 2 < SC_STEPS) scan_load5(opA, r4b + (st + 2) * 1024, r2rb + (st + 2) * 512, r2b + (st + 2) * 512);
                P5_STEP(opB, st + 1);
            }
#undef P5_STEP
            __syncthreads();
        }
        float* o = PL + (size_t)(task0 + tk) * 8192 + (32 * half + 4 * rg) * 64 + 8 * q;
#pragma unroll
        for (int j = 0; j < 4; ++j) {
            *(f32x4*)(o + j * 64) = (f32x4){Sp[j][0].x, Sp[j][0].y, Sp[j][1].x, Sp[j][1].y}; *(f32x4*)(o + j * 64 + 4) = (f32x4){Sp[j][2].x, Sp[j][2].y, Sp[j][3].x, Sp[j][3].y};
            *(f32x4*)(o + 4096 + j * 64) = (f32x4){Sl[j][0].x, Sl[j][0].y, Sl[j][1].x, Sl[j][1].y}; *(f32x4*)(o + 4096 + j * 64 + 4) = (f32x4){Sl[j][2].x, Sl[j][2].y, Sl[j][3].x, Sl[j][3].y}; }
    }
}
__device__ __forceinline__ void dma16(const void* gsrc, unsigned lds_dst) { unsigned keep;
    asm volatile("s_mov_b32 %0, m0\n\ts_mov_b32 m0, %2\n\ts_nop 0\n\tglobal_load_lds_dwordx4 %1, off\n\ts_mov_b32 m0, %0" : "=&s"(keep) : "v"(gsrc), "s"(lds_dst) : "memory"); }
__device__ __forceinline__ void dma4(const void* gsrc, unsigned lds_dst) { unsigned keep;
    asm volatile("s_mov_b32 %0, m0\n\ts_mov_b32 m0, %2\n\ts_nop 0\n\tglobal_load_lds_dword %1, off\n\ts_mov_b32 m0, %0" : "=&s"(keep) : "v"(gsrc), "s"(lds_dst) : "memory"); }
__device__ __forceinline__ void phase6(const Ctx& c, const Args& a) {
    const float* __restrict__ PL = (const float*)(c.ws + WS_PL); float* __restrict__ SI = (float*)(c.ws + WS_SINIT);
    constexpr int NB6 = 5, SLOT6 = 16384 + 4096, SB_OFF = NB6 * SLOT6, SB_BYTES = 16 * 65 * 4;
    for (int blk = c.bx; blk < 96; blk += c.G) {
        if (blk < 64) {
            const int bh = blk >> 2, rg = blk & 3;
            const unsigned lds0 = (unsigned)(uintptr_t)c.lds;
            const float* Pb = PL + (size_t)(bh * 64) * 8192;
            const int hw = c.wave - 4, nt = c.wave, j = c.lane & 15, q = c.lane >> 4;
#define P6_ISSUE(cc, slot) do { const float* pc_ = Pb + (size_t)(cc) * 8192; const unsigned d_ = lds0 + (unsigned)(slot) * SLOT6; \
            _Pragma("unroll") for (int i_ = 0; i_ < 4; ++i_) dma16(pc_ + (4 * hw + i_) * 256 + c.lane * 4, (unsigned)__builtin_amdgcn_readfirstlane(d_ + (4 * hw + i_) * 1024)); \
            dma16(pc_ + 4096 + (16 * rg) * 64 + hw * 256 + c.lane * 4, (unsigned)__builtin_amdgcn_readfirstlane(d_ + 16384 + hw * 1024)); } while (0)
            asm volatile("s_waitcnt vmcnt(0) lgkmcnt(0)\n\ts_barrier" ::: "memory");
            if (c.wave >= 4) {
#pragma unroll
                for (int cc = 0; cc < NB6 - 1; ++cc) P6_ISSUE(cc, cc);
            } else {
#pragma unroll
                for (int r = 0; r < 4; ++r) *(LAS float*)(c.lds + SB_OFF + ((4 * q + r) * 65 + 16 * nt + j) * 4) = 0.f;
            }
            f32x4 st = {0.f, 0.f, 0.f, 0.f};
            int slot = 0, islot = NB6 - 1;
#pragma unroll 1
            for (int cc = 0; cc < 64; ++cc) {
                if (c.wave >= 4) asm volatile("s_waitcnt vmcnt(15)" ::: "memory");
                asm volatile("s_waitcnt lgkmcnt(0)\n\ts_barrier" ::: "memory");
                if (c.wave >= 4) { const int nc = cc + NB6 - 1 < 64 ? cc + NB6 - 1 : 63; P6_ISSUE(nc, islot); }
                else {
                    float* sip = SI + ((size_t)(bh * 64 + cc) * 64 + 16 * rg + 4 * q) * 64 + 16 * nt + j;
#pragma unroll
                    for (int r = 0; r < 4; ++r) sip[r * 64] = st[r];
                    const LAS unsigned char* sl = c.lds + slot * SLOT6;
                    const LAS unsigned char* sa = c.lds + SB_OFF + (cc & 1) * SB_BYTES + (j * 65 + q) * 4;
                    const LAS unsigned char* sb = sl + (q * 64 + 16 * nt + j) * 4;
                    f32x4 a0, a1 = {0.f, 0.f, 0.f, 0.f};
#pragma unroll
                    for (int r = 0; r < 4; ++r) a0[r] = *(const LAS float*)(sl + 16384 + ((4 * q + r) * 64 + 16 * nt + j) * 4);
#pragma unroll
                    for (int ks = 0; ks < 16; ks += 2) {
                        a0 = __builtin_amdgcn_mfma_f32_16x16x4f32(*(const LAS float*)(sa + ks * 16), *(const LAS float*)(sb + ks * 1024), a0, 0, 0, 0);
                        a1 = __builtin_amdgcn_mfma_f32_16x16x4f32(*(const LAS float*)(sa + (ks + 1) * 16), *(const LAS float*)(sb + (ks + 1) * 1024), a1, 0, 0, 0); }
                    st = a0 + a1;
#pragma unroll
                    for (int r = 0; r < 4; ++r) *(LAS float*)(c.lds + SB_OFF + ((cc + 1) & 1) * SB_BYTES + ((4 * q + r) * 65 + 16 * nt + j) * 4) = st[r];
                }
                slot = slot + 1 == NB6 ? 0 : slot + 1; islot = islot + 1 == NB6 ? 0 : islot + 1;
            }
            asm volatile("s_waitcnt vmcnt(0) lgkmcnt(0)\n\ts_barrier" ::: "memory");
#undef P6_ISSUE
        } else {
            const int q6 = blk - 64, b = q6 >> 4, chl = c.tid & 31, ch = (q6 & 15) * 32 + chl, seg = c.tid >> 5;
            const float* __restrict__ LSA = (const float*)(c.ws + WS_LSA); const float* __restrict__ LSH = (const float*)(c.ws + WS_LSH); float* __restrict__ LC = (float*)(c.ws + WS_LC);
            const unsigned t0 = (unsigned)(b * 512 + seg * 32) * 512u + (unsigned)ch;
            float sa[32], sh[32];
#pragma unroll
            for (int i = 0; i < 32; ++i) { sa[i] = __expf(LSA[t0 + (unsigned)i * 512u]); sh[i] = LSH[t0 + (unsigned)i * 512u]; }
            float A = 1.f, H = 0.f;
#pragma unroll
            for (int i = 0; i < 32; ++i) { H = sa[i] * H + sh[i]; A *= sa[i]; }
            LAS float* ex = (LAS float*)c.lds;
            asm volatile("s_waitcnt lgkmcnt(0)\n\ts_barrier" ::: "memory");
            ex[(seg * 32 + chl) * 2] = A; ex[(seg * 32 + chl) * 2 + 1] = H;
            asm volatile("s_waitcnt lgkmcnt(0)\n\ts_barrier" ::: "memory");
            float h = 0.f;
            for (int s2 = 0; s2 < seg; ++s2) h = ex[(s2 * 32 + chl) * 2] * h + ex[(s2 * 32 + chl) * 2 + 1];
#pragma unroll
            for (int i = 0; i < 32; ++i) { LC[t0 + (unsigned)i * 512u] = h; h = sa[i] * h + sh[i]; }
            asm volatile("s_waitcnt lgkmcnt(0)\n\ts_barrier" ::: "memory");
        }
    }
    if (c.G > P6_BUSY && c.bx >= P6_BUSY) { const int gw6 = (c.bx - P6_BUSY) * NWAVES + c.wave, ngw6 = (c.G - P6_BUSY) * NWAVES; convert_rest(c, a, gw6, ngw6); moe_convert(c, a, 0, 0, P6_MOE_E, gw6, ngw6); if (P6_MOE_U > 0) moe_convert(c, a, 1, 0, P6_MOE_U, gw6, ngw6); }
}
__device__ __forceinline__ void phase7(const Ctx& c, const float* __restrict__ YZ) {
    const float* __restrict__ SI = (const float*)(c.ws + WS_SINIT); float* __restrict__ OR = (float*)(c.ws + WS_ORAW);
    LAS float* Yl = (LAS float*)c.lds;
    const int v = c.tid & 63, tq = c.wave;
    for (int task = c.bx; task < 1024; task += c.G) {
        const int bh = task >> 6, cc = task & 63; const size_t tb = (size_t)bh * T + cc * 128;
        LAS float* Sl = Yl + 16384;
#pragma unroll
        for (int i = 0; i < 2; ++i) { const int idx = c.tid + 512 * i, row = idx >> 4, c4 = idx & 15; *(LAS f32x4*)(Sl + row * 68 + 4 * c4) = *(const f32x4*)(SI + ((size_t)task * 64 + row) * 64 + 4 * c4); }
#pragma unroll
        for (int i = 0; i < 4; ++i) { const int idx = c.tid + 512 * i, tt = idx >> 4, c4 = idx & 15; *(LAS f32x4*)(Yl + tt * 64 + 4 * c4) = *(const f32x4*)(YZ + (tb + tt) * 128 + 4 * c4); }
#pragma unroll
        for (int i = 0; i < 4; ++i) { const int idx = c.tid + 512 * i, tt = idx >> 4, c4 = idx & 15; *(LAS f32x4*)(Yl + 8192 + tt * 64 + 4 * c4) = *(const f32x4*)(YZ + (tb + tt) * 128 + 64 + 4 * c4); }
        __syncthreads();
        f32x4 sr[16];
#pragma unroll
        for (int i = 0; i < 16; ++i) sr[i] = *(const LAS f32x4*)(Sl + v * 68 + 4 * i);
        float* orow = OR + ((size_t)(bh >> 3) * T + cc * 128) * 512 + (bh & 7) * 64 + v;
#pragma unroll 2
        for (int i = 0; i < 16; ++i) { const int tt = 16 * tq + i; float acc = Yl[8192 + tt * 64 + v]; f32x4 a4 = {0.f, 0.f, 0.f, 0.f};
#pragma unroll
            for (int k4 = 0; k4 < 16; ++k4) { const f32x4 y4 = *(const LAS f32x4*)(Yl + tt * 64 + 4 * k4); a4 += sr[k4] * y4; }
            acc += (a4[0] + a4[1]) + (a4[2] + a4[3]);
            orow[(size_t)tt * 512] = acc; }
        __syncthreads();
    }
}
template <int MODE> __device__ __forceinline__ void phase8(const Ctx& c, const Args& a) {
    const bf16* __restrict__ P = (const bf16*)(c.ws + WS_PROJ); bf16* __restrict__ Y = (bf16*)(c.ws + WS_Y);
    const float* __restrict__ OR = (const float*)(c.ws + WS_ORAW); const float* __restrict__ BS = (const float*)(c.ws + WS_BS);
    const bf16* __restrict__ G1 = (const bf16*)(c.ws + WS_G1);
    const bf16* __restrict__ HL = (const bf16*)(c.ws + WS_LA); const bf16* __restrict__ CP = (const bf16*)(c.ws + WS_LU); const float* __restrict__ LC = (const float*)(c.ws + WS_LC);
    const int hd = c.lane >> 3, ch = 64 * hd + 8 * (c.lane & 7);
    float gw[8], gb[8], muv[8];
#pragma unroll
    for (int e = 0; e < 8; ++e) { gw[e] = INF(I_GNW)[ch + e]; gb[e] = INF(I_GNB)[ch + e]; muv[e] = INF(I_MU)[1024 + ch + e]; }
    for (int m = c.gw; m < M; m += c.ngw) { const int t = m & (T - 1);
        const f32x4 oa = *(const f32x4*)(OR + (size_t)m * 512 + ch), ob = *(const f32x4*)(OR + (size_t)m * 512 + ch + 4);
        const u32x4 vq = *(const u32x4*)(P + (size_t)m * EIN + 2048 + ch); u32x4 vpq = {0u, 0u, 0u, 0u}; if (t > 0) vpq = *(const u32x4*)(P + (size_t)(m - 1) * EIN + 2048 + ch);
        const float bon = BS[(size_t)m * 8 + hd];
        const u32x4 gq = *(const u32x4*)(G1 + (size_t)m * 1536 + 1024 + ch);
        const u32x4 hq = *(const u32x4*)(HL + (size_t)m * 512 + ch), cq = *(const u32x4*)(CP + (size_t)m * 512 + ch), lq = *(const u32x4*)(P + (size_t)m * EIN + 512 + ch);
        const f32x4 ca = *(const f32x4*)(LC + (size_t)(m >> 4) * 512 + ch), cb = *(const f32x4*)(LC + (size_t)(m >> 4) * 512 + ch + 4);
        float o[8] = {oa[0], oa[1], oa[2], oa[3], ob[0], ob[1], ob[2], ob[3]};
        float s = 0.f;
#pragma unroll
        for (int e = 0; e < 8; ++e) s += o[e];
        s += __shfl_xor(s, 1); s += __shfl_xor(s, 2); s += __shfl_xor(s, 4);
        const float mean = s * (1.0f / 64.0f); float q = 0.f;
#pragma unroll
        for (int e = 0; e < 8; ++e) { o[e] -= mean; q += o[e] * o[e]; }
        q += __shfl_xor(q, 1); q += __shfl_xor(q, 2); q += __shfl_xor(q, 4);
        const float rstd = rsqrtf(q * (1.0f / 64.0f) + 64e-5f);
        float v[8]; { float v0[8], vp[8]; unpack8(vq, v0); unpack8(vpq, vp);
#pragma unroll
            for (int e = 0; e < 8; ++e) v[e] = v0[e] + (vp[e] - v0[e]) * muv[e]; }
        float g[8]; unpack8(gq, g);
        float y[8];
#pragma unroll
        for (int e = 0; e < 8; ++e) y[e] = (o[e] * rstd * gw[e] + gb[e] + bon * v[e]) * g[e];
        *(u32x4*)(Y + (size_t)m * 1024 + 512 + ch) = pack8(y);
        float hl[8], cp[8], lg[8]; unpack8(hq, hl); unpack8(cq, cp); unpack8(lq, lg);
        const float lc[8] = {ca[0], ca[1], ca[2], ca[3], cb[0], cb[1], cb[2], cb[3]};
#pragma unroll
        for (int e = 0; e < 8; ++e) y[e] = gelu_tanh(lg[e]) * (hl[e] + cp[e] * lc[e]);
        *(u32x4*)(Y + (size_t)m * 1024 + ch) = pack8(y);
    }
}
__device__ __forceinline__ void phase15(const Ctx& c, const Args& a) {
    bf16* Q = (bf16*)(c.ws + WS_Q); bf16* Kb = (bf16*)(c.ws + WS_K); const int* pos = (const int*)a.in[I_POS];
    const int d0 = 16 * (c.lane & 3);
    float qg[16], kg[16];
#pragma unroll
    for (int e = 0; e < 16; ++e) { qg[e] = INF(I_QNORM)[d0 + e] * (0.125f*1.4426950408889634f); kg[e] = INF(I_KNORM)[d0 + e]; }
    const float inv_l = powf(500000.0f, -(float)(2 * (c.lane & 7)) / 16.0f);
    for (int m = c.gw; m < M; m += c.ngw) {
        const float p = (float)pos[m];
        float cs[8], sn[8];
        { float sl, cl; sincosf(p * inv_l, &sl, &cl);
#pragma unroll
          for (int i = 0; i < 8; ++i) { cs[i] = __builtin_bit_cast(float, __builtin_amdgcn_readlane(__builtin_bit_cast(int, cl), i)); sn[i] = __builtin_bit_cast(float, __builtin_amdgcn_readlane(__builtin_bit_cast(int, sl), i)); } }
#pragma unroll
        for (int which = 0; which < 2; ++which) {
            bf16* row = (which ? Kb : Q) + (size_t)m * 1024 + 16 * c.lane;
            float x[16]; { float lo[8], hi[8]; unpack8(*(const u32x4*)row, lo); unpack8(*(const u32x4*)(row + 8), hi);
#pragma unroll
                for (int e = 0; e < 8; ++e) { x[e] = lo[e]; x[8 + e] = hi[e]; } }
            float s = 0.f;
#pragma unroll
            for (int e = 0; e < 16; ++e) s += x[e] * x[e];
            s += __shfl_xor(s, 1); s += __shfl_xor(s, 2);
            const float r = rsqrtf(s * (1.0f / 64.0f) + 1e-6f);
#pragma unroll
            for (int e = 0; e < 16; ++e) x[e] = x[e] * r * (which ? kg[e] : qg[e]);
            if ((c.lane & 3) == 0) {
#pragma unroll
                for (int i = 0; i < 8; ++i) { const float x1 = x[i], x2 = x[8 + i]; x[i] = x1 * cs[i] - x2 * sn[i]; x[8 + i] = x2 * cs[i] + x1 * sn[i]; } }
            float lo[8], hi[8];
#pragma unroll
            for (int e = 0; e < 8; ++e) { lo[e] = x[e]; hi[e] = x[8 + e]; }
            *(u32x4*)row = pack8(lo); *(u32x4*)(row + 8) = pack8(hi);
        }
    }
}
__device__ __forceinline__ void phase17(const Ctx& c, const Args& a) {
    const bf16* O0 = (const bf16*)(c.ws + WS_OA0); const bf16* O1 = (const bf16*)(c.ws + WS_OA1); bf16* AO = (bf16*)(c.ws + WS_AO);
    const float lam_init = 0.8f - 0.6f * 0.7408182206817179f;
    const float d1 = wave_sum(INF(I_LQ1)[c.lane] * INF(I_LK1)[c.lane]), d2 = wave_sum(INF(I_LQ2)[c.lane] * INF(I_LK2)[c.lane]);
    const float lam = __expf(d1) - __expf(d2) + lam_init;
    const int d0 = 16 * (c.lane & 7);
    float sg[16];
#pragma unroll
    for (int e = 0; e < 16; ++e) sg[e] = INF(I_SUBLN)[d0 + e] * (1.0f - lam_init);
    for (int m = c.gw; m < M; m += c.ngw) {
        const size_t off = (size_t)m * 1024 + 16 * c.lane;
        float x0[8], x1[8], y0[8], y1[8], d[16];
        unpack8(*(const u32x4*)(O0 + off), x0); unpack8(*(const u32x4*)(O0 + off + 8), x1); unpack8(*(const u32x4*)(O1 + off), y0); unpack8(*(const u32x4*)(O1 + off + 8), y1);
        float s = 0.f;
#pragma unroll
        for (int e = 0; e < 8; ++e) { d[e] = x0[e] - lam * y0[e]; d[8 + e] = x1[e] - lam * y1[e]; s += d[e] * d[e] + d[8 + e] * d[8 + e]; }
        s += __shfl_xor(s, 1); s += __shfl_xor(s, 2); s += __shfl_xor(s, 4);
        const float r = rsqrtf(s * (1.0f / 128.0f) + 1e-6f);
        float lo[8], hi[8];
#pragma unroll
        for (int e = 0; e < 8; ++e) { lo[e] = d[e] * r * sg[e]; hi[e] = d[8 + e] * r * sg[8 + e]; }
        *(u32x4*)(AO + off) = pack8(lo); *(u32x4*)(AO + off + 8) = pack8(hi);
    }
}
template <class XT> __device__ __forceinline__ void phase19(const Ctx& c, const Args& a, const XT* x3) {
    unsigned char* XNM = (unsigned char*)(c.ws + WS_XNM);       unsigned* cntw = (unsigned*)(c.ws + WS_CTL) + CW_CNT; int* LIST = (int*)(c.ws + WS_LIST); int* TOKI = (int*)(c.ws + WS_TOKI); float* TOKG = (float*)(c.ws + WS_TOKG);
    const float* g = INF(I_OLNFFN); const float* rt = INF(I_ROUTER);
    f32x4 gv[4]; f32x4 rw[4][4][2];
#pragma unroll
    for (int j = 0; j < 4; ++j) { gv[j] = ((const f32x4*)g)[c.lane + 64 * j];
#pragma unroll
        for (int i = 0; i < 4; ++i) { const float* rp = rt + (size_t)(256 * j + 4 * c.lane + i) * 8; rw[j][i][0] = *(const f32x4*)rp; rw[j][i][1] = *(const f32x4*)(rp + 4); } }
    for (int m = c.gw; m < M; m += c.ngw) {
        f32x4 v[4]; float s = 0.f;
#pragma unroll
        for (int j = 0; j < 4; ++j) { v[j] = ld_x4(x3 + (size_t)m * D, c.lane + 64 * j); s += (v[j].x * v[j].x + v[j].y * v[j].y) + (v[j].z * v[j].z + v[j].w * v[j].w); }
        const float r = rsqrtf(wave_sum(s) * (1.0f / 1024.0f) + 1e-6f);
        f32x4 l0 = {0.f, 0.f, 0.f, 0.f}, l1 = {0.f, 0.f, 0.f, 0.f};
#pragma unroll
        for (int j = 0; j < 4; ++j) { const f32x4 o = v[j] * r * gv[j];
            ((unsigned*)(XNM + (size_t)m * D))[c.lane + 64 * j] = pg8::pk4_fp8(o.x, o.y, o.z, o.w);
#pragma unroll
            for (int i = 0; i < 4; ++i) { l0 += rw[j][i][0] * o[i]; l1 += rw[j][i][1] * o[i]; } }
        float lg[8];
#pragma unroll
        for (int e = 0; e < 4; ++e) { lg[e] = wave_sum(l0[e]); lg[4 + e] = wave_sum(l1[e]); }
        int i1 = 0; float v1 = lg[0];
#pragma unroll
        for (int e = 1; e < 8; ++e) if (lg[e] > v1) { v1 = lg[e]; i1 = e; }
        int i2 = (i1 + 1) & 7; float v2 = -INFINITY;
#pragma unroll
        for (int e = 0; e < 8; ++e) if (e != i1 && lg[e] > v2) { v2 = lg[e]; i2 = e; }
        if (c.lane == 0) {
            const float g2 = 1.0f / (1.0f + __expf(v1 - v2)), g1 = 1.0f - g2;
            const int s1 = (int)__hip_atomic_fetch_add(cntw + 64 * i1, 1u, __ATOMIC_RELAXED, __HIP_MEMORY_SCOPE_AGENT);
            const int s2 = (int)__hip_atomic_fetch_add(cntw + 64 * i2, 1u, __ATOMIC_RELAXED, __HIP_MEMORY_SCOPE_AGENT);
            LIST[i1 * 16384 + s1] = m; LIST[i2 * 16384 + s2] = m;
            *(int4*)(TOKI + (size_t)m * 4) = make_int4(i1, s1, i2, s2); *(f32x2*)(TOKG + (size_t)m * 2) = (f32x2){g1, g2};
        }
    }
}
template <class XT> __device__ __forceinline__ void phase22(const Ctx& c, const XT* x3, float* out) {
    const bf16* Y2 = (const bf16*)(c.ws + WS_Y2); unsigned* cntw = (unsigned*)(c.ws + WS_CTL) + CW_CNT; const int* TOKI = (const int*)(c.ws + WS_TOKI); const float* TOKG = (const float*)(c.ws + WS_TOKG);
    int toff[8]; { int acc = 0;
#pragma unroll
        for (int e = 0; e < 8; ++e) { toff[e] = acc; acc += ((int)__hip_atomic_load(cntw + 64 * e, __ATOMIC_RELAXED, __HIP_MEMORY_SCOPE_AGENT) + 255) >> 8; } }
    for (int m = c.gw; m < M; m += c.ngw) {
        int4 ti; f32x2 tg;
        ti.x = __hip_atomic_load(TOKI + (size_t)m * 4 + 0, __ATOMIC_RELAXED, __HIP_MEMORY_SCOPE_AGENT); ti.y = __hip_atomic_load(TOKI + (size_t)m * 4 + 1, __ATOMIC_RELAXED, __HIP_MEMORY_SCOPE_AGENT);
        ti.z = __hip_atomic_load(TOKI + (size_t)m * 4 + 2, __ATOMIC_RELAXED, __HIP_MEMORY_SCOPE_AGENT); ti.w = __hip_atomic_load(TOKI + (size_t)m * 4 + 3, __ATOMIC_RELAXED, __HIP_MEMORY_SCOPE_AGENT);
        tg.x = __hip_atomic_load(TOKG + (size_t)m * 2 + 0, __ATOMIC_RELAXED, __HIP_MEMORY_SCOPE_AGENT); tg.y = __hip_atomic_load(TOKG + (size_t)m * 2 + 1, __ATOMIC_RELAXED, __HIP_MEMORY_SCOPE_AGENT);
        int b1 = 0, b2 = 0;
#pragma unroll
        for (int e = 0; e < 8; ++e) { if (ti.x == e) b1 = toff[e]; if (ti.z == e) b2 = toff[e]; }
        const bf16* y1 = Y2 + (size_t)(b1 * 256 + ti.y) * 1024; const bf16* y2 = Y2 + (size_t)(b2 * 256 + ti.w) * 1024;
#pragma unroll
        for (int j = 0; j < 4; ++j) { const u32x2 w1 = ((const u32x2*)y1)[c.lane + 64 * j], w2 = ((const u32x2*)y2)[c.lane + 64 * j];
            f32x4* op = (f32x4*)(out + (size_t)m * D) + c.lane + 64 * j; f32x4 o = ld_x4(x3 + (size_t)m * D, c.lane + 64 * j);
            o.x += tg.x * bflo(w1.x) + tg.y * bflo(w2.x); o.y += tg.x * bfhi(w1.x) + tg.y * bfhi(w2.x); o.z += tg.x * bflo(w1.y) + tg.y * bflo(w2.y); o.w += tg.x * bfhi(w1.y) + tg.y * bfhi(w2.y);
            *op = o; }
    }
}

__global__ void __launch_bounds__(NTHR, 2) fwd(Args a) {
    extern __shared__ __attribute__((aligned(16))) unsigned char lds_raw[];
    Ctx c; c.lds = (LAS unsigned char*)lds_raw; c.ws = a.ws;
    c.tid = threadIdx.x; c.lane = c.tid & 63; c.wave = __builtin_amdgcn_readfirstlane(c.tid >> 6);
    c.G = gridDim.x; c.bx = blockIdx.x; c.vcu = (c.G % 8 == 0) ? (c.bx % 8) * (c.G / 8) + c.bx / 8 : c.bx;
    c.gw = c.vcu * NWAVES + c.wave; c.ngw = c.G * NWAVES;
    volatile LAS unsigned* MISC = (volatile LAS unsigned*)(c.lds + MISC_OFF);
    for (int u = c.tid; u < (LDS_BYTES - RING_BYTES) / 4; u += NTHR) ((LAS unsigned*)(c.lds + RING_BYTES))[u] = 0u;
    __syncthreads();
    unsigned* ctl = (unsigned*)(a.ws + WS_CTL);
    const int lo = a.ph_lo, hi = a.ph_hi;
    XcdBarrier bar; bar.bar = ctl + CW_BAR; bar.x = 0; bar.st = MISC + 8;
    unsigned bar_gen = 0u; (void)bar_gen;
    if (FLAT_BAR != 1 && hi - lo > 1) bar = xcd_barrier_post(ctl + CW_BAR, MISC + 8);
#ifndef PHMASK
#define PHMASK 0x7fffffu
#endif
#define IN(k) ((((PHMASK) >> (k)) & 1u) && lo <= (k) && (k) < hi)
#ifndef REPMASK
#define REPMASK 0u
#endif
#if PROBE_BUILD
#define NREP(k) ((((REPMASK) >> (k)) & 1u) ? ((int)((a.repmask >> (k)) & 1u) + 1) : 1)
#else
#define NREP(k) 1
#endif
#define SEAM(k) do { if (IN(k) && IN((k) + 1)) { GRID_BARRIER(bar); } } while (0)
    float* out = a.out; unsigned char* ws = a.ws;
    bf16* XN = (bf16*)(ws + WS_XN); bf16* XR = (bf16*)(ws + WS_XR);

    if (IN(0)) {
#pragma unroll 1
        for (int rep_ = 0; rep_ < NREP(0); ++rep_) { { phase0(c, a); }
        if (rep_ + 1 < NREP(0)) GRID_BARRIER(bar); } }
    SEAM(0);
    if (IN(1)) {
#pragma unroll 1
        for (int rep_ = 0; rep_ < NREP(1); ++rep_) { { { pg8::Gemm g{XN, (const bf16*)(ws + WS_WIN), D, 0}; pg8::StaticOrder S; S.init(M, EIN, c.G, c.bx); pg8::EpiStore E{(bf16*)(ws + WS_PROJ), EIN, 0, 0};
        pg8::gemm_phase<pg8::EpiStore, pg8::StaticOrder, false>(c.lds, g, S, E); } }
        if (rep_ + 1 < NREP(1)) GRID_BARRIER(bar); } }
    SEAM(1);
    if (IN(2)) {
#pragma unroll 1
        for (int rep_ = 0; rep_ < NREP(2); ++rep_) { { phase2(c, a); }
        if (rep_ + 1 < NREP(2)) GRID_BARRIER(bar); } }
    SEAM(2);
    if (IN(3)) {
#pragma unroll 1
        for (int rep_ = 0; rep_ < NREP(3); ++rep_) { { {
        { pg8::Gemm g{(const bf16*)(ws + WS_A2), (const bf16*)(ws + WS_B2T), 128, 0, 256}; pg8::StaticOrderT<1> S; S.init(M, 1536, c.G, c.bx); pg8::EpiStore E{(bf16*)(ws + WS_G1), 1536, 0, 0};
          pg8::gemm_phase<pg8::EpiStore, pg8::StaticOrderT<1>, false>(c.lds, g, S, E); }
        { pg8::Gemm g{(const bf16*)(ws + WS_XC), (const bf16*)(ws + WS_BLRU), 256, 0, 512}; pg8::StaticOrderT<2> S; S.init(M, 1024, c.G, c.bx); pg8::EpiStore E{(bf16*)(ws + WS_G2), 1024, 0, 0};
          pg8::gemm_phase<pg8::EpiStore, pg8::StaticOrderT<2>, false>(c.lds, g, S, E); } } }
        if (rep_ + 1 < NREP(3)) GRID_BARRIER(bar); } }
    SEAM(3);
#if defined(PROBE_P4MODE)
    if (IN(4)) { phase4<PROBE_P4MODE>(c, a); GRID_BARRIER(bar); }
#endif
    if (IN(4)) {
#pragma unroll 1
        for (int rep_ = 0; rep_ < NREP(4); ++rep_) { { }
        if (rep_ + 1 < NREP(4)) GRID_BARRIER(bar); } }
#if defined(PROBE_P5MODE)
    if (IN(5)) { phase5<PROBE_P5MODE>(c, out); GRID_BARRIER(bar); }
#endif
    if (IN(5)) {
#pragma unroll 1
        for (int rep_ = 0; rep_ < NREP(5); ++rep_) { { phase4<2>(c, a); phase5f(c, a, out); }
        if (rep_ + 1 < NREP(5)) GRID_BARRIER(bar); } }
    SEAM(5);
#if defined(PROBE_P6)
    if (IN(6)) { phase6(c, a); GRID_BARRIER(bar); }
#endif
    if (IN(6)) {
#pragma unroll 1
        for (int rep_ = 0; rep_ < NREP(6); ++rep_) { { phase6(c, a); }
        if (rep_ + 1 < NREP(6)) GRID_BARRIER(bar); } }
    SEAM(6);
    if (IN(7)) {
#pragma unroll 1
        for (int rep_ = 0; rep_ < NREP(7); ++rep_) { { phase7(c, out); }
        if (rep_ + 1 < NREP(7)) GRID_BARRIER(bar); } }
    SEAM(7);
#if defined(PROBE_P8MODE)
    if (IN(8)) { phase8<PROBE_P8MODE>(c, a); GRID_BARRIER(bar); }
#endif
    if (IN(8)) {
#pragma unroll 1
        for (int rep_ = 0; rep_ < NREP(8); ++rep_) { { phase8<0>(c, a); }
        if (rep_ + 1 < NREP(8)) GRID_BARRIER(bar); } }
    SEAM(8);
    if (IN(9)) {
#pragma unroll 1
        for (int rep_ = 0; rep_ < NREP(9); ++rep_) { { { pg8::Gemm g{(const bf16*)(ws + WS_Y), (const bf16*)(ws + WS_WOUT), D, 0}; pg8::StaticOrder S; S.init(M, D, c.G, c.bx); pg8::EpiResidB E{INF(I_X), nullptr, XR, D, (float*)(ws + WS_RS1)};
        pg8::gemm_phase<pg8::EpiResidB, pg8::StaticOrder, false>(c.lds, g, S, E); } }
        if (rep_ + 1 < NREP(9)) GRID_BARRIER(bar); } }
    SEAM(9);
    if (IN(10)) {
#pragma unroll 1
        for (int rep_ = 0; rep_ < NREP(10); ++rep_) { { }
        if (rep_ + 1 < NREP(10)) GRID_BARRIER(bar); } }
    if (IN(11)) {
#pragma unroll 1
        for (int rep_ = 0; rep_ < NREP(11); ++rep_) { { { pg8::Gemm g{XR, (const bf16*)(ws + WS_WGU), D, 0}; pg8::StaticOrder S; S.init(M, 2 * FFN, c.G, c.bx); pg8::RowScaled<pg8::EpiSwiGLU> E{{(bf16*)(ws + WS_PROJ), FFN}, (const float*)(ws + WS_RS1)};
        pg8::gemm_phase<pg8::RowScaled<pg8::EpiSwiGLU>, pg8::StaticOrder, false>(c.lds, g, S, E);
        if (c.G == 256 && c.bx >= 128) moe_convert(c, a, 1, 0, P11_MOE_U, (c.bx - 128) * NWAVES + c.wave, 128 * NWAVES); } }
        if (rep_ + 1 < NREP(11)) GRID_BARRIER(bar); } }
    SEAM(11);
    if (IN(12)) {
#pragma unroll 1
        for (int rep_ = 0; rep_ < NREP(12); ++rep_) { { { pg8::Gemm g{(const bf16*)(ws + WS_PROJ), (const bf16*)(ws + WS_WDN), FFN, 0}; pg8::StaticOrder S; S.init(M, D, c.G, c.bx); pg8::EpiResidB E{nullptr, XR, XR, D, (float*)(ws + WS_RS2)};
        pg8::gemm_phase<pg8::EpiResidB, pg8::StaticOrder, false>(c.lds, g, S, E); } }
        if (rep_ + 1 < NREP(12)) GRID_BARRIER(bar); } }
    SEAM(12);
    if (IN(13)) {
#pragma unroll 1
        for (int rep_ = 0; rep_ < NREP(13); ++rep_) { { }
        if (rep_ + 1 < NREP(13)) GRID_BARRIER(bar); } }
    if (IN(14)) {
#pragma unroll 1
        for (int rep_ = 0; rep_ < NREP(14); ++rep_) { { { pg8::Gemm g{XR, (const bf16*)(ws + WS_WQKV), D, 0}; pg8::StaticOrder S; S.init(M, 3072, c.G, c.bx); pg8::RowScaled<pg8::EpiStore> E{{(bf16*)(ws + WS_Q), D, 1024, (size_t)(WS_K - WS_Q) / 2}, (const float*)(ws + WS_RS2)};
        pg8::gemm_phase<pg8::RowScaled<pg8::EpiStore>, pg8::StaticOrder, false>(c.lds, g, S, E); } }
        if (rep_ + 1 < NREP(14)) GRID_BARRIER(bar); } }
    SEAM(14);
    if (IN(15)) {
#pragma unroll 1
        for (int rep_ = 0; rep_ < NREP(15); ++rep_) { { { phase15(c, a); moe_convert(c, a, 1, c.G == 256 ? P11_MOE_U : 0, NE); } }
        if (rep_ + 1 < NREP(15)) GRID_BARRIER(bar); } }
    SEAM(15);
    if (IN(16)) {
#pragma unroll 1
        for (int rep_ = 0; rep_ < NREP(16); ++rep_) { { { const attn_body::AttnTensors AT{(const attn_body::bf16*)(ws + WS_Q), (const attn_body::bf16*)(ws + WS_K), (const attn_body::bf16*)(ws + WS_V), (attn_body::bf16*)(ws + WS_OA0)};
        const attn_body::StaticOrder S((int)c.G, (int)blockIdx.x); attn_body::attn_phase<attn_body::StaticOrder>((char*)lds_raw, AT, S); } }
        if (rep_ + 1 < NREP(16)) GRID_BARRIER(bar); } }
    SEAM(16);
    if (IN(17)) {
#pragma unroll 1
        for (int rep_ = 0; rep_ < NREP(17); ++rep_) { { { phase17(c, a); moe_convert(c, a, 2, 0, P17_MOE_D); } }
        if (rep_ + 1 < NREP(17)) GRID_BARRIER(bar); } }
    SEAM(17);
    if (IN(18)) {
#pragma unroll 1
        for (int rep_ = 0; rep_ < NREP(18); ++rep_) { { { pg8::Gemm g{(const bf16*)(ws + WS_AO), (const bf16*)(ws + WS_WO), D, 0}; pg8::StaticOrder S; S.init(M, D, c.G, c.bx); pg8::EpiResidB E{nullptr, XR, XR, D, nullptr};
        pg8::gemm_phase<pg8::EpiResidB, pg8::StaticOrder, false>(c.lds, g, S, E); } }
        if (rep_ + 1 < NREP(18)) GRID_BARRIER(bar); } }
    SEAM(18);
    if (IN(19)) {
#pragma unroll 1
        for (int rep_ = 0; rep_ < NREP(19); ++rep_) { { phase19(c, a, XR); if (c.G > P6_BUSY) moe_convert(c, a, 0, P6_MOE_E, NE); else moe_convert(c, a, 0); }
        if (rep_ + 1 < NREP(19)) GRID_BARRIER(bar); } }
    SEAM(19);
#if defined(PROBE_P20)
    if (IN(20)) { { pg8::Gemm g{(const bf16*)(ws + WS_XNM), (const bf16*)(ws + WS_WGUM), D / 2, MOE_GU_E8M0}; pg8::MoeOrder S; S.init(ctl + CW_CNT, 2 * ED / 256, c.G, c.bx, (const int*)(ws + WS_LIST));
        pg8::EpiSwiGLU8 E{(unsigned char*)(ws + WS_HM2), ED, MOE_H_SCALE};
        pg8::gemm_phase<pg8::EpiSwiGLU8, pg8::MoeOrder, true, true>(c.lds, g, S, E); } GRID_BARRIER(bar); }
#endif
    if (IN(20)) {
#pragma unroll 1
        for (int rep_ = 0; rep_ < NREP(20); ++rep_) { { { pg8::Gemm g{(const bf16*)(ws + WS_XNM), (const bf16*)(ws + WS_WGUM), D / 2, MOE_GU_E8M0}; pg8::MoeOrder S; S.init(ctl + CW_CNT, 2 * ED / 256, c.G, c.bx, (const int*)(ws + WS_LIST));
        pg8::EpiSwiGLU8 E{(unsigned char*)(ws + WS_HM2), ED, MOE_H_SCALE};
        pg8::gemm_phase<pg8::EpiSwiGLU8, pg8::MoeOrder, true, true>(c.lds, g, S, E);
        { const int cut = S.nwg % (int)c.G;
          if (cut == 0) moe_convert(c, a, 2, P17_MOE_D, NE);
          else if ((int)c.bx >= cut) moe_convert(c, a, 2, P17_MOE_D, NE, ((int)c.bx - cut) * NWAVES + c.wave, ((int)c.G - cut) * NWAVES); } } }
        if (rep_ + 1 < NREP(20)) GRID_BARRIER(bar); } }
    SEAM(20);
#if defined(PROBE_P21)
    if (IN(21)) { { pg8::Gemm g{(const bf16*)(ws + WS_HM2), (const bf16*)(ws + WS_WDM), ED / 2, MOE_DN_E8M0}; pg8::MoeOrder S; S.init(ctl + CW_CNT, D / 256, c.G, c.bx, (const int*)(ws + WS_LIST));
        pg8::EpiStore E{(bf16*)(ws + WS_Y2), D, 0, 0};
        pg8::gemm_phase<pg8::EpiStore, pg8::MoeOrder, false, true>(c.lds, g, S, E); } GRID_BARRIER(bar); }
#endif
    if (IN(21)) {
#pragma unroll 1
        for (int rep_ = 0; rep_ < NREP(21); ++rep_) { { { pg8::Gemm g{(const bf16*)(ws + WS_HM2), (const bf16*)(ws + WS_WDM), ED / 2, MOE_DN_E8M0}; pg8::MoeOrder S; S.init(ctl + CW_CNT, D / 256, c.G, c.bx, (const int*)(ws + WS_LIST));
        const int rtail = S.nwg % (int)c.G; const bool split = P21_SPLIT_EN && rtail > 0 && rtail * pg8::EpiSplitK::SK <= (int)c.G && rtail <= 36;
        if (split) S.lim = S.nwg - rtail;
        pg8::EpiStore E{(bf16*)(ws + WS_Y2), D, 0, 0};
        pg8::gemm_phase<pg8::EpiStore, pg8::MoeOrder, false, true>(c.lds, g, S, E);
        if (P21_TAIL_EN && split && (int)c.bx < rtail * pg8::EpiSplitK::SK) {
            const int tu = (int)c.bx / pg8::EpiSplitK::SK, ks = (int)c.bx % pg8::EpiSplitK::SK;
            pg8::TailOrder TS; pg8::order_map(S.lim + tu, S.nwg, S.t8, S.nN, TS.u0.pm, TS.u0.pn); TS.u0.pb = S.expert_of(TS.u0.pm) * S.nN + TS.u0.pn;
            constexpr int KS = ED / 2 / pg8::EpiSplitK::SK;
            pg8::Gemm g2{(const bf16*)(ws + WS_HM2) + ks * KS, (const bf16*)(ws + WS_WDM) + ks * KS, KS, MOE_DN_E8M0, ED / 2};
            pg8::EpiSplitK E2{(float*)(ws + WS_PART) + (size_t)tu * pg8::EpiSplitK::SK * 65536, ks, ctl + CW_SPL + 16 * tu + P21_CNT_OFF, (bf16*)(ws + WS_Y2), D};
            pg8::gemm_phase<pg8::EpiSplitK, pg8::TailOrder, false, true>(c.lds, g2, TS, E2); } } }
        if (rep_ + 1 < NREP(21)) GRID_BARRIER(bar); } }
    SEAM(21);
    if (IN(22)) {
#pragma unroll 1
        for (int rep_ = 0; rep_ < NREP(22); ++rep_) { { phase22(c, XR, out); }
        if (rep_ + 1 < NREP(22)) GRID_BARRIER(bar); } }
#undef IN
#undef SEAM
}

extern "C" void kernel_launch(void* const* d_in, const int* in_sizes, int n_in, void* d_out, int out_size, void* d_ws, size_t ws_size, hipStream_t stream) {
    static int grid = 0;
    if (grid == 0) {
        if (n_in != 42 || in_sizes[0] != M * D || out_size != M * D || ws_size < WS_END) { fprintf(stderr, "kernel_launch: unexpected shapes (n_in %d, in0 %d, out %d, ws %zu)\n", n_in, n_in > 0 ? in_sizes[0] : -1, out_size, ws_size); grid = -1; return; }
        int dev = 0, cus = 0, per_cu = 0;
        if (hipGetDevice(&dev) != hipSuccess || hipDeviceGetAttribute(&cus, hipDeviceAttributeMultiprocessorCount, dev) != hipSuccess) { grid = -1; return; }
        if (hipFuncSetAttribute((const void*)fwd, hipFuncAttributeMaxDynamicSharedMemorySize, LDS_BYTES) != hipSuccess) { fprintf(stderr, "kernel_launch: hipFuncSetAttribute failed\n"); grid = -1; return; }
        if (hipOccupancyMaxActiveBlocksPerMultiprocessor(&per_cu, (const void*)fwd, NTHR, LDS_BYTES) != hipSuccess || per_cu < 1) fprintf(stderr, "kernel_launch: occupancy query says %d\n", per_cu);
        (void)hipGetLastError();
        grid = cus;
    }
    if (grid < 0) return;
    (void)hipMemsetAsync((char*)d_ws + WS_CTL, 0, CTL_ZERO_BYTES, stream);
    Args a{};
    for (int i = 0; i < 42; ++i) a.in[i] = d_in[i];
    a.out = (float*)d_out; a.ws = (unsigned char*)d_ws;
#if PROBE_BUILD
#ifdef PROBE_ZERO
    a.repmask = 0; a.pad = 0;
#else
    a.repmask = REPMASK; a.pad = 0;
#endif
#endif
#if ONE_LAUNCH
    a.ph_lo = 0; a.ph_hi = LAST_PHASE + 1;
    hipLaunchKernelGGL(fwd, dim3(grid), dim3(NTHR), LDS_BYTES, stream, a);
#else
    for (int p = 0; p <= LAST_PHASE; ++p) { a.ph_lo = p; a.ph_hi = p + 1; hipLaunchKernelGGL(fwd, dim3(grid), dim3(NTHR), LDS_BYTES, stream, a); }
#endif
}
```

```cpp
#include <hip/hip_runtime.h>
#include <hip/hip_bf16.h>
#include <cstdio>
#include <cstdint>
#include <cmath>

#define LAS __attribute__((address_space(3)))
#define GAS __attribute__((address_space(1)))
typedef unsigned short bf16;
typedef short bf16x8 __attribute__((ext_vector_type(8)));
typedef float f32x4 __attribute__((ext_vector_type(4)));
typedef float f32x2 __attribute__((ext_vector_type(2)));
typedef unsigned u32x4 __attribute__((ext_vector_type(4)));
typedef unsigned u32x2 __attribute__((ext_vector_type(2)));
typedef GAS unsigned gu32;

__device__ __forceinline__ unsigned cvt_pk_bf16(float lo, float hi) { unsigned r; asm volatile("v_cvt_pk_bf16_f32 %0, %1, %2" : "=v"(r) : "v"(lo), "v"(hi)); return r; }
__device__ __forceinline__ float bflo(unsigned w) { return __builtin_bit_cast(float, w << 16); }
__device__ __forceinline__ float bfhi(unsigned w) { return __builtin_bit_cast(float, w & 0xffff0000u); }
__device__ __forceinline__ float bf1(bf16 b) { return __builtin_bit_cast(float, (unsigned)b << 16); }
__device__ __forceinline__ bf16 f2bf(float f) { return (bf16)(cvt_pk_bf16(f, 0.f) & 0xffffu); }
__device__ __forceinline__ float rbf(float f) { return bflo(cvt_pk_bf16(f, 0.f)); }
__device__ __forceinline__ void unpack8(u32x4 w, float (&f)[8]) { f[0] = bflo(w.x); f[1] = bfhi(w.x); f[2] = bflo(w.y); f[3] = bfhi(w.y); f[4] = bflo(w.z); f[5] = bfhi(w.z); f[6] = bflo(w.w); f[7] = bfhi(w.w); }
__device__ __forceinline__ u32x4 pack8(const float (&f)[8]) { u32x4 w; w.x = cvt_pk_bf16(f[0], f[1]); w.y = cvt_pk_bf16(f[2], f[3]); w.z = cvt_pk_bf16(f[4], f[5]); w.w = cvt_pk_bf16(f[6], f[7]); return w; }
__device__ __forceinline__ float wave_sum(float v) {
#pragma unroll
    for (int o = 1; o < 64; o <<= 1) v += __shfl_xor(v, o);
    return v;
}
__device__ __forceinline__ float sigmoidf_(float x) { return __builtin_amdgcn_rcpf(1.0f + __expf(-x)); }
__device__ __forceinline__ float tanhf_(float x) { const float e = __expf(2.0f * x); return 1.0f - 2.0f * __builtin_amdgcn_rcpf(e + 1.0f); }
__device__ __forceinline__ float gelu_tanh(float x) { return 0.5f * x * (1.0f + tanhf_(0.7978845608028654f * (x + 0.044715f * x * x * x))); }
__device__ __forceinline__ float silu_(float x) { return x * __builtin_amdgcn_rcpf(1.0f + __expf(-x)); }
#define ONE_LAUNCH 1
namespace pg8 {
typedef unsigned short bf16_t;
constexpr int BM = 256, BK = 64, HALF = 128, HTB = HALF * BK * 2  , STAGE_BYTES = 8 * HTB, NXCD = 8, WGM = 8;
__host__ __device__ __forceinline__ int lds_byte(int r, int c) { const int st = (r >> 4) * 2 + (c >> 5), rr = r & 15, cc = c & 31, ob = rr * 64 + cc * 2; return st * 1024 + (ob ^ (((ob >> 9) & 1) << 5)); }
__host__ __device__ __forceinline__ void stage_rc(int b, int& R, int& C) { const int st = b / 1024, sb = b % 1024, swz = sb ^ (((sb >> 9) & 1) << 5); R = (st >> 1) * 16 + swz / 64; C = (st & 1) * 32 + (swz % 64) / 2; }
__host__ __device__ __forceinline__ int perm32(int rho) { const int n = rho >> 4, i = rho & 15; return 8 * (i >> 2) + 4 * n + (i & 3); }

struct Unit { int pm, pn, pb; };
struct Gemm { const bf16_t* A; const bf16_t* Bt; int K; int scale; int ld; };
typedef int i32x4_t __attribute__((ext_vector_type(4))); typedef int i32x8_t __attribute__((ext_vector_type(8)));

__device__ __forceinline__ void order_map(int L, int nwg, int nM, int nN, int& pm, int& pn) {
    int wgid = L; { const int q = nwg / NXCD, r = nwg % NXCD, xcd = wgid % NXCD, off = wgid / NXCD; wgid = (xcd < r ? xcd * (q + 1) : r * (q + 1) + (xcd - r) * q) + off; }
    const int nig = WGM * nN, gid = wgid / nig, fm = gid * WGM, gsz = (nM - fm) < WGM ? (nM - fm) : WGM;
    pm = fm + ((wgid % nig) % gsz); pn = (wgid % nig) / gsz;
}
template <int KMODE> struct StaticOrderT {
    int nM, nN, nwg, G, c;
    __device__ __forceinline__ void init(int M, int N, int G_, int c_) { nM = M / BM; nN = N / BM; nwg = nM * nN; G = G_; c = c_; }
    __device__ __forceinline__ int koff(const Unit& u) const { return KMODE == 1 ? (u.pn >= 4 ? 128 : 0) : KMODE == 2 ? (u.pn & 1) * 256 : 0; }
    __device__ __forceinline__ bool next(int i, Unit& u) const {
        const long L = (long)i * G + c; if (L >= nwg) return false;
        order_map((int)L, nwg, nM, nN, u.pm, u.pn); u.pb = u.pn; return true;
    }
    __device__ __forceinline__ int gather(const Unit&, int) const { return 0; }
    __device__ __forceinline__ const int* gather_ptr(const Unit&, int) const { return nullptr; }
};
typedef StaticOrderT<0> StaticOrder;
struct MoeOrder {
    int t1, t2, t3, t4, t5, t6, t7, t8;
    int c0, c1, c2, c3, c4, c5, c6, c7;
    int nN, nwg, lim, G, c; const int* list;
    __device__ __forceinline__ void init(const unsigned* cntw, int nN_, int G_, int c_, const int* list_) {
        c0 = (int)__builtin_amdgcn_readfirstlane(__hip_atomic_load(cntw + 0 * 64, __ATOMIC_RELAXED, __HIP_MEMORY_SCOPE_AGENT));
        c1 = (int)__builtin_amdgcn_readfirstlane(__hip_atomic_load(cntw + 1 * 64, __ATOMIC_RELAXED, __HIP_MEMORY_SCOPE_AGENT));
        c2 = (int)__builtin_amdgcn_readfirstlane(__hip_atomic_load(cntw + 2 * 64, __ATOMIC_RELAXED, __HIP_MEMORY_SCOPE_AGENT));
        c3 = (int)__builtin_amdgcn_readfirstlane(__hip_atomic_load(cntw + 3 * 64, __ATOMIC_RELAXED, __HIP_MEMORY_SCOPE_AGENT));
        c4 = (int)__builtin_amdgcn_readfirstlane(__hip_atomic_load(cntw + 4 * 64, __ATOMIC_RELAXED, __HIP_MEMORY_SCOPE_AGENT));
        c5 = (int)__builtin_amdgcn_readfirstlane(__hip_atomic_load(cntw + 5 * 64, __ATOMIC_RELAXED, __HIP_MEMORY_SCOPE_AGENT));
        c6 = (int)__builtin_amdgcn_readfirstlane(__hip_atomic_load(cntw + 6 * 64, __ATOMIC_RELAXED, __HIP_MEMORY_SCOPE_AGENT));
        c7 = (int)__builtin_amdgcn_readfirstlane(__hip_atomic_load(cntw + 7 * 64, __ATOMIC_RELAXED, __HIP_MEMORY_SCOPE_AGENT));
        t1 = (c0 + 255) >> 8; t2 = t1 + ((c1 + 255) >> 8); t3 = t2 + ((c2 + 255) >> 8); t4 = t3 + ((c3 + 255) >> 8);
        t5 = t4 + ((c4 + 255) >> 8); t6 = t5 + ((c5 + 255) >> 8); t7 = t6 + ((c6 + 255) >> 8); t8 = t7 + ((c7 + 255) >> 8);
        nN = nN_; nwg = t8 * nN_; lim = nwg; G = G_; c = c_; list = list_;
    }
    __device__ __forceinline__ int koff(const Unit&) const { return 0; }
    __device__ __forceinline__ int expert_of(int pm) const { return (pm >= t1) + (pm >= t2) + (pm >= t3) + (pm >= t4) + (pm >= t5) + (pm >= t6) + (pm >= t7); }
    __device__ __forceinline__ bool next(int i, Unit& u) const {
        const long L = (long)i * G + c; if (L >= lim) return false;
        order_map((int)L, nwg, t8, nN, u.pm, u.pn); u.pb = expert_of(u.pm) * nN + u.pn; return true;
    }
    __device__ __forceinline__ int gather(const Unit& u, int r) const {
        const int e = expert_of(u.pm);
        const int tb = e == 0 ? 0 : e == 1 ? t1 : e == 2 ? t2 : e == 3 ? t3 : e == 4 ? t4 : e == 5 ? t5 : e == 6 ? t6 : t7;
        const int ce = e == 0 ? c0 : e == 1 ? c1 : e == 2 ? c2 : e == 3 ? c3 : e == 4 ? c4 : e == 5 ? c5 : e == 6 ? c6 : c7;
        int slot = (u.pm - tb) * 256 + r; if (slot >= ce) slot = 0;
        return list[e * 16384 + slot];
    }
    __device__ __forceinline__ const int* gather_ptr(const Unit& u, int r) const {
        const int e = expert_of(u.pm);
        const int tb = e == 0 ? 0 : e == 1 ? t1 : e == 2 ? t2 : e == 3 ? t3 : e == 4 ? t4 : e == 5 ? t5 : e == 6 ? t6 : t7;
        const int ce = e == 0 ? c0 : e == 1 ? c1 : e == 2 ? c2 : e == 3 ? c3 : e == 4 ? c4 : e == 5 ? c5 : e == 6 ? c6 : c7;
        int slot = (u.pm - tb) * 256 + r; if (slot >= ce) slot = 0;
        return list + e * 16384 + slot;
    }
};

struct TailOrder {
    Unit u0;
    __device__ __forceinline__ int koff(const Unit&) const { return 0; }
    __device__ __forceinline__ bool next(int i, Unit& u) const { if (i != 0) return false; u = u0; return true; }
    __device__ __forceinline__ int gather(const Unit&, int) const { return 0; }
    __device__ __forceinline__ const int* gather_ptr(const Unit&, int) const { return nullptr; }
};

struct EpiStore {
    static constexpr bool PERM = true;
    bf16_t* O; int ldc; int split_cols; size_t split_stride;
    __device__ __forceinline__ void operator()(const f32x4 (&acc)[2][2][4][2], const Unit& u, int wr, int wc, int fr, int fq, const float* rowv = nullptr) const {
        const int row0 = u.pm * BM + wr * 64 + fr; int colt = u.pn * BM; bf16_t* base = O;
        if (split_cols) { const int t = colt / split_cols; base += (size_t)t * split_stride; colt -= t * split_cols; }
        const int col0 = colt + wc * 64 + 8 * fq;
#pragma unroll
        for (int ai = 0; ai < 2; ++ai)
#pragma unroll
            for (int m = 0; m < 4; ++m) { bf16_t* rowp = base + (size_t)(row0 + ai * HALF + m * 16) * ldc + col0; const float r = rowv ? rowv[ai * 4 + m] : 1.0f;
#pragma unroll
                for (int bj = 0; bj < 2; ++bj) { const f32x4 v0 = acc[ai][bj][m][0] * r, v1 = acc[ai][bj][m][1] * r;
                    u32x4 w; w.x = cvt_pk_bf16(v0[0], v0[1]); w.y = cvt_pk_bf16(v0[2], v0[3]); w.z = cvt_pk_bf16(v1[0], v1[1]); w.w = cvt_pk_bf16(v1[2], v1[3]);
                    *(u32x4*)(rowp + bj * 32) = w; } }
    }
};
struct EpiSplitK {
    static constexpr bool PERM = true; static constexpr int SK = 7, RW = 37;
    float* part; int ks; unsigned* cnt; bf16_t* O; int ldc;
    __device__ __forceinline__ void operator()(const f32x4 (&acc)[2][2][4][2], const Unit& u, int wr, int wc, int fr, int fq) const {
        float* P = part + (size_t)ks * (BM * BM);
        const int row0 = wr * 64 + fr, col0 = wc * 64 + 8 * fq;
#pragma unroll
        for (int ai = 0; ai < 2; ++ai)
#pragma unroll
            for (int m = 0; m < 4; ++m) { float* rowp = P + (row0 + ai * HALF + m * 16) * BM + col0;
#pragma unroll
                for (int bj = 0; bj < 2; ++bj) { *(f32x4*)(rowp + bj * 32) = acc[ai][bj][m][0]; *(f32x4*)(rowp + bj * 32 + 4) = acc[ai][bj][m][1]; } }
        asm volatile("s_waitcnt vmcnt(0)" ::: "memory");
        __syncthreads();
        if (threadIdx.x == 0) {
            __builtin_amdgcn_fence(__ATOMIC_RELEASE, "agent");
            (void)__hip_atomic_fetch_add(cnt, 1u, __ATOMIC_RELAXED, __HIP_MEMORY_SCOPE_AGENT);
            unsigned sp = 0u;
            while (__hip_atomic_load(cnt, __ATOMIC_RELAXED, __HIP_MEMORY_SCOPE_AGENT) < (unsigned)SK) { __builtin_amdgcn_s_sleep(1); if (++sp > (1u << 22)) break; }
            __builtin_amdgcn_fence(__ATOMIC_ACQUIRE, "agent");
        }
        __syncthreads();
        const int r0 = ks * RW, nr = (BM - r0) < RW ? (BM - r0) : RW;
        constexpr int NI = (RW * 64 + 511) / 512;
        f32x4 v[NI][SK];
#pragma unroll
        for (int i = 0; i < NI; ++i) { int f = (int)threadIdx.x + 512 * i; f = f < nr * 64 ? f : nr * 64 - 1;
            const float* src = part + (r0 + (f >> 6)) * BM + (f & 63) * 4;
#pragma unroll
            for (int k = 0; k < SK; ++k) v[i][k] = *(const f32x4*)(src + (size_t)k * (BM * BM)); }
#pragma unroll
        for (int i = 0; i < NI; ++i) { const int f = (int)threadIdx.x + 512 * i;
            f32x4 s = v[i][0];
#pragma unroll
            for (int k = 1; k < SK; ++k) s += v[i][k];
            u32x2 w; w.x = cvt_pk_bf16(s[0], s[1]); w.y = cvt_pk_bf16(s[2], s[3]);
            if (f < nr * 64) *(u32x2*)(O + (size_t)(u.pm * BM + r0 + (f >> 6)) * ldc + u.pn * BM + (f & 63) * 4) = w; }
    }
};
struct EpiSwiGLU {
    static constexpr bool PERM = true;
    bf16_t* H; int ldh;
    __device__ __forceinline__ void operator()(const f32x4 (&acc)[2][2][4][2], const Unit& u, int wr, int wc, int fr, int fq, const float* rowv = nullptr) const {
        const int row0 = u.pm * BM + wr * 64 + fr; const int col0 = u.pn * HALF + wc * 32 + 8 * fq;
#pragma unroll
        for (int ai = 0; ai < 2; ++ai)
#pragma unroll
            for (int m = 0; m < 4; ++m) { bf16_t* rowp = H + (size_t)(row0 + ai * HALF + m * 16) * ldh + col0; const float r = rowv ? rowv[ai * 4 + m] : 1.0f;
                const f32x4 g0 = acc[ai][0][m][0] * r, g1 = acc[ai][0][m][1] * r, u0 = acc[ai][1][m][0] * r, u1 = acc[ai][1][m][1] * r;
                u32x4 w; w.x = cvt_pk_bf16(silu_(g0[0]) * u0[0], silu_(g0[1]) * u0[1]); w.y = cvt_pk_bf16(silu_(g0[2]) * u0[2], silu_(g0[3]) * u0[3]);
                w.z = cvt_pk_bf16(silu_(g1[0]) * u1[0], silu_(g1[1]) * u1[1]); w.w = cvt_pk_bf16(silu_(g1[2]) * u1[2], silu_(g1[3]) * u1[3]);
                *(u32x4*)rowp = w; }
    }
};
__device__ __forceinline__ unsigned pk4_fp8(float a, float b, float c, float d) { int v = 0; v = __builtin_amdgcn_cvt_pk_fp8_f32(a, b, v, false); v = __builtin_amdgcn_cvt_pk_fp8_f32(c, d, v, true); return (unsigned)v; }
struct EpiSwiGLU8 {
    static constexpr bool PERM = true;
    unsigned char* H; int ldh; float oscale;
    __device__ __forceinline__ void operator()(const f32x4 (&acc)[2][2][4][2], const Unit& u, int wr, int wc, int fr, int fq) const {
        const int row0 = u.pm * BM + wr * 64 + fr; const int col0 = u.pn * HALF + wc * 32 + 8 * fq;
#pragma unroll
        for (int ai = 0; ai < 2; ++ai)
#pragma unroll
            for (int m = 0; m < 4; ++m) { unsigned char* rowp = H + (size_t)(row0 + ai * HALF + m * 16) * ldh + col0;
                const f32x4 g0 = acc[ai][0][m][0], g1 = acc[ai][0][m][1], u0 = acc[ai][1][m][0] * oscale, u1 = acc[ai][1][m][1] * oscale;
                u32x2 w; w.x = pk4_fp8(silu_(g0[0]) * u0[0], silu_(g0[1]) * u0[1], silu_(g0[2]) * u0[2], silu_(g0[3]) * u0[3]);
                w.y = pk4_fp8(silu_(g1[0]) * u1[0], silu_(g1[1]) * u1[1], silu_(g1[2]) * u1[2], silu_(g1[3]) * u1[3]);
                *(u32x2*)rowp = w; }
    }
};
template <class Base> struct RowScaled : Base {
    const float* rsq;
    __device__ __forceinline__ void operator()(const f32x4 (&acc)[2][2][4][2], const Unit& u, int wr, int wc, int fr, int fq, const float (&ss)[8]) const {
        float rowv[8];
#pragma unroll
        for (int i = 0; i < 8; ++i) rowv[i] = rsqrtf(ss[i] * (1.0f / 1024.0f) + 1e-6f);
        Base::operator()(acc, u, wr, wc, fr, fq, rowv);
    }
};
template <class T> struct is_rowscaled { static constexpr bool value = false; };
template <class B> struct is_rowscaled<RowScaled<B>> { static constexpr bool value = true; };
constexpr int ROWS_OFF = STAGE_BYTES + 1024;
struct EpiResid {
    static constexpr bool PERM = false;
    const float* resid; float* out; int ldc;
    __device__ __forceinline__ void operator()(const f32x4 (&acc)[2][2][4][2], const Unit& u, int wr, int wc, int fr, int fq) const {
        const int col0 = u.pn * BM + wc * 32 + 4 * fq;
#pragma unroll
        for (int ai = 0; ai < 2; ++ai)
#pragma unroll
            for (int m = 0; m < 4; ++m) { const size_t off = (size_t)(u.pm * BM + ai * HALF + wr * 64 + m * 16 + fr) * ldc + col0;
                f32x4 rs[2][2];
#pragma unroll
                for (int bj = 0; bj < 2; ++bj)
#pragma unroll
                    for (int n = 0; n < 2; ++n) rs[bj][n] = *(const f32x4*)(resid + off + bj * HALF + n * 16);
#pragma unroll
                for (int bj = 0; bj < 2; ++bj)
#pragma unroll
                    for (int n = 0; n < 2; ++n) *(f32x4*)(out + off + bj * HALF + n * 16) = rs[bj][n] + acc[ai][bj][m][n];
                if (m & 1) asm volatile("" ::: "memory"); }
    }
};

struct EpiResidB {
    static constexpr bool PERM = true;
    const float* rf; const bf16_t* rb; bf16_t* O; int ldc; float* rsq;
    __device__ __forceinline__ void operator()(const f32x4 (&acc)[2][2][4][2], const Unit& u, int wr, int wc, int fr, int fq) const {
        const int col0 = u.pn * BM + wc * 64 + 8 * fq;
#pragma unroll
        for (int ai = 0; ai < 2; ++ai)
#pragma unroll
            for (int m = 0; m < 4; ++m) { const size_t off = (size_t)(u.pm * BM + ai * HALF + wr * 64 + m * 16 + fr) * ldc + col0;
                f32x4 rs[2][2];
#pragma unroll
                for (int bj = 0; bj < 2; ++bj) {
                    if (rf) { rs[bj][0] = *(const f32x4*)(rf + off + bj * 32); rs[bj][1] = *(const f32x4*)(rf + off + bj * 32 + 4); }
                    else { const u32x4 w = *(const u32x4*)(rb + off + bj * 32); rs[bj][0] = (f32x4){bflo(w.x), bfhi(w.x), bflo(w.y), bfhi(w.y)}; rs[bj][1] = (f32x4){bflo(w.z), bfhi(w.z), bflo(w.w), bfhi(w.w)}; } }
                float ss = 0.f;
#pragma unroll
                for (int bj = 0; bj < 2; ++bj) { const f32x4 v0 = rs[bj][0] + acc[ai][bj][m][0], v1 = rs[bj][1] + acc[ai][bj][m][1];
                    ss += (v0[0] * v0[0] + v0[1] * v0[1]) + (v0[2] * v0[2] + v0[3] * v0[3]) + (v1[0] * v1[0] + v1[1] * v1[1]) + (v1[2] * v1[2] + v1[3] * v1[3]);
                    u32x4 w; w.x = cvt_pk_bf16(v0[0], v0[1]); w.y = cvt_pk_bf16(v0[2], v0[3]); w.z = cvt_pk_bf16(v1[0], v1[1]); w.w = cvt_pk_bf16(v1[2], v1[3]);
                    *(u32x4*)(O + off + bj * 32) = w; }
                if (rsq) { ss += __shfl_xor(ss, 16); ss += __shfl_xor(ss, 32);
                    ss = rintf(ss * 256.0f) * (1.0f / 256.0f);
                    if (fq == 0) (void)__hip_atomic_fetch_add(rsq + u.pm * BM + ai * HALF + wr * 64 + m * 16 + fr, ss, __ATOMIC_RELAXED, __HIP_MEMORY_SCOPE_AGENT); }
                if (m & 1) asm volatile("" ::: "memory"); }
    }
};

#ifndef PG8_ALIGN_DEFAULT
#define PG8_ALIGN_DEFAULT true
#endif
template <class Epi, class Sched, bool GATHER, bool FP8 = false, bool ALIGN_EPI = PG8_ALIGN_DEFAULT>
__device__ __forceinline__ void gemm_phase(LAS unsigned char* lds, const Gemm g, const Sched& S, const Epi& E) {
    const int tid = threadIdx.x, wid = __builtin_amdgcn_readfirstlane(tid >> 6), lane = tid & 63, wr = wid >> 2, wc = wid & 3, fr = lane & 15, fq = lane >> 4;
    const int K = g.ld ? g.ld : g.K; int nt = g.K / BK; asm volatile("" : "+s"(nt));
    const size_t kstep = (size_t)(BK * 2);
    const size_t hstep = (size_t)HALF * K * 2;
    const size_t tstep = 2 * hstep;
    int sR[2], sC[2];
    unsigned voffB[2];
    const size_t bstep = Epi::PERM ? (size_t)32 * K * 2 : hstep;
#pragma unroll
    for (int i = 0; i < 2; ++i) { stage_rc(tid * 16 + i * 8192, sR[i], sC[i]);
        const int Rb0 = Epi::PERM ? (64 * (sR[i] >> 5) + perm32(sR[i] & 31)) : sR[i];
        voffB[i] = (unsigned)(Rb0 * K + sC[i]) * 2u; }
    const unsigned ldsw = (unsigned)wid * 1024u;
    const int aoff = lds_byte(wr * 64 + fr, fq * 8), boff = lds_byte(wc * 32 + fr, fq * 8);
#define PG8_SA(b, h) (((b) * 2 + (h)) * HTB)
#define PG8_SB(b, h) ((4 + (b) * 2 + (h)) * HTB)
#define PG8_STAGE(bufoff, gbase, voff) do { _Pragma("unroll") for (int _i = 0; _i < 2; ++_i) \
        __builtin_amdgcn_global_load_lds((const unsigned*)((const char*)(gbase) + (voff)[_i]), (LAS unsigned*)(lds + (bufoff) + ldsw + _i * 8192), 16, 0, 0); } while (0)
#define PG8_STAGEA(bufoff, gbase, o0, o1) do { \
        __builtin_amdgcn_global_load_lds((const unsigned*)((const char*)(gbase) + (o0)), (LAS unsigned*)(lds + (bufoff) + ldsw), 16, 0, 0); \
        __builtin_amdgcn_global_load_lds((const unsigned*)((const char*)(gbase) + (o1)), (LAS unsigned*)(lds + (bufoff) + ldsw + 8192), 16, 0, 0); } while (0)
#define PG8_LDA(dst, b, h) do { _Pragma("unroll") for (int m = 0; m < 4; ++m) _Pragma("unroll") for (int k = 0; k < 2; ++k) dst[m][k] = *(const LAS bf16x8*)(lds + PG8_SA(b, h) + aoff + m * 2048 + k * 1024); } while (0)
#define PG8_LDB(dst, b, h) do { _Pragma("unroll") for (int n = 0; n < 2; ++n) _Pragma("unroll") for (int k = 0; k < 2; ++k) dst[n][k] = *(const LAS bf16x8*)(lds + PG8_SB(b, h) + boff + n * 2048 + k * 1024); } while (0)
#define PG8_CAT(x) __builtin_shufflevector(__builtin_bit_cast(i32x4_t, x[0]), __builtin_bit_cast(i32x4_t, x[1]), 0, 1, 2, 3, 4, 5, 6, 7)
#define PG8_MMA(ai, bj, At, Bt) do { __builtin_amdgcn_s_setprio(1); \
        if constexpr (FP8) { _Pragma("unroll") for (int m = 0; m < 4; ++m) _Pragma("unroll") for (int n = 0; n < 2; ++n) \
            { const i32x8_t b8_ = PG8_CAT(Bt[n]), a8_ = PG8_CAT(At[m]); asm volatile("v_mfma_scale_f32_16x16x128_f8f6f4 %0, %1, %2, %0, %3, %4 op_sel_hi:[0,0,0]" : "+v"(acc[ai][bj][m][n]) : "v"(b8_), "v"(a8_), "v"(sc_w), "v"(sc_a)); } } \
        else { _Pragma("unroll") for (int m = 0; m < 4; ++m) _Pragma("unroll") for (int n = 0; n < 2; ++n) _Pragma("unroll") for (int k = 0; k < 2; ++k) \
            acc[ai][bj][m][n] = __builtin_amdgcn_mfma_f32_16x16x32_bf16(Bt[n][k], At[m][k], acc[ai][bj][m][n], 0, 0, 0); } \
        __builtin_amdgcn_s_setprio(0); } while (0)
#define PG8_WAIT_V(n) asm volatile("s_waitcnt vmcnt(" #n ")" ::: "memory")
#define PG8_WAIT_L(n) asm volatile("s_waitcnt lgkmcnt(" #n ")" ::: "memory")
#define PG8_BAR __builtin_amdgcn_s_barrier()
#define PG8_SCHED __builtin_amdgcn_sched_barrier(0)
    Unit cur, nxt; int ui = 0;
    if (!S.next(0, cur)) return;
    constexpr bool ROWS = is_rowscaled<Epi>::value;
    int rsl = 0; (void)rsl;
#define PG8_ROWDMA(unit, slot) do { if constexpr (ROWS) { if (wid < 4) __builtin_amdgcn_global_load_lds((const unsigned*)(E.rsq + (size_t)(unit).pm * BM + wid * 64 + lane), \
        (LAS unsigned*)(lds + ROWS_OFF + (slot) * 1024 + wid * 256), 4, 0, 0); } } while (0)
    PG8_ROWDMA(cur, 0);
    int sc_w = g.scale, sc_a = 0x7f7f7f7f; asm volatile("" : "+v"(sc_w), "+v"(sc_a));
    (void)sc_w; (void)sc_a;
    unsigned oC00, oC01, oC10, oC11, oN00, oN01, oN10, oN11;
    if constexpr (GATHER) {
        oC00 = (unsigned)(S.gather(cur, sR[0]) * K + sC[0]) * 2u; oC01 = (unsigned)(S.gather(cur, sR[1]) * K + sC[1]) * 2u;
        oC10 = (unsigned)(S.gather(cur, 128 + sR[0]) * K + sC[0]) * 2u; oC11 = (unsigned)(S.gather(cur, 128 + sR[1]) * K + sC[1]) * 2u;
    } else {
        oC00 = (unsigned)(sR[0] * K + sC[0]) * 2u; oC01 = (unsigned)(sR[1] * K + sC[1]) * 2u; oC10 = oC00 + (unsigned)hstep; oC11 = oC01 + (unsigned)hstep;
    }
    oN00 = oC00; oN01 = oC01; oN10 = oC10; oN11 = oC11;
    int tkN0 = 0, tkN1 = 0, tkN2 = 0, tkN3 = 0; bool gnext = false; (void)tkN0; (void)tkN1; (void)tkN2; (void)tkN3; (void)gnext;
    f32x4 acc[2][2][4][2];
#pragma unroll
    for (int a = 0; a < 2; ++a)
#pragma unroll
        for (int b = 0; b < 2; ++b)
#pragma unroll
            for (int m = 0; m < 4; ++m)
#pragma unroll
                for (int n = 0; n < 2; ++n) acc[a][b][m][n] = (f32x4){0.f, 0.f, 0.f, 0.f};
    bf16x8 At[4][2], B0[2][2], B1[2][2];
    const char* cA = (const char*)g.A + (GATHER ? (size_t)0 : (size_t)cur.pm * tstep) + S.koff(cur) * 2; const char* cB = (const char*)g.Bt + (size_t)cur.pb * tstep + S.koff(cur) * 2;
    PG8_STAGE(PG8_SB(0, 0), cB, voffB); PG8_STAGE(PG8_SB(0, 1), cB + bstep, voffB); PG8_STAGEA(PG8_SA(0, 0), cA, oC00, oC01); PG8_STAGEA(PG8_SA(0, 1), cA, oC10, oC11);
    if (wr == 1) PG8_BAR;
    PG8_WAIT_V(2); PG8_BAR;
    PG8_STAGE(PG8_SB(1, 0), cB + kstep, voffB); PG8_STAGEA(PG8_SA(1, 0), cA + kstep, oC00, oC01); PG8_STAGE(PG8_SB(1, 1), cB + bstep + kstep, voffB);
    PG8_WAIT_V(6); PG8_BAR;
    for (;;) {
        const bool has_next = S.next(ui + 1, nxt);
        const char* nA = has_next ? (const char*)g.A + (GATHER ? (size_t)0 : (size_t)nxt.pm * tstep) + S.koff(nxt) * 2 : cA; const char* nB = has_next ? (const char*)g.Bt + (size_t)nxt.pb * tstep + S.koff(nxt) * 2 : cB;
        if (has_next) PG8_ROWDMA(nxt, rsl == 2 ? 0 : rsl + 1);
        if constexpr (GATHER) {
            if (has_next) { const int* p0 = S.gather_ptr(nxt, sR[0]); const int* p1 = S.gather_ptr(nxt, sR[1]); const int* p2 = S.gather_ptr(nxt, 128 + sR[0]); const int* p3 = S.gather_ptr(nxt, 128 + sR[1]);
                asm volatile("global_load_dword %0, %4, off\n\tglobal_load_dword %1, %5, off\n\tglobal_load_dword %2, %6, off\n\tglobal_load_dword %3, %7, off"
                             : "=&v"(tkN0), "=&v"(tkN1), "=&v"(tkN2), "=&v"(tkN3) : "v"(p0), "v"(p1), "v"(p2), "v"(p3) : "memory"); gnext = true;
            } else gnext = false;
        }
        for (int t = 0; t < nt; t += 2) {
            const bool last = (t == nt - 2);
            const char* a1 = cA + (size_t)(t + 1) * kstep;
            const char* a2 = last ? nA : cA + (size_t)(t + 2) * kstep; const char* b2 = last ? nB : cB + (size_t)(t + 2) * kstep;
            const char* a3 = a2 + kstep; const char* b3 = b2 + kstep;
            unsigned o00 = oC00, o01 = oC01, o10 = oC10, o11 = oC11;
            if constexpr (GATHER) { if (last) { asm volatile("" : "+v"(tkN0), "+v"(tkN1), "+v"(tkN2), "+v"(tkN3));
                if (gnext) { oN00 = (unsigned)(tkN0 * K + sC[0]) * 2u; oN01 = (unsigned)(tkN1 * K + sC[1]) * 2u; oN10 = (unsigned)(tkN2 * K + sC[0]) * 2u; oN11 = (unsigned)(tkN3 * K + sC[1]) * 2u; }
                else { oN00 = oC00; oN01 = oC01; oN10 = oC10; oN11 = oC11; }
                o00 = oN00; o01 = oN01; o10 = oN10; o11 = oN11; } }
            PG8_LDB(B0, 0, 0); PG8_LDB(B1, 0, 1); PG8_SCHED; PG8_LDA(At, 0, 0); PG8_STAGEA(PG8_SA(1, 1), a1, oC10, oC11);
            PG8_WAIT_V(8); PG8_WAIT_L(0); PG8_BAR; PG8_MMA(0, 0, At, B0); PG8_MMA(0, 1, At, B1); PG8_BAR; PG8_SCHED;
            PG8_LDA(At, 0, 1); PG8_STAGE(PG8_SB(0, 0), b2, voffB); PG8_STAGE(PG8_SB(0, 1), b2 + bstep, voffB); PG8_STAGEA(PG8_SA(0, 0), a2, o00, o01);
            PG8_WAIT_V(8); PG8_WAIT_L(0); PG8_BAR; PG8_MMA(1, 0, At, B0); PG8_MMA(1, 1, At, B1); PG8_BAR; PG8_SCHED;
            PG8_LDB(B0, 1, 0); PG8_LDB(B1, 1, 1); PG8_SCHED; PG8_LDA(At, 1, 0); PG8_STAGEA(PG8_SA(0, 1), a2, o10, o11);
            PG8_WAIT_V(8); PG8_WAIT_L(0); PG8_BAR; PG8_MMA(0, 0, At, B0); PG8_MMA(0, 1, At, B1); PG8_BAR; PG8_SCHED;
            PG8_LDA(At, 1, 1); PG8_STAGE(PG8_SB(1, 0), b3, voffB); PG8_STAGE(PG8_SB(1, 1), b3 + bstep, voffB); PG8_STAGEA(PG8_SA(1, 0), a3, o00, o01);
            PG8_WAIT_V(8); PG8_WAIT_L(0); PG8_BAR; PG8_MMA(1, 0, At, B0); PG8_MMA(1, 1, At, B1); PG8_BAR; PG8_SCHED;
        }
        if constexpr (ALIGN_EPI) { if (wr == 0) PG8_BAR; }
        if constexpr (FP8) asm volatile("s_nop 15\n\ts_nop 15" ::: "memory");
        if constexpr (ROWS) { float ssv[8];
#pragma unroll
            for (int i = 0; i < 8; ++i) ssv[i] = *(const LAS float*)(lds + ROWS_OFF + rsl * 1024 + (wr * 64 + fr + (i >> 2) * HALF + (i & 3) * 16) * 4);
            E(acc, cur, wr, wc, fr, fq, ssv); rsl = rsl == 2 ? 0 : rsl + 1; }
        else E(acc, cur, wr, wc, fr, fq);
        if (!has_next) break;
#pragma unroll
        for (int a = 0; a < 2; ++a)
#pragma unroll
            for (int b = 0; b < 2; ++b)
#pragma unroll
                for (int m = 0; m < 4; ++m)
#pragma unroll
                    for (int n = 0; n < 2; ++n) acc[a][b][m][n] = (f32x4){0.f, 0.f, 0.f, 0.f};
        cur = nxt; cA = nA; cB = nB; ++ui;
        oC00 = oN00; oC01 = oN01; oC10 = oN10; oC11 = oN11;
        if constexpr (ALIGN_EPI) { if (wr == 1) PG8_BAR; }
    }
    PG8_WAIT_V(0);
    if constexpr (!ALIGN_EPI) { if (wr == 0) PG8_BAR; }
    PG8_BAR;
#undef PG8_ROWDMA
#undef PG8_SA
#undef PG8_SB
#undef PG8_STAGE
#undef PG8_STAGEA
#undef PG8_LDA
#undef PG8_LDB
#undef PG8_MMA
#undef PG8_CAT
#undef PG8_WAIT_V
#undef PG8_WAIT_L
#undef PG8_BAR
#undef PG8_SCHED
}
}
namespace attn_body {
using bf16=__hip_bfloat16;
using bf16x8=__attribute__((ext_vector_type(8)))short;
using s16x4=__attribute__((ext_vector_type(4)))short;
using f32x16=__attribute__((ext_vector_type(16)))float;
using u32x4=__attribute__((ext_vector_type(4)))unsigned;
constexpr int BATCH=2,NHEAD=16,SEQ=8192,D=64,DM=NHEAD*D;
constexpr int NW=8,QBLK=32,QB=QBLK*NW,KVBLK=64,NQB=SEQ/QB;
constexpr int ATTN_PITCH=DM, ATTN_UNIT_ROWS=QB;
__device__ __forceinline__ int crow(int r,int hi){return (r&3)+8*(r>>2)+4*hi;}
#define SBAR() __builtin_amdgcn_sched_barrier(0)
__device__ __forceinline__ void cmask(f32x16&p0,f32x16&p1,int jb,int qrel,int hi){
  const float NEG=-INFINITY; int kb=64*jb+4*hi;
  #pragma unroll
  for(int r=0;r<16;++r){int kv=kb+(r&3)+8*(r>>2); if(kv>qrel)p0[r]=NEG; if(kv+32>qrel)p1[r]=NEG;}
}

constexpr int NSLOT=3, SLOTB=8192;
constexpr int LDS_K=0, LDS_V=NSLOT*SLOTB, LDS_WS=3*NSLOT*SLOTB, LDS_OST=LDS_WS+NW*64*4, LDS_BYTES=LDS_OST+NW*4096;
constexpr float C2=0.125f*1.4426950408889634f;
__device__ __forceinline__ void glds16(const void*gsrc,unsigned lds_dst){unsigned keep;
  asm volatile("s_mov_b32 %0, m0\n\ts_mov_b32 m0, %2\n\ts_nop 0\n\tglobal_load_lds_dwordx4 %1, off\n\ts_mov_b32 m0, %0":"=&s"(keep):"v"(gsrc),"s"(lds_dst):"memory");}
__device__ __forceinline__ float max3f(float a,float b,float c){float r;asm("v_max3_f32 %0, %1, %2, %3":"=v"(r):"v"(a),"v"(b),"v"(c));return r;}
__device__ __forceinline__ float max2f(float a,float b){float r;asm("v_max_f32_e32 %0, %1, %2":"=v"(r):"v"(a),"v"(b));return r;}
__device__ __forceinline__ float fadd_s(float a,float b){float r;asm("v_add_f32_e32 %0, %1, %2":"=v"(r):"v"(a),"v"(b));return r;}
__device__ __forceinline__ float fsub_s(float a,float b){float r;asm("v_sub_f32_e32 %0, %1, %2":"=v"(r):"v"(a),"v"(b));return r;}
typedef float f32x2_t __attribute__((ext_vector_type(2))); typedef __bf16 bf16x2_t __attribute__((ext_vector_type(2)));
__device__ __forceinline__ unsigned cvtpk_s(float lo,float hi){f32x2_t v={lo,hi};bf16x2_t b=__builtin_convertvector(v,bf16x2_t);return __builtin_bit_cast(unsigned,b);}
#define WAIT_BAR(N) asm volatile("s_waitcnt vmcnt(" #N ") lgkmcnt(0)\n\ts_barrier":::"memory")

__device__ __forceinline__ void qkt(f32x16&p0,f32x16&p1,const char*Kslot,const bf16x8*qr,const f32x16&negm,int r32,int hi){
  const char*kb=Kslot+hi*1024+r32*16;
  #pragma unroll
  for(int d0=0;d0<4;++d0){
    const bf16x8 b0=*reinterpret_cast<const bf16x8*>(kb+d0*2048);
    const bf16x8 b1=*reinterpret_cast<const bf16x8*>(kb+d0*2048+512);
    if(d0==0){p0=__builtin_amdgcn_mfma_f32_32x32x16_bf16(b0,qr[0],negm,0,0,0);p1=__builtin_amdgcn_mfma_f32_32x32x16_bf16(b1,qr[0],negm,0,0,0);}
    else{p0=__builtin_amdgcn_mfma_f32_32x32x16_bf16(b0,qr[d0],p0,0,0,0);p1=__builtin_amdgcn_mfma_f32_32x32x16_bf16(b1,qr[d0],p1,0,0,0);}}
}
typedef __attribute__((address_space(3))) const char* lds_cptr;
typedef short v4i16_t __attribute__((ext_vector_type(4)));
__device__ __forceinline__ void kload8(bf16x8*kf,lds_cptr kp){
  kf[0]=*(const __attribute__((address_space(3))) bf16x8*)(kp);      kf[1]=*(const __attribute__((address_space(3))) bf16x8*)(kp+512);
  kf[2]=*(const __attribute__((address_space(3))) bf16x8*)(kp+2048); kf[3]=*(const __attribute__((address_space(3))) bf16x8*)(kp+2560);
  kf[4]=*(const __attribute__((address_space(3))) bf16x8*)(kp+4096); kf[5]=*(const __attribute__((address_space(3))) bf16x8*)(kp+4608);
  kf[6]=*(const __attribute__((address_space(3))) bf16x8*)(kp+6144); kf[7]=*(const __attribute__((address_space(3))) bf16x8*)(kp+6656);
}
__device__ __forceinline__ void kload2(bf16x8*kf,lds_cptr kp,int j){ kf[2*j]=*(const __attribute__((address_space(3))) bf16x8*)(kp+j*2048); kf[2*j+1]=*(const __attribute__((address_space(3))) bf16x8*)(kp+j*2048+512); }
__device__ __forceinline__ s16x4 vtr(lds_cptr p){ return __builtin_bit_cast(s16x4,__builtin_amdgcn_ds_read_tr16_b64_v4i16((__attribute__((address_space(3))) v4i16_t*)p)); }
__device__ __forceinline__ float rowmax(const f32x16&p0,const f32x16&p1){
  float a=max3f(p0[0],p0[1],p1[0]),b=max3f(p0[2],p0[3],p1[1]);a=max3f(a,p1[2],p1[3]);
  #pragma unroll
  for(int r=4;r<16;r+=4){a=max3f(a,p0[r],p0[r+1]);b=max3f(b,p0[r+2],p0[r+3]);a=max3f(a,p1[r],p1[r+1]);b=max3f(b,p1[r+2],p1[r+3]);}
  const float m=max2f(a,b);
  auto rr=__builtin_amdgcn_permlane32_swap(__float_as_uint(m),__float_as_uint(m),false,false);
  return max2f(__uint_as_float(rr[0]),__uint_as_float(rr[1]));
}
__device__ __forceinline__ void pv(f32x16*o,int vb,bf16x8 pa0,bf16x8 pa1,bf16x8 pa2,bf16x8 pa3){
  #pragma unroll
  for(int d0=0;d0<4;++d0){s16x4 lo[4],hi[4];
    #pragma unroll
    for(int ks=0;ks<4;++ks){
      asm volatile("ds_read_b64_tr_b16 %0,%1 offset:%c2":"=&v"(lo[ks]):"v"(vb),"i"(d0*4096+ks*1024):"memory");
      asm volatile("ds_read_b64_tr_b16 %0,%1 offset:%c2":"=&v"(hi[ks]):"v"(vb),"i"(d0*4096+ks*1024+512):"memory");}
    asm volatile("s_waitcnt lgkmcnt(0)":::"memory");SBAR();
    #define PK(k) (bf16x8){lo[k][0],lo[k][1],lo[k][2],lo[k][3],hi[k][0],hi[k][1],hi[k][2],hi[k][3]}
    o[d0]=__builtin_amdgcn_mfma_f32_32x32x16_bf16(pa0,PK(0),o[d0],0,0,0);
    o[d0]=__builtin_amdgcn_mfma_f32_32x32x16_bf16(pa1,PK(1),o[d0],0,0,0);
    o[d0]=__builtin_amdgcn_mfma_f32_32x32x16_bf16(pa2,PK(2),o[d0],0,0,0);
    o[d0]=__builtin_amdgcn_mfma_f32_32x32x16_bf16(pa3,PK(3),o[d0],0,0,0);
    #undef PK
  }
}

#ifndef ATTN_STORE16
#define ATTN_STORE16(p,v) (*(u32x4*)(p)=(v))
#endif
template<int THRL> __device__ __forceinline__ void attn_unit(int b,int hq,int hv,int qb,const bf16*Q,const bf16*__restrict__ K,const bf16*__restrict__ V,bf16*O,char*shm){
  const int tid=threadIdx.x,lane=tid&63,r32=lane&31,hi=lane>>5; const int wid=__builtin_amdgcn_readfirstlane(tid>>6);
  const long rowbase=(long)b*SEQ; const int q0=qb*QB;
  const bf16*Qw=Q+(rowbase+q0+wid*QBLK)*DM+hq*D;
  const bf16*Kh=K+rowbase*DM+hq*D,*Vh=V+rowbase*DM+hv*D;
  const unsigned lds0=(unsigned)(uintptr_t)shm;
  float*wsf=(float*)(shm+LDS_WS)+wid*64;
  const bf16*ksrc=Kh+(long)lane*DM+wid*8;
  const bf16*vsrc=Vh+(long)(16*(wid&3)+(lane>>2))*DM+(wid>>2)*32+(lane&3)*8;
  const unsigned kdst=lds0+LDS_K+wid*1024, vdst=lds0+LDS_V+wid*1024;
  #define DMA_K(t,slot) glds16(ksrc+(long)(t)*KVBLK*DM,(unsigned)__builtin_amdgcn_readfirstlane(kdst+(slot)))
  #define DMA_V(t,slot) do{ glds16(vsrc+(long)(t)*KVBLK*DM,(unsigned)__builtin_amdgcn_readfirstlane(vdst+2*(slot))); glds16(vsrc+64+(long)(t)*KVBLK*DM,(unsigned)__builtin_amdgcn_readfirstlane(vdst+8192+2*(slot))); }while(0)
  const int vb0=(int)(lds0+LDS_V)+((lane>>4)&1)*32+(lane&3)*8+(4*hi+((lane&15)>>2))*64;
  const char*Kbase=shm+LDS_K; bf16x8 kf[8];
  const lds_cptr shm3=(lds_cptr)shm; const lds_cptr kp0=shm3+LDS_K+hi*1024+r32*16; const lds_cptr vp0=shm3+LDS_V+((lane>>4)&1)*32+(lane&3)*8+(4*hi+((lane&15)>>2))*64;
  if(__builtin_amdgcn_readfirstlane(wid)>=4)__builtin_amdgcn_s_setprio(1);
  const int NT=(q0+QB)/KVBLK;
  DMA_K(0,0);DMA_V(0,0);DMA_K(1,SLOTB);
  bf16x8 qr[4];
  #pragma unroll
  for(int d0=0;d0<4;++d0)qr[d0]=*reinterpret_cast<const bf16x8*>(&Qw[(long)r32*DM+d0*16+hi*8]);
  typedef __attribute__((address_space(3))) bf16x8 lds_bf16x8;
  { __attribute__((address_space(3))) char* qst=(__attribute__((address_space(3))) char*)shm+LDS_OST+wid*4096+lane*16;
    #pragma unroll
    for(int d0=0;d0<4;++d0)*(lds_bf16x8*)(qst+d0*1024)=qr[d0]; }
  const lds_cptr qp0=(lds_cptr)shm+LDS_OST+wid*4096+lane*16;
  #define QL(d) (*(const lds_bf16x8*)(qp0+(d)*1024))
  float mhat=0.f,l_reg=0.f;f32x16 o[4];o[0]=f32x16{};o[1]=f32x16{};o[2]=f32x16{};o[3]=f32x16{};f32x16 negm=f32x16{};asm volatile("":"+v"(negm));
  const int qrel=wid*QBLK+r32;
  #define CMASK(P0,P1,t) do{int jb_=(t)-(NT-4); if(jb_>=0)cmask(P0,P1,jb_,qrel,hi);}while(0)
  bool resc=false;
  #define START(P0,P1) do{ const float rm=rowmax(P0,P1); resc=false; \
    { const float dl=rm; mhat=fadd_s(mhat,dl); \
      _Pragma("unroll") for(int r=0;r<16;++r){P0[r]=fsub_s(P0[r],dl);P1[r]=fsub_s(P1[r],dl);} \
      _Pragma("unroll") for(int r=0;r<16;++r)negm[r]=-mhat; asm volatile("":"+v"(negm)); } \
    _Pragma("unroll") for(int r=0;r<16;++r)P0[r]=__builtin_amdgcn_exp2f(P0[r]); }while(0)
  #define RESC() do{ if(resc){ asm volatile("s_waitcnt lgkmcnt(0)":::"memory"); \
      _Pragma("unroll") for(int d_=0;d_<4;++d_) _Pragma("unroll") for(int r=0;r<16;++r)o[d_][r]*=wsf[crow(r,hi)]; } }while(0)
  f32x16 pA0,pA1,pB0,pB1;
  int sl_prev=0,sl_cur=0,sl_next=SLOTB;
  #define ROT() do{sl_prev=sl_cur;sl_cur=sl_next;sl_next=(sl_next==(NSLOT-1)*SLOTB)?0:sl_next+SLOTB;}while(0)
  DMA_K(2,2*SLOTB);
  WAIT_BAR(3);
  qkt(pA0,pA1,Kbase,qr,negm,r32,hi);asm volatile("s_nop 15\n\ts_nop 7":"+v"(pA0),"+v"(pA1));CMASK(pA0,pA1,0);
  START(pA0,pA1);
  _Pragma("unroll") for(int r=0;r<16;++r)pA1[r]=__builtin_amdgcn_exp2f(pA1[r]);
  WAIT_BAR(0);
  DMA_K(3,0);DMA_V(1,SLOTB);
  ROT();
  kload8(kf,kp0+sl_cur);
  WAIT_BAR(3);
  s16x4 fAlo,fAhi,fBlo,fBhi,fClo,fChi; u32x4 pw0,pw1,pw2,pw3;
  #define PKW(P,B) cvtpk_s(P[B],P[B+1])
  #define PAF(k) __builtin_bit_cast(bf16x8,pw##k)
  #define PIN(x) asm volatile("":"+v"(x))
  #define MX3(a,b,c) __builtin_fmaxf(__builtin_fmaxf((a),(b)),(c))
  #define GAPA(MF,A0,A1,A2,A3,W0,W1,PW) do{ MF; sacc+=A0; sacc+=A1; sacc+=A2; sacc+=A3; PIN(sacc); W0; W1; PIN(PW); SBAR(); }while(0)
  #define EX(v) __builtin_amdgcn_exp2f(v)
  #define GAPB(MF,X,B) do{ MF; X[B]=EX(X[B]); X[B+1]=EX(X[B+1]); PIN(X); SBAR(); }while(0)
  #define VRDF(F,n) do{ F##lo=vtr(vp_+(((n)&3)*4096+((n)>>2)*1024)); F##hi=vtr(vp_+(((n)&3)*4096+((n)>>2)*1024+512)); }while(0)
  #define VFRF(F) (bf16x8){F##lo[0],F##lo[1],F##lo[2],F##lo[3],F##hi[0],F##hi[1],F##hi[2],F##hi[3]}
  #define KRD(G,j) do{ if(G){ kload2(kf,kp0+sl_next,j); SBAR(); } }while(0)
  #define STEP(C0,C1,P0,P1,t,GK,GV,GL) do{ SBAR(); \
    const lds_cptr vp_=vp0+2*sl_prev; \
    const bf16x8 q0_=QL(0),q1_=QL(1),q2_=QL(2),q3_=QL(3); SBAR(); float sacc=(P0[0]+P0[1]); \
    GAPA(C0=__builtin_amdgcn_mfma_f32_32x32x16_bf16(kf[0],q0_,negm,0,0,0), P0[2],P0[3],P0[4],P0[5],     pw0[0]=PKW(P0,0), pw0[1]=PKW(P0,2), pw0); \
    GAPA(C1=__builtin_amdgcn_mfma_f32_32x32x16_bf16(kf[1],q0_,negm,0,0,0), P0[6],P0[7],P0[8],P0[9],     pw0[2]=PKW(P0,4), pw0[3]=PKW(P0,6), pw0); \
    GAPA(C0=__builtin_amdgcn_mfma_f32_32x32x16_bf16(kf[2],q1_,C0,0,0,0),   P0[10],P0[11],P0[12],P0[13], pw1[0]=PKW(P0,8), pw1[1]=PKW(P0,10), pw1); \
    GAPA(C1=__builtin_amdgcn_mfma_f32_32x32x16_bf16(kf[3],q1_,C1,0,0,0),   P0[14],P0[15],P1[0],P1[1],   pw1[2]=PKW(P0,12),pw1[3]=PKW(P0,14), pw1); \
    GAPA(C0=__builtin_amdgcn_mfma_f32_32x32x16_bf16(kf[4],q2_,C0,0,0,0),   P1[2],P1[3],P1[4],P1[5],     pw2[0]=PKW(P1,0), pw2[1]=PKW(P1,2), pw2); \
    GAPA(C1=__builtin_amdgcn_mfma_f32_32x32x16_bf16(kf[5],q2_,C1,0,0,0),   P1[6],P1[7],P1[8],P1[9],     pw2[2]=PKW(P1,4), pw2[3]=PKW(P1,6), pw2); \
    VRDF(fA,0); SBAR(); GAPA(C0=__builtin_amdgcn_mfma_f32_32x32x16_bf16(kf[6],q3_,C0,0,0,0),   P1[10],P1[11],P1[12],P1[13], pw3[0]=PKW(P1,8), pw3[1]=PKW(P1,10), pw3); \
    VRDF(fB,1); SBAR(); GAPA(C1=__builtin_amdgcn_mfma_f32_32x32x16_bf16(kf[7],q3_,C1,0,0,0),   P1[14],P1[15],0.f,0.f,       pw3[2]=PKW(P1,12),pw3[3]=PKW(P1,14), pw3); \
    l_reg+=sacc; \
    if(GK){DMA_K((t)+3,sl_cur);} if(GV){DMA_V((t)+1,sl_next);} \
    CMASK(C0,C1,t); \
    { float a=MX3(C0[0],C0[1],C1[0]),b=MX3(C0[2],C0[3],C1[1]); a=MX3(a,C1[2],C1[3]); \
      _Pragma("unroll") for(int r=4;r<16;r+=4){a=MX3(a,C0[r],C0[r+1]);b=MX3(b,C0[r+2],C0[r+3]);a=MX3(a,C1[r],C1[r+1]);b=MX3(b,C1[r+2],C1[r+3]);} \
      float rm=__builtin_fmaxf(a,b); { auto rr=__builtin_amdgcn_permlane32_swap(__float_as_uint(rm),__float_as_uint(rm),false,false); rm=__builtin_fmaxf(__uint_as_float(rr[0]),__uint_as_float(rr[1])); } \
      resc=false; \
      if(__builtin_expect(__any(rm>(float)THRL),0)){ const float dl=__builtin_fmaxf(rm,0.f); mhat+=dl; \
        _Pragma("unroll") for(int r=0;r<16;++r){C0[r]-=dl;C1[r]-=dl;} \
        _Pragma("unroll") for(int r=0;r<16;++r)negm[r]=-mhat; asm volatile("":"+v"(negm)); \
        const float f=__builtin_amdgcn_exp2f(-dl); l_reg*=f; if(hi==0)wsf[r32]=f; resc=true; } } \
    SBAR(); \
    VRDF(fC,2);  SBAR(); GAPB(o[0]=__builtin_amdgcn_mfma_f32_32x32x16_bf16(PAF(0),VFRF(fA),o[0],0,0,0), C0,0); \
    VRDF(fA,3);  SBAR(); GAPB(o[1]=__builtin_amdgcn_mfma_f32_32x32x16_bf16(PAF(0),VFRF(fB),o[1],0,0,0), C0,2); \
    VRDF(fB,4);  SBAR(); GAPB(o[2]=__builtin_amdgcn_mfma_f32_32x32x16_bf16(PAF(0),VFRF(fC),o[2],0,0,0), C0,4); \
    VRDF(fC,5);  SBAR(); GAPB(o[3]=__builtin_amdgcn_mfma_f32_32x32x16_bf16(PAF(0),VFRF(fA),o[3],0,0,0), C0,6); \
    VRDF(fA,6);  SBAR(); KRD(GL,0); GAPB(o[0]=__builtin_amdgcn_mfma_f32_32x32x16_bf16(PAF(1),VFRF(fB),o[0],0,0,0), C0,8); \
    VRDF(fB,7);  SBAR(); KRD(GL,1); GAPB(o[1]=__builtin_amdgcn_mfma_f32_32x32x16_bf16(PAF(1),VFRF(fC),o[1],0,0,0), C0,10); \
    VRDF(fC,8);  SBAR(); KRD(GL,2); GAPB(o[2]=__builtin_amdgcn_mfma_f32_32x32x16_bf16(PAF(1),VFRF(fA),o[2],0,0,0), C0,12); \
    VRDF(fA,9);  SBAR(); KRD(GL,3); GAPB(o[3]=__builtin_amdgcn_mfma_f32_32x32x16_bf16(PAF(1),VFRF(fB),o[3],0,0,0), C0,14); \
    VRDF(fB,10); SBAR(); GAPB(o[0]=__builtin_amdgcn_mfma_f32_32x32x16_bf16(PAF(2),VFRF(fC),o[0],0,0,0), C1,0); \
    VRDF(fC,11); SBAR(); GAPB(o[1]=__builtin_amdgcn_mfma_f32_32x32x16_bf16(PAF(2),VFRF(fA),o[1],0,0,0), C1,2); \
    VRDF(fA,12); SBAR(); GAPB(o[2]=__builtin_amdgcn_mfma_f32_32x32x16_bf16(PAF(2),VFRF(fB),o[2],0,0,0), C1,4); \
    VRDF(fB,13); SBAR(); GAPB(o[3]=__builtin_amdgcn_mfma_f32_32x32x16_bf16(PAF(2),VFRF(fC),o[3],0,0,0), C1,6); \
    VRDF(fC,14); SBAR(); GAPB(o[0]=__builtin_amdgcn_mfma_f32_32x32x16_bf16(PAF(3),VFRF(fA),o[0],0,0,0), C1,8); \
    VRDF(fA,15); SBAR(); GAPB(o[1]=__builtin_amdgcn_mfma_f32_32x32x16_bf16(PAF(3),VFRF(fB),o[1],0,0,0), C1,10); \
    GAPB(o[2]=__builtin_amdgcn_mfma_f32_32x32x16_bf16(PAF(3),VFRF(fC),o[2],0,0,0), C1,12); \
    GAPB(o[3]=__builtin_amdgcn_mfma_f32_32x32x16_bf16(PAF(3),VFRF(fA),o[3],0,0,0), C1,14); \
    }while(0)
  int t=1;
  #undef CMASK
  #define CMASK(P0,P1,t) do{}while(0)
  for(;t+5<NT;t+=2){
    STEP(pB0,pB1,pA0,pA1,t,true,true,true);     WAIT_BAR(3); RESC(); ROT();
    STEP(pA0,pA1,pB0,pB1,t+1,true,true,true);   WAIT_BAR(3); RESC(); ROT();
  }
  #undef CMASK
  #define CMASK(P0,P1,t) do{int jb_=(t)-(NT-4); if(jb_>=0)cmask(P0,P1,jb_,qrel,hi);}while(0)
  #define ENDW(tt) do{ if((tt)+3<NT){WAIT_BAR(3);} else if((tt)+2<NT){WAIT_BAR(2);} else {WAIT_BAR(0);} }while(0)
  for(;t+1<NT;t+=2){
    STEP(pB0,pB1,pA0,pA1,t,(t+3<NT),(t+1<NT),(t+1<NT));       ENDW(t);   RESC(); ROT();
    STEP(pA0,pA1,pB0,pB1,t+1,(t+4<NT),(t+2<NT),(t+2<NT));     ENDW(t+1); RESC(); ROT();
  }
  STEP(pB0,pB1,pA0,pA1,NT-1,false,false,false); RESC();
  { float sacc=pB0[0]+pB0[1]; _Pragma("unroll") for(int r=2;r<16;++r)sacc+=pB0[r]; _Pragma("unroll") for(int r=0;r<16;++r)sacc+=pB1[r]; l_reg+=sacc;
    pw0=(u32x4){PKW(pB0,0),PKW(pB0,2),PKW(pB0,4),PKW(pB0,6)};pw1=(u32x4){PKW(pB0,8),PKW(pB0,10),PKW(pB0,12),PKW(pB0,14)};pw2=(u32x4){PKW(pB1,0),PKW(pB1,2),PKW(pB1,4),PKW(pB1,6)};pw3=(u32x4){PKW(pB1,8),PKW(pB1,10),PKW(pB1,12),PKW(pB1,14)};
    SBAR(); pv(o,vb0+2*sl_cur,PAF(0),PAF(1),PAF(2),PAF(3)); }
  #undef PKW
  #undef PAF
  #undef VFRF
  #undef VRDF
  #undef PIN
  #undef MX3
  #undef GAPA
  #undef GAPB
  #undef EX
  #undef KRD
  #undef STEP
  #undef ENDW
  {auto rr=__builtin_amdgcn_permlane32_swap(__float_as_uint(l_reg),__float_as_uint(l_reg),false,false);l_reg=__uint_as_float(rr[0])+__uint_as_float(rr[1]);}
  if(hi==0)wsf[32+r32]=l_reg;asm volatile("s_waitcnt lgkmcnt(0)":::"memory");
  float rli[16];
  #pragma unroll
  for(int r=0;r<16;++r)rli[r]=__builtin_amdgcn_rcpf(wsf[32+crow(r,hi)]);
  bf16*Ow=O+(rowbase+q0+wid*QBLK)*DM+hv*D;
  { bf16*stg=(bf16*)(shm+LDS_OST)+wid*2048;
    #pragma unroll
    for(int pass=0;pass<2;++pass){
      #pragma unroll
      for(int r=0;r<16;++r){const int orow=crow(r,hi);
        #pragma unroll
        for(int d0=0;d0<2;++d0)stg[orow*64+d0*32+r32]=__float2bfloat16(o[2*pass+d0][r]*rli[r]);}
      asm volatile("s_waitcnt lgkmcnt(0)":::"memory");
      #pragma unroll
      for(int i=0;i<4;++i){const int row=i*8+(lane>>3),ch=lane&7; const u32x4 v=*(const u32x4*)(stg+row*64+ch*8); ATTN_STORE16(Ow+(long)row*DM+pass*64+ch*8,v);}
      asm volatile("s_waitcnt lgkmcnt(0)":::"memory"); } }
  __builtin_amdgcn_s_setprio(0);
  asm volatile("s_waitcnt lgkmcnt(0)\n\ts_barrier":::"memory");
  #undef DMA_K
  #undef DMA_V
  #undef CMASK
  #undef START
  #undef RESC
  #undef ROT
  #undef QL
}
constexpr int ATTN_LDS_BYTES=LDS_BYTES;
struct AttnTensors { const bf16* Q; const bf16* K; const bf16* V; bf16* O; };
struct AttnUnit { int bh; int qb; };
struct StaticOrder {
  int vcu;
  __device__ __forceinline__ explicit StaticOrder(int grid,int block):vcu((block%8)*(grid/8)+block/8){}
  __device__ __forceinline__ bool next(int i,AttnUnit&u)const{ if(i>=4)return false; const int s=vcu&7; u.bh=vcu>>3; u.qb=(i==0)?s:(i==1)?15-s:(i==2)?16+s:31-s; return true; }
  __device__ __forceinline__ void a_ready(const AttnUnit&)const{}
  __device__ __forceinline__ void done(const AttnUnit&)const{}
};
template<class Sched,int THRL=8> __device__ __forceinline__ void attn_phase(char*lds,const AttnTensors&T,const Sched&S){
  AttnUnit u;
  for(int i=0;S.next(i,u);++i){ S.a_ready(u); const int hq=u.bh&15, cm=hq&1; attn_unit<THRL>(u.bh>>4,hq,hq&~1,u.qb,T.Q,T.K,T.V,T.O+(size_t)cm*((size_t)16384*1024),lds); S.done(u); }
}
#undef SBAR
#undef WAIT_BAR
}
constexpr int NWAVES = 8, NTHR = 512;
constexpr int BATCH = 2, T = 8192, D = 1024, M = BATCH * T;
constexpr int EIN = 2816, FFN = 2816, NE = 8, ED = 3584;
constexpr int NPH = 23;
constexpr float MOE_WG_SCALE = 64.f, MOE_WD_SCALE = 128.f, MOE_H_SCALE = 8.f;
constexpr int MOE_GU_E8M0 = 0x79797979, MOE_DN_E8M0 = 0x75757575;
#ifndef LAST_PHASE
#define LAST_PHASE (NPH - 1)
#endif
#ifndef ONE_LAUNCH
#define ONE_LAUNCH 0
#endif

constexpr size_t KiB = 1024, MiB = 1u << 20;
constexpr size_t WS_CTL = 0, CTL_ZERO_BYTES = 192 * KiB;
constexpr size_t WS_WIN = 1 * MiB, WS_WOUT = WS_WIN + 5632 * KiB, WS_WGU = WS_WOUT + 2 * MiB, WS_WDN = WS_WGU + 11 * MiB, WS_WQKV = WS_WDN + 5632 * KiB, WS_WO = WS_WQKV + 6 * MiB;
static_assert(WS_WO + 2 * MiB == 33 * MiB, "weights map");
constexpr size_t WS_B2T = 33 * MiB, WS_BLRU = 34 * MiB;
constexpr size_t WS_XN = 35 * MiB;
constexpr size_t WS_LA = 35 * MiB, WS_LU = 51 * MiB;
constexpr size_t WS_PROJ = 67 * MiB;
constexpr size_t WS_Q = 67 * MiB, WS_K = 99 * MiB, WS_V = 131 * MiB;
constexpr size_t WS_XC = 155 * MiB;
constexpr size_t WS_SINIT = 155 * MiB;
constexpr size_t WS_A2 = 171 * MiB;
constexpr size_t WS_G1 = 179 * MiB;
constexpr size_t WS_G2 = 227 * MiB;
constexpr size_t WS_PL = 259 * MiB, WS_ORAW = 227 * MiB;
constexpr size_t WS_OA0 = 163 * MiB, WS_OA1 = 195 * MiB, WS_AO = 227 * MiB;
constexpr size_t WS_REC4 = 259 * MiB;
constexpr size_t WS_Y = 259 * MiB;
constexpr size_t WS_REC2 = 387 * MiB;
constexpr size_t WS_SMALL = 451 * MiB;
constexpr size_t WS_BS = WS_SMALL, WS_LSA = WS_SMALL + 1 * MiB, WS_LSH = WS_SMALL + 3 * MiB, WS_LC = WS_SMALL + 5 * MiB;
constexpr size_t WS_LIST = WS_SMALL, WS_TOKI = WS_SMALL + 512 * KiB, WS_TOKG = WS_SMALL + 1024 * KiB;
constexpr size_t WS_WGUM = 291 * MiB, WS_WDM = 347 * MiB;
constexpr size_t WS_XNM = 1 * MiB;
constexpr size_t WS_HM2 = 33 * MiB;
constexpr size_t WS_Y2 = 271 * MiB;
constexpr size_t WS_PART = 155 * MiB;
constexpr size_t WS_XR = WS_REC2;
constexpr size_t WS_RS1 = 65536, WS_RS2 = 131072;
constexpr size_t WS_END = 458 * MiB;
static_assert(WS_HM2 + (size_t)34816 * 3584 * 2 <= WS_WGUM && WS_WDM + (size_t)8 * 1024 * 3584 * 2 <= WS_SMALL && WS_Y2 + (size_t)34816 * 1024 * 2 <= WS_WDM, "MoE map");
constexpr int CW_BAR = 4096, CW_CNT = 8192, CW_SPL = 12288;
constexpr int RING_BYTES = 131072, MISC_OFF = RING_BYTES + 320, LDS_BYTES = 147456;

#define XB_TMO      128
#define XB_XCNT(j)  (256  + 64 * (j))
#define XB_XSUB(j)  (1280 + 64 * (j))
#define XB_XGEN(j)  (2304 + 64 * (j))
#define XB_TOP      3328
#define XB_TOPGEN   3392
#define XCD_BAR_WORDS 3456
#define XB_SPIN_CAP (1u << 18)
__device__ __forceinline__ unsigned xb_ld(unsigned* p)              { return __hip_atomic_load(p, __ATOMIC_RELAXED, __HIP_MEMORY_SCOPE_AGENT); }
__device__ __forceinline__ unsigned xb_add(unsigned* p, unsigned v) { return __hip_atomic_fetch_add(p, v, __ATOMIC_RELAXED, __HIP_MEMORY_SCOPE_AGENT); }
__device__ __forceinline__ unsigned xb_xcc_id() { return (unsigned)__builtin_amdgcn_s_getreg((3 << 11) | 20) & 0xFu; }
#define XB_SPIN(cond, bar) do { unsigned _sp = 0; while (cond) { __builtin_amdgcn_s_sleep(1); \
    if ((++_sp & 255u) == 0u) { if (xb_ld(&(bar)[XB_TMO])) break; if (_sp > XB_SPIN_CAP) { atomicAdd(&(bar)[XB_TMO], 1u); break; } } } } while (0)
struct XcdBarrier { unsigned* bar; unsigned x; volatile LAS unsigned* st; };
__device__ __forceinline__ XcdBarrier xcd_barrier_post(unsigned* bar, volatile LAS unsigned* st) {
    XcdBarrier b; b.bar = bar; b.x = xb_xcc_id(); b.st = st;
    if (threadIdx.x == 0) (void)xb_add(&bar[XB_XCNT(b.x)], 1u);
    return b;
}
__device__ __forceinline__ void xcd_barrier_complete(unsigned* bar, unsigned x, unsigned& nloc, unsigned& nx) {
    const unsigned G = gridDim.x * gridDim.y * gridDim.z;
    unsigned sum, cnt, mine, sp = 0u;
    for (;;) {
        sum = 0u; cnt = 0u; mine = 0u;
#pragma unroll
        for (unsigned j = 0; j < 16; ++j) { const unsigned c = xb_ld(&bar[XB_XCNT(j)]); sum += c; cnt += (c > 0u) ? 1u : 0u; mine = (j == x) ? c : mine; }
        if (sum == G) break;
        __builtin_amdgcn_s_sleep(1);
        if ((++sp & 255u) == 0u) { if (xb_ld(&bar[XB_TMO])) break; if (sp > XB_SPIN_CAP) { atomicAdd(&bar[XB_TMO], 1u); break; } }
    }
    nloc = mine > 0u ? mine : 1u; nx = cnt > 0u ? cnt : 1u;
}
__device__ __forceinline__ void xcd_barrier(const XcdBarrier& b) {
    asm volatile("s_waitcnt vmcnt(0)" ::: "memory");
    __syncthreads();
    if (threadIdx.x == 0) {
        unsigned* bar = b.bar;
        __builtin_amdgcn_s_waitcnt(0);
        unsigned nloc = b.st[0], nx = b.st[1];
        if (nloc == 0u) { xcd_barrier_complete(bar, b.x, nloc, nx); b.st[0] = nloc; b.st[1] = nx; }
        const unsigned old = xb_add(&bar[XB_XSUB(b.x)], 1u);
        const unsigned gen = old / nloc;
        if (old + 1u == (gen + 1u) * nloc) {
            __builtin_amdgcn_fence(__ATOMIC_RELEASE, "agent");
            asm volatile("s_waitcnt vmcnt(0)" ::: "memory");
            const unsigned og = xb_add(&bar[XB_TOP], 1u);
            const unsigned tg = og / nx;
            if (og + 1u == (tg + 1u) * nx) xb_add(&bar[XB_TOPGEN], 1u);
            else XB_SPIN(xb_ld(&bar[XB_TOPGEN]) == tg, bar);
            __builtin_amdgcn_fence(__ATOMIC_ACQUIRE, "agent");
            xb_add(&bar[XB_XGEN(b.x)], 1u);
            asm volatile("s_waitcnt vmcnt(0)" ::: "memory");
        } else {
            XB_SPIN(xb_ld(&bar[XB_XGEN(b.x)]) == gen, bar);
            __builtin_amdgcn_fence(__ATOMIC_ACQUIRE, "agent");
            asm volatile("s_waitcnt vmcnt(0)" ::: "memory");
        }
    }
    __syncthreads();
}

#ifndef FLAT_BAR
#define FLAT_BAR 0
#endif
constexpr int CW_SLOT = 14336;
__device__ __forceinline__ void flat_barrier(unsigned* slots, unsigned gen) {
    asm volatile("s_waitcnt vmcnt(0)" ::: "memory");
    __syncthreads();
    if (threadIdx.x < 64) {
        const unsigned G = gridDim.x, lane = threadIdx.x;
        if (lane == 0) { __builtin_amdgcn_fence(__ATOMIC_RELEASE, "agent"); __hip_atomic_store(&slots[blockIdx.x], gen, __ATOMIC_RELAXED, __HIP_MEMORY_SCOPE_AGENT); }
        unsigned sp = 0u;
        for (;;) {
            bool ok = true;
            for (unsigned i = lane; i < G; i += 64u) ok = ok && (__hip_atomic_load(&slots[i], __ATOMIC_RELAXED, __HIP_MEMORY_SCOPE_AGENT) >= gen);
            if (__all(ok)) break;
            __builtin_amdgcn_s_sleep(1);
            if (++sp > XB_SPIN_CAP) break;
        }
        __builtin_amdgcn_fence(__ATOMIC_ACQUIRE, "agent");
    }
    __syncthreads();
}
#define XB_XSLOT 3520
__device__ __forceinline__ void xcd_barrier2(const XcdBarrier& b) {
    asm volatile("s_waitcnt vmcnt(0)" ::: "memory");
    __syncthreads();
    if (threadIdx.x < 64) {
        unsigned* bar = b.bar; const unsigned lane = threadIdx.x;
        unsigned gen = 0u;
        if (lane == 0) {
            __builtin_amdgcn_s_waitcnt(0);
            unsigned nloc = b.st[0], nx = b.st[1];
            if (nloc == 0u) { xcd_barrier_complete(bar, b.x, nloc, nx); b.st[0] = nloc; b.st[1] = nx;
                unsigned mask = 0u;
#pragma unroll
                for (unsigned j = 0; j < 16; ++j) mask |= (xb_ld(&bar[XB_XCNT(j)]) > 0u) ? (1u << j) : 0u;
                b.st[2] = mask; }
            const unsigned old = xb_add(&bar[XB_XSUB(b.x)], 1u);
            const unsigned g0 = old / nloc; gen = g0 + 1u;
            if (old + 1u == gen * nloc) {
                __builtin_amdgcn_fence(__ATOMIC_RELEASE, "agent");
                asm volatile("s_waitcnt vmcnt(0)" ::: "memory");
                __hip_atomic_store(&bar[XB_XSLOT + b.x], gen, __ATOMIC_RELAXED, __HIP_MEMORY_SCOPE_AGENT);
            }
        }
        gen = __builtin_amdgcn_readfirstlane(gen);
        asm volatile("s_waitcnt lgkmcnt(0)" ::: "memory");
        const unsigned mask = b.st[2];
        const bool need = lane < 16u && ((mask >> lane) & 1u);
        unsigned sp = 0u;
        for (;;) {
            const bool ok = !need || xb_ld(&bar[XB_XSLOT + (lane & 15u)]) >= gen;
            if (__all(ok)) break;
            __builtin_amdgcn_s_sleep(1);
            if (++sp > XB_SPIN_CAP) break;
        }
        __builtin_amdgcn_fence(__ATOMIC_ACQUIRE, "agent");
    }
    __syncthreads();
}
#if FLAT_BAR == 2
#define GRID_BARRIER(b) xcd_barrier2(b)
#elif FLAT_BAR
#define GRID_BARRIER(b) flat_barrier(ctl + CW_SLOT, ++bar_gen)
#else
#define GRID_BARRIER(b) xcd_barrier(b)
#endif

#ifndef P21_SPLIT_EN
#define P21_SPLIT_EN 1
#endif
#define P21_CNT_OFF 0
#define P21_TAIL_EN 1
#ifndef PROBE_BUILD
#define PROBE_BUILD 0
#endif
#ifndef REPMASK
#define REPMASK 0u
#endif
#if PROBE_BUILD
struct Args { const void* in[42]; float* out; unsigned char* ws; int ph_lo, ph_hi; unsigned repmask; unsigned pad; };
#else
struct Args { const void* in[42]; float* out; unsigned char* ws; int ph_lo, ph_hi; };
#endif
struct Ctx { LAS unsigned char* lds; unsigned char* ws; int tid, lane, wave, G, bx, vcu, gw, ngw; };
#define INF(k) ((const float*)a.in[k])
enum { I_X = 0, I_POS, I_ELNMIX, I_EWIN, I_CONVW, I_CONVB, I_GAW, I_GAB, I_GXW, I_GXB, I_LAM, I_MU, I_W0, I_W2, I_A0, I_A2, I_G2, I_KK, I_KA, I_RK, I_GNW, I_GNB, I_EWOUT, I_ELNFFN,
       I_FFG, I_FFU, I_FFD, I_OLNMIX, I_WQKV, I_QNORM, I_KNORM, I_LQ1, I_LK1, I_LQ2, I_LK2, I_SUBLN, I_WO, I_OLNFFN, I_ROUTER, I_MOEG, I_MOEU, I_MOED };

__device__ __forceinline__ void transpose_item(const float* __restrict__ W, int K, int N, bf16* __restrict__ WT, int mode, LAS float* scr, int item, int lane, const float* __restrict__ ks = nullptr) {
    const int nblk = N / 32, kb = item / nblk, nb = item % nblk, k0 = 64 * kb, n0 = 32 * nb;
#pragma unroll 8
    for (int i = 0; i < 32; ++i) { const int kk = 2 * i + (lane >> 5); scr[kk * 33 + (lane & 31)] = W[(size_t)(k0 + kk) * N + n0 + (lane & 31)] * (ks ? ks[k0 + kk] : 1.0f); }
    asm volatile("s_waitcnt lgkmcnt(0)" ::: "memory");
    const int rb = mode == 0 ? n0 : (256 * (n0 >> 7) + 2 * (n0 & 127) + (mode == 2 ? 32 : 0));
    const int c = lane & 7;
#pragma unroll
    for (int j = 0; j < 4; ++j) { const int n = (lane >> 3) + 8 * j; const LAS float* s = scr + (8 * c) * 33 + n;
        u32x4 o; o.x = cvt_pk_bf16(s[0 * 33], s[1 * 33]); o.y = cvt_pk_bf16(s[2 * 33], s[3 * 33]); o.z = cvt_pk_bf16(s[4 * 33], s[5 * 33]); o.w = cvt_pk_bf16(s[6 * 33], s[7 * 33]);
        *(u32x4*)(WT + (size_t)(rb + n) * K + k0 + 8 * c) = o; }
    asm volatile("s_waitcnt lgkmcnt(0)" ::: "memory");
}
__device__ __forceinline__ void transpose_item8(const float* __restrict__ W, int K, int N, unsigned char* __restrict__ WT, int mode, float wscale, LAS float* scr, int item, int lane) {
    const int nblk = N / 32, kb = item / nblk, nb = item % nblk, k0 = 64 * kb, n0 = 32 * nb;
#pragma unroll 8
    for (int i = 0; i < 32; ++i) { const int kk = 2 * i + (lane >> 5); scr[kk * 33 + (lane & 31)] = W[(size_t)(k0 + kk) * N + n0 + (lane & 31)] * wscale; }
    asm volatile("s_waitcnt lgkmcnt(0)" ::: "memory");
    const int rb = mode == 0 ? n0 : (256 * (n0 >> 7) + 2 * (n0 & 127) + (mode == 2 ? 32 : 0));
    const int c = lane & 7;
#pragma unroll
    for (int j = 0; j < 4; ++j) { const int n = (lane >> 3) + 8 * j; const LAS float* s = scr + (8 * c) * 33 + n;
        u32x2 o; o.x = pg8::pk4_fp8(s[0 * 33], s[1 * 33], s[2 * 33], s[3 * 33]); o.y = pg8::pk4_fp8(s[4 * 33], s[5 * 33], s[6 * 33], s[7 * 33]);
        *(u32x2*)(WT + (size_t)(rb + n) * K + k0 + 8 * c) = o; }
    asm volatile("s_waitcnt lgkmcnt(0)" ::: "memory");
}
__device__ __forceinline__ f32x4 ld_x4(const float* row, int idx) { return ((const f32x4*)row)[idx]; }
__device__ __forceinline__ f32x4 ld_x4(const bf16* row, int idx) { const u32x2 w = ((const u32x2*)row)[idx]; return (f32x4){bflo(w.x), bfhi(w.x), bflo(w.y), bfhi(w.y)}; }
template <class XT> __device__ __forceinline__ void rms_row_bf16(const XT* __restrict__ xrow, const float* __restrict__ g, bf16* __restrict__ orow, int lane) {
    f32x4 v[4]; float s = 0.f;
#pragma unroll
    for (int j = 0; j < 4; ++j) { v[j] = ld_x4(xrow, lane + 64 * j); s += (v[j].x * v[j].x + v[j].y * v[j].y) + (v[j].z * v[j].z + v[j].w * v[j].w); }
    const float r = rsqrtf(wave_sum(s) * (1.0f / 1024.0f) + 1e-6f);
#pragma unroll
    for (int j = 0; j < 4; ++j) { const f32x4 gv = ((const f32x4*)g)[lane + 64 * j]; const f32x4 o = v[j] * r * gv;
        u32x2 w; w.x = cvt_pk_bf16(o.x, o.y); w.y = cvt_pk_bf16(o.z, o.w); ((u32x2*)orow)[lane + 64 * j] = w; }
}
__device__ __forceinline__ void rowstat_phase(const Ctx& c, const bf16* x, float* RS) {
    for (int m = c.gw; m < M; m += c.ngw) { float s = 0.f;
#pragma unroll
        for (int j = 0; j < 2; ++j) { float f[8]; unpack8(((const u32x4*)(x + (size_t)m * D))[c.lane + 64 * j], f);
#pragma unroll
            for (int e = 0; e < 8; ++e) s += f[e] * f[e]; }
        s = wave_sum(s);
        if (c.lane == 0) RS[m] = rsqrtf(s * (1.0f / 1024.0f) + 1e-6f); }
}
template <class XT> __device__ __forceinline__ void rms_rows_phase(const Ctx& c, const XT* x, const float* g, bf16* out) {
    for (int m = c.gw; m < M; m += c.ngw) rms_row_bf16(x + (size_t)m * D, g, out + (size_t)m * D, c.lane);
}
__device__ __forceinline__ void moe_convert(const Ctx& c, const Args& a, int which, int e_lo = 0, int e_hi = NE, int gw = -1, int ngw = 0) {
    if (gw < 0) { gw = c.gw; ngw = c.ngw; }
    LAS float* scr = (LAS float*)(c.lds + c.wave * 16384);
    unsigned char* WG = (unsigned char*)(c.ws + WS_WGUM); unsigned char* WD = (unsigned char*)(c.ws + WS_WDM);
    if (which < 2) { constexpr int IPE = (D / 64) * (ED / 32);
        const float* W = INF(which == 0 ? I_MOEG : I_MOEU);
        for (int it = e_lo * IPE + gw; it < e_hi * IPE; it += ngw) { const int e = it / IPE, r = it % IPE;
            transpose_item8(W + (size_t)e * D * ED, D, ED, WG + (size_t)e * 2 * ED * D, 1 + which, MOE_WG_SCALE, scr, r, c.lane); }
    } else { constexpr int IPE = (ED / 64) * (D / 32);
        const float* W = INF(I_MOED);
        for (int it = e_lo * IPE + gw; it < e_hi * IPE; it += ngw) { const int e = it / IPE, r = it % IPE;
            transpose_item8(W + (size_t)e * ED * D, ED, D, WD + (size_t)e * D * ED, 0, MOE_WD_SCALE, scr, r, c.lane); }
    }
}
constexpr int P6_BUSY = 96, P6_MOE_E = 5, P6_MOE_U = 0, P11_MOE_U = 4, P17_MOE_D = 4;
__device__ __forceinline__ void convert_rest(const Ctx& c, const Args& a, int gw, int ngw) {
    LAS float* scr = (LAS float*)(c.lds + c.wave * 16384);
    constexpr int I_SQ = (D / 64) * (D / 32), I_FF = (D / 64) * (FFN / 32), I_DN = (FFN / 64) * (D / 32), I_QKV = (D / 64) * (3072 / 32);
    constexpr int NITEMS = I_SQ + 2 * I_FF + I_DN + I_QKV + I_SQ;
    for (int it = gw; it < NITEMS; it += ngw) {
        int r = it;
        if (r < I_SQ) { transpose_item(INF(I_EWOUT), D, D, (bf16*)(c.ws + WS_WOUT), 0, scr, r, c.lane); continue; } r -= I_SQ;
        if (r < I_FF) { transpose_item(INF(I_FFG), D, FFN, (bf16*)(c.ws + WS_WGU), 1, scr, r, c.lane, INF(I_ELNFFN)); continue; } r -= I_FF;
        if (r < I_FF) { transpose_item(INF(I_FFU), D, FFN, (bf16*)(c.ws + WS_WGU), 2, scr, r, c.lane, INF(I_ELNFFN)); continue; } r -= I_FF;
        if (r < I_DN) { transpose_item(INF(I_FFD), FFN, D, (bf16*)(c.ws + WS_WDN), 0, scr, r, c.lane); continue; } r -= I_DN;
        if (r < I_QKV) { transpose_item(INF(I_WQKV), D, 3072, (bf16*)(c.ws + WS_WQKV), 0, scr, r, c.lane, INF(I_OLNMIX)); continue; } r -= I_QKV;
        transpose_item(INF(I_WO), D, D, (bf16*)(c.ws + WS_WO), 0, scr, r, c.lane);
    }
}
__device__ __forceinline__ void phase0(const Ctx& c, const Args& a) {
    LAS float* scr = (LAS float*)(c.lds + c.wave * 16384);
    constexpr int I_IN = (D / 64) * (EIN / 32);
    for (int it = c.gw; it < I_IN; it += c.ngw) transpose_item(INF(I_EWIN), D, EIN, (bf16*)(c.ws + WS_WIN), 0, scr, it, c.lane);
    if (c.G <= P6_BUSY) convert_rest(c, a, c.gw, c.ngw);
    { const float* w2 = INF(I_W2); const float* a2 = INF(I_A2); const float* g2 = INF(I_G2); const float* wa = INF(I_GAW); const float* wx = INF(I_GXW);
      bf16* B2 = (bf16*)(c.ws + WS_B2T); bf16* BL = (bf16*)(c.ws + WS_BLRU);
      constexpr int N1 = 1536 * 32, N2 = 1024 * 64;
      for (int id = c.bx * NTHR + c.tid; id < N1 + N2; id += c.G * NTHR) {
          float f[8];
          if (id < N1) { const int n = id >> 5, k0 = (id & 31) * 8;
#pragma unroll
              for (int e = 0; e < 8; ++e) { const int k = k0 + e; float v = 0.f;
                  if (n < 512) { if (k < 64) v = w2[k * 512 + n]; }
                  else if (n < 1024) { if (k >= 64 && k < 128) v = a2[(k - 64) * 512 + (n - 512)]; }
                  else { if (k >= 128) v = g2[(k - 128) * 512 + (n - 1024)]; }
                  f[e] = v; }
              *(u32x4*)(B2 + (size_t)n * 256 + k0) = pack8(f);
          } else { const int id2 = id - N1, n = id2 >> 6, k0 = (id2 & 63) * 8; const int nn = n & 511, hd = nn >> 6, j = nn & 63; const float* w = n < 512 ? wa : wx;
#pragma unroll
              for (int e = 0; e < 8; ++e) { const int k = k0 + e; f[e] = ((k >> 6) == hd) ? w[(hd * 64 + (k & 63)) * 64 + j] : 0.f; }
              *(u32x4*)(BL + (size_t)n * 512 + k0) = pack8(f);
          }
      } }
    rms_rows_phase(c, INF(I_X), INF(I_ELNMIX), (bf16*)(c.ws + WS_XN));
}

__device__ __forceinline__ void phase2(const Ctx& c, const Args& a) {
    const bf16* P = (const bf16*)(c.ws + WS_PROJ); bf16* XC = (bf16*)(c.ws + WS_XC); bf16* A2 = (bf16*)(c.ws + WS_A2);
    const int c0 = 8 * c.lane;
    float cw[4][8], cb[8], mu[8];
#pragma unroll
    for (int j = 0; j < 4; ++j)
#pragma unroll
        for (int e = 0; e < 8; ++e) cw[j][e] = INF(I_CONVW)[j * 512 + c0 + e];
#pragma unroll
    for (int e = 0; e < 8; ++e) { cb[e] = INF(I_CONVB)[c0 + e]; mu[e] = INF(I_MU)[1536 + ((8 * c.lane) & 255) + e]; }
    for (int m = c.gw; m < M; m += c.ngw) {
        const int t = m & (T - 1);
        float acc[8];
#pragma unroll
        for (int e = 0; e < 8; ++e) acc[e] = cb[e];
#pragma unroll
        for (int j = 0; j < 4; ++j) { if (t - 3 + j >= 0) { float x[8]; unpack8(*(const u32x4*)(P + (size_t)(m - 3 + j) * EIN + c0), x);
#pragma unroll
                for (int e = 0; e < 8; ++e) acc[e] += cw[j][e] * x[e]; } }
        *(u32x4*)(XC + (size_t)m * 512 + c0) = pack8(acc);
        if (c.lane < 32) { const int col = 1024 + 1536 + 8 * c.lane; float p[8], pp[8], o[8];
            unpack8(*(const u32x4*)(P + (size_t)m * EIN + col), p);
            if (t > 0) unpack8(*(const u32x4*)(P + (size_t)(m - 1) * EIN + col), pp); else {
#pragma unroll
                for (int e = 0; e < 8; ++e) pp[e] = 0.f; }
#pragma unroll
            for (int e = 0; e < 8; ++e) { const float s = p[e] + (pp[e] - p[e]) * mu[e]; o[e] = c.lane < 8 ? tanhf_(s) : (c.lane < 16 ? s : sigmoidf_(s)); }
            *(u32x4*)(A2 + (size_t)m * 256 + 8 * c.lane) = pack8(o); }
    }
}

template <int MODE> __device__ __forceinline__ void phase4(const Ctx& c, const Args& a) {
    const bf16* __restrict__ P = (const bf16*)(c.ws + WS_PROJ); const bf16* __restrict__ G1 = (const bf16*)(c.ws + WS_G1);
    float* __restrict__ R4 = (float*)(c.ws + WS_REC4); float* __restrict__ R2 = (float*)(c.ws + WS_REC2); float* __restrict__ BS = (float*)(c.ws + WS_BS);
    if (MODE != 2) {
        const int hd = c.lane >> 3, c8 = c.lane & 7, ch = 64 * hd + 4 * c8;
        float mur[8], muk[8], muv[8], w0[8], a0[8], kkw[8], kaw[8], rkw[8];
#pragma unroll
        for (int e = 0; e < 8; ++e) { const int cc = ch + (e & 3) + 32 * (e >> 2); mur[e] = INF(I_MU)[cc]; muk[e] = INF(I_MU)[512 + cc]; muv[e] = INF(I_MU)[1024 + cc]; w0[e] = INF(I_W0)[cc]; a0[e] = INF(I_A0)[cc];
            kkw[e] = INF(I_KK)[cc]; kaw[e] = INF(I_KA)[cc]; rkw[e] = INF(I_RK)[cc]; }
        for (int m0 = c.gw; m0 < M; m0 += 2 * c.ngw) {
            u32x2 lr[2][2], lk[2][2], lv[2][2], lrp[2][2], lkp[2][2], lvp[2][2], lw[2][2], la[2][2];
#pragma unroll
            for (int u = 0; u < 2; ++u) { const int m = m0 + u * c.ngw; const int t = m & (T - 1); const bf16* pr = P + (size_t)m * EIN + 1024 + ch; const bf16* g1 = G1 + (size_t)m * 1536 + ch;
#pragma unroll
                for (int h2 = 0; h2 < 2; ++h2) { lr[u][h2] = *(const u32x2*)(pr + 32 * h2); lk[u][h2] = *(const u32x2*)(pr + 512 + 32 * h2); lv[u][h2] = *(const u32x2*)(pr + 1024 + 32 * h2);
                    lw[u][h2] = *(const u32x2*)(g1 + 32 * h2); la[u][h2] = *(const u32x2*)(g1 + 512 + 32 * h2);
                    if (t > 0) { lrp[u][h2] = *(const u32x2*)(pr - EIN + 32 * h2); lkp[u][h2] = *(const u32x2*)(pr - EIN + 512 + 32 * h2); lvp[u][h2] = *(const u32x2*)(pr - EIN + 1024 + 32 * h2); }
                    else { lrp[u][h2] = (u32x2){0u, 0u}; lkp[u][h2] = (u32x2){0u, 0u}; lvp[u][h2] = (u32x2){0u, 0u}; } } }
#pragma unroll
            for (int u = 0; u < 2; ++u) { const int m = m0 + u * c.ngw; const int t = m & (T - 1), b = m >> 13;
                float r[8], k[8], v[8], dec[8], kk[8], bb[8], k2[8]; float n2 = 0.f, bon = 0.f;
#pragma unroll
                for (int e = 0; e < 8; ++e) { const int h2 = e >> 2, p = (e >> 1) & 1, od = e & 1;
#define UNP_(L) (od ? bfhi(p ? L[u][h2].y : L[u][h2].x) : bflo(p ? L[u][h2].y : L[u][h2].x))
                    const float r0 = UNP_(lr), k0 = UNP_(lk), v0 = UNP_(lv), rp = UNP_(lrp), kp = UNP_(lkp), vp = UNP_(lvp), wpre = UNP_(lw), apre = UNP_(la);
#undef UNP_
                    r[e] = r0 + (rp - r0) * mur[e]; k[e] = k0 + (kp - k0) * muk[e]; v[e] = v0 + (vp - v0) * muv[e];
                    const float z = w0[e] + wpre;
                    const float wlog = -__logf(1.0f + __expf(-z)) - 0.5f;
                    dec[e] = __expf(-__expf(wlog));
                    const float av = sigmoidf_(a0[e] + apre);
                    kk[e] = k[e] * kkw[e]; n2 += kk[e] * kk[e];
                    k2[e] = k[e] * (1.0f + (av - 1.0f) * kaw[e]);
                    bb[e] = av;
                    bon += r[e] * k2[e] * rkw[e];
                }
                n2 += __shfl_xor(n2, 1); n2 += __shfl_xor(n2, 2); n2 += __shfl_xor(n2, 4);
                bon += __shfl_xor(bon, 1); bon += __shfl_xor(bon, 2); bon += __shfl_xor(bon, 4);
                const float inv = 1.0f / fmaxf(sqrtf(n2), 1e-12f);
#pragma unroll
                for (int e = 0; e < 8; ++e) { kk[e] *= inv; bb[e] *= kk[e]; }
                const size_t rec = ((size_t)(b * 8 + hd) * T + t);
                float* q4 = R4 + rec * 256 + 4 * c8; float* q2 = R2 + rec * 128 + 4 * c8;
                *(f32x4*)(q4) = (f32x4){dec[0], dec[1], dec[2], dec[3]}; *(f32x4*)(q4 + 32) = (f32x4){dec[4], dec[5], dec[6], dec[7]};
                *(f32x4*)(q4 + 64) = (f32x4){kk[0], kk[1], kk[2], kk[3]}; *(f32x4*)(q4 + 96) = (f32x4){kk[4], kk[5], kk[6], kk[7]};
                *(f32x4*)(q4 + 128) = (f32x4){bb[0], bb[1], bb[2], bb[3]}; *(f32x4*)(q4 + 160) = (f32x4){bb[4], bb[5], bb[6], bb[7]};
                *(f32x4*)(q4 + 192) = (f32x4){k2[0], k2[1], k2[2], k2[3]}; *(f32x4*)(q4 + 224) = (f32x4){k2[4], k2[5], k2[6], k2[7]};
                *(f32x4*)(q2) = (f32x4){r[0], r[1], r[2], r[3]}; *(f32x4*)(q2 + 32) = (f32x4){r[4], r[5], r[6], r[7]};
                *(f32x4*)(q2 + 64) = (f32x4){v[0], v[1], v[2], v[3]}; *(f32x4*)(q2 + 96) = (f32x4){v[4], v[5], v[6], v[7]};
                if (c8 == 0) BS[(size_t)m * 8 + hd] = bon;
            }
        }
    }
    if (MODE != 1) {
        const bf16* __restrict__ G2 = (const bf16*)(c.ws + WS_G2); const bf16* __restrict__ XC = (const bf16*)(c.ws + WS_XC);
        bf16* __restrict__ HL = (bf16*)(c.ws + WS_LA); bf16* __restrict__ CP = (bf16*)(c.ws + WS_LU); float* __restrict__ LSA = (float*)(c.ws + WS_LSA); float* __restrict__ LSH = (float*)(c.ws + WS_LSH);
        for (int item = c.gw; item < M / 8; item += c.ngw) {
            const int tile = item >> 1, ch = 256 * (item & 1) + 4 * c.lane;
            float ba[4], bxb[4], sp[4];
#pragma unroll
            for (int e = 0; e < 4; ++e) { ba[e] = INF(I_GAB)[ch + e]; bxb[e] = INF(I_GXB)[ch + e]; sp[e] = log1pf(__expf(-INF(I_LAM)[ch + e])); }
            float h[4], sl[4];
#pragma unroll
            for (int e = 0; e < 4; ++e) { h[e] = 0.f; sl[e] = 0.f; }
#pragma unroll 4
            for (int tt = 0; tt < 16; ++tt) { const size_t m = (size_t)tile * 16 + tt;
                const u32x2 gaq = *(const u32x2*)(G2 + m * 1024 + ch), gxq = *(const u32x2*)(G2 + m * 1024 + 512 + ch), xcq = *(const u32x2*)(XC + m * 512 + ch);
                const float ga[4] = {bflo(gaq.x), bfhi(gaq.x), bflo(gaq.y), bfhi(gaq.y)}, gx[4] = {bflo(gxq.x), bfhi(gxq.x), bflo(gxq.y), bfhi(gxq.y)}, xc[4] = {bflo(xcq.x), bfhi(xcq.x), bflo(xcq.y), bfhi(xcq.y)};
                float ho[4], co[4];
#pragma unroll
                for (int e = 0; e < 4; ++e) {
                    const float la = -8.0f * sigmoidf_(ga[e] + ba[e]) * sp[e];
                    const float x2 = 2.0f * la;
                    const float em = x2 < -0.5f ? 1.0f - __expf(x2) : -x2 * (1.0f + x2 * (0.5f + x2 * (0.16666667f + x2 * (0.041666668f + x2 * (0.0083333338f + x2 * 0.0013888889f)))));
                    const float u = sqrtf(fmaxf(em, 0.f)) * sigmoidf_(gx[e] + bxb[e]) * xc[e];
                    h[e] = __expf(la) * h[e] + u; sl[e] += la; ho[e] = h[e]; co[e] = __expf(sl[e]); }
                *(u32x2*)(HL + m * 512 + ch) = (u32x2){cvt_pk_bf16(ho[0], ho[1]), cvt_pk_bf16(ho[2], ho[3])}; *(u32x2*)(CP + m * 512 + ch) = (u32x2){cvt_pk_bf16(co[0], co[1]), cvt_pk_bf16(co[2], co[3])}; }
            *(f32x4*)(LSA + (size_t)tile * 512 + ch) = (f32x4){sl[0], sl[1], sl[2], sl[3]};
            *(f32x4*)(LSH + (size_t)tile * 512 + ch) = (f32x4){h[0], h[1], h[2], h[3]};
        }
    }
}

__device__ __forceinline__ float quad_sum(float v) {
    v += __builtin_bit_cast(float, __builtin_amdgcn_update_dpp(0, __builtin_bit_cast(int, v), 0xB1, 0xF, 0xF, true));
    v += __builtin_bit_cast(float, __builtin_amdgcn_update_dpp(0, __builtin_bit_cast(int, v), 0x4E, 0xF, 0xF, true));
    return v;
}
constexpr int SC_STEPS = 8, SC_TASK_BYTES = SC_STEPS * 1536, SC_BUF_BYTES = 4 * SC_TASK_BYTES;
__device__ __forceinline__ void scan_issue(const Ctx& c, int task0, int s) {
    const float* R4 = (const float*)(c.ws + WS_REC4); const float* R2 = (const float*)(c.ws + WS_REC2);
#pragma unroll
    for (int i = 0; i < 6; ++i) { const int id = c.wave * 6 + i, tk = id / 12, rem = id % 12; const int task = task0 + tk, bh = task >> 6, t0 = (task & 63) * 128 + s * SC_STEPS;
        const unsigned dst = (unsigned)((s & 1) * SC_BUF_BYTES + tk * SC_TASK_BYTES);
        if (rem < 8) __builtin_amdgcn_global_load_lds((const unsigned*)(R4 + ((size_t)bh * T + t0 + rem) * 256 + c.lane * 4), (LAS unsigned*)(c.lds + dst + rem * 1024), 16, 0, 0);
        else __builtin_amdgcn_global_load_lds((const unsigned*)(R2 + ((size_t)bh * T + t0 + 2 * (rem - 8)) * 128 + c.lane * 4), (LAS unsigned*)(c.lds + dst + 8192 + (rem - 8) * 1024), 16, 0, 0); }
}
#define LDS4(p) (*(const LAS f32x4*)(p))
__device__ __forceinline__ float oct_sum(float v) {
    v += __builtin_bit_cast(float, __builtin_amdgcn_update_dpp(0, __builtin_bit_cast(int, v), 0xB1, 0xF, 0xF, true));
    v += __builtin_bit_cast(float, __builtin_amdgcn_update_dpp(0, __builtin_bit_cast(int, v), 0x4E, 0xF, 0xF, true));
    v += __builtin_bit_cast(float, __builtin_amdgcn_update_dpp(0, __builtin_bit_cast(int, v), 0x141, 0xF, 0xF, true));
    return v;
}
__device__ __forceinline__ void oct_sum8(float (&x)[8]) {
#define OS8_STEP(ctrl) \
    "v_add_f32_dpp %0, %0, %0 " ctrl " row_mask:0xf bank_mask:0xf\n\tv_add_f32_dpp %1, %1, %1 " ctrl " row_mask:0xf bank_mask:0xf\n\t" \
    "v_add_f32_dpp %2, %2, %2 " ctrl " row_mask:0xf bank_mask:0xf\n\tv_add_f32_dpp %3, %3, %3 " ctrl " row_mask:0xf bank_mask:0xf\n\t" \
    "v_add_f32_dpp %4, %4, %4 " ctrl " row_mask:0xf bank_mask:0xf\n\tv_add_f32_dpp %5, %5, %5 " ctrl " row_mask:0xf bank_mask:0xf\n\t" \
    "v_add_f32_dpp %6, %6, %6 " ctrl " row_mask:0xf bank_mask:0xf\n\tv_add_f32_dpp %7, %7, %7 " ctrl " row_mask:0xf bank_mask:0xf\n\t"
    asm volatile("s_nop 1\n\t" OS8_STEP("quad_perm:[1,0,3,2]") OS8_STEP("quad_perm:[2,3,0,1]") OS8_STEP("row_half_mirror")
                 : "+v"(x[0]), "+v"(x[1]), "+v"(x[2]), "+v"(x[3]), "+v"(x[4]), "+v"(x[5]), "+v"(x[6]), "+v"(x[7]));
#undef OS8_STEP
}
struct ScanOps5 { f32x4 w[2], kk[2], bb[2], kp[2], rr[2], vv; };
__device__ __forceinline__ void scan_load5(ScanOps5& o, const LAS unsigned char* r4, const LAS unsigned char* r2r, const LAS unsigned char* r2v) {
    o.w[0] = LDS4(r4); o.w[1] = LDS4(r4 + 16); o.kk[0] = LDS4(r4 + 256); o.kk[1] = LDS4(r4 + 272); o.bb[0] = LDS4(r4 + 512); o.bb[1] = LDS4(r4 + 528); o.kp[0] = LDS4(r4 + 768); o.kp[1] = LDS4(r4 + 784);
    o.rr[0] = LDS4(r2r); o.rr[1] = LDS4(r2r + 16); o.vv = LDS4(r2v);
}
template <int MODE> __device__ __forceinline__ void phase5(const Ctx& c, float* __restrict__ YZ) {
    float* PL = (float*)(c.ws + WS_PL);
    const int tk = c.wave >> 1, half = c.wave & 1, rg = c.lane >> 3, q = c.lane & 7;
    for (int tg = c.bx; tg < 256; tg += c.G) {
        const int task0 = tg * 4;
        f32x2 Sp[4][4], Sl[4][4];
#pragma unroll
        for (int j = 0; j < 4; ++j)
#pragma unroll
            for (int i = 0; i < 4; ++i) { Sp[j][i] = (f32x2){(8 * q + 2 * i == 32 * half + 4 * rg + j) ? 1.f : 0.f, (8 * q + 2 * i + 1 == 32 * half + 4 * rg + j) ? 1.f : 0.f}; Sl[j][i] = (f32x2){0.f, 0.f}; }
        if (MODE != 2) scan_issue(c, task0, 0);
        asm volatile("s_waitcnt vmcnt(0)" ::: "memory"); __syncthreads();
        for (int s = 0; s < 16; ++s) {
            if (MODE != 2) { if (s + 1 < 16) scan_issue(c, task0, s + 1); }
            if (MODE != 1) {
            const LAS unsigned char* base = c.lds + (s & 1) * SC_BUF_BYTES + tk * SC_TASK_BYTES;
            const LAS unsigned char* r4b = base + q * 32; const LAS unsigned char* r2rb = base + 8192 + q * 32; const LAS unsigned char* r2b = base + 8192 + 256 + (32 * half + 4 * rg) * 4;
            float* yzp = YZ + ((size_t)((task0 + tk) >> 6) * T + ((task0 + tk) & 63) * 128 + s * SC_STEPS) * 128 + 32 * half + 4 * rg;
            ScanOps5 cur, nxt; scan_load5(cur, r4b, r2rb, r2b);
#pragma unroll 2
            for (int st = 0; st < SC_STEPS; ++st) {
                if (st + 1 < SC_STEPS) scan_load5(nxt, r4b + (st + 1) * 1024, r2rb + (st + 1) * 512, r2b + (st + 1) * 512);
                __builtin_amdgcn_sched_barrier(0);
                const f32x2 w2[4] = {cur.w[0].xy, cur.w[0].zw, cur.w[1].xy, cur.w[1].zw}, kk2[4] = {cur.kk[0].xy, cur.kk[0].zw, cur.kk[1].xy, cur.kk[1].zw};
                const f32x2 bb2[4] = {cur.bb[0].xy, cur.bb[0].zw, cur.bb[1].xy, cur.bb[1].zw}, kp2[4] = {cur.kp[0].xy, cur.kp[0].zw, cur.kp[1].xy, cur.kp[1].zw};
                float sp[4], sl[4];
#pragma unroll
                for (int j = 0; j < 4; ++j) { f32x2 a0 = Sp[j][0] * kk2[0], a1 = Sl[j][0] * kk2[0];
#pragma unroll
                    for (int i = 1; i < 4; ++i) { a0 = __builtin_elementwise_fma(Sp[j][i], kk2[i], a0); a1 = __builtin_elementwise_fma(Sl[j][i], kk2[i], a1); }
                    sp[j] = -oct_sum(a0.x + a0.y); sl[j] = -oct_sum(a1.x + a1.y); }
#pragma unroll
                for (int j = 0; j < 4; ++j) { const f32x2 vj = {cur.vv[j], cur.vv[j]}, spj = {sp[j], sp[j]}, slj = {sl[j], sl[j]};
#pragma unroll
                    for (int i = 0; i < 4; ++i) { Sp[j][i] = __builtin_elementwise_fma(Sp[j][i], w2[i], spj * bb2[i]);
                        Sl[j][i] = __builtin_elementwise_fma(Sl[j][i], w2[i], __builtin_elementwise_fma(slj, bb2[i], vj * kp2[i])); } }
                { const f32x2 rr2[4] = {cur.rr[0].xy, cur.rr[0].zw, cur.rr[1].xy, cur.rr[1].zw}; f32x4 yv, zv;
#pragma unroll
                  for (int j = 0; j < 4; ++j) { f32x2 a0 = Sp[j][0] * rr2[0], a1 = Sl[j][0] * rr2[0];
#pragma unroll
                      for (int i = 1; i < 4; ++i) { a0 = __builtin_elementwise_fma(Sp[j][i], rr2[i], a0); a1 = __builtin_elementwise_fma(Sl[j][i], rr2[i], a1); }
                      yv[j] = oct_sum(a0.x + a0.y); zv[j] = oct_sum(a1.x + a1.y); }
                  if (q == 0) { *(f32x4*)(yzp + (size_t)st * 128) = yv; *(f32x4*)(yzp + (size_t)st * 128 + 64) = zv; } }
                __builtin_amdgcn_sched_barrier(0);
                if (st + 1 < SC_STEPS) cur = nxt;
            }
            }
            asm volatile("s_waitcnt vmcnt(0)" ::: "memory"); __syncthreads();
        }
        float* o = PL + (size_t)(task0 + tk) * 8192 + (32 * half + 4 * rg) * 64 + 8 * q;
#pragma unroll
        for (int j = 0; j < 4; ++j) {
            *(f32x4*)(o + j * 64) = (f32x4){Sp[j][0].x, Sp[j][0].y, Sp[j][1].x, Sp[j][1].y}; *(f32x4*)(o + j * 64 + 4) = (f32x4){Sp[j][2].x, Sp[j][2].y, Sp[j][3].x, Sp[j][3].y};
            *(f32x4*)(o + 4096 + j * 64) = (f32x4){Sl[j][0].x, Sl[j][0].y, Sl[j][1].x, Sl[j][1].y}; *(f32x4*)(o + 4096 + j * 64 + 4) = (f32x4){Sl[j][2].x, Sl[j][2].y, Sl[j][3].x, Sl[j][3].y}; }
    }
}
struct ScanRaw { u32x2 r, k, v, rp, kp, vp, w, a; };
__device__ __forceinline__ void scan_raw_load(ScanRaw& o, const bf16* __restrict__ pr, const bf16* __restrict__ g1, bool first) {
    o.r = *(const u32x2*)(pr); o.k = *(const u32x2*)(pr + 512); o.v = *(const u32x2*)(pr + 1024); o.w = *(const u32x2*)(g1); o.a = *(const u32x2*)(g1 + 512);
    if (!first) { o.rp = *(const u32x2*)(pr - EIN); o.kp = *(const u32x2*)(pr - EIN + 512); o.vp = *(const u32x2*)(pr - EIN + 1024); }
    else { o.rp = (u32x2){0u, 0u}; o.kp = (u32x2){0u, 0u}; o.vp = (u32x2){0u, 0u}; }
}
__device__ __forceinline__ float row16_sum(float v) { v += __shfl_xor(v, 1); v += __shfl_xor(v, 2); v += __shfl_xor(v, 4); v += __shfl_xor(v, 8); return v; }
__device__ __forceinline__ float scan_produce(const ScanRaw& x, const LAS unsigned char* prm, LAS unsigned char* rec4, LAS unsigned char* rec2, int c4) {
    const f32x4 mur = LDS4(prm + c4 * 16), muk = LDS4(prm + 256 + c4 * 16), muv = LDS4(prm + 512 + c4 * 16), w0 = LDS4(prm + 768 + c4 * 16), a0 = LDS4(prm + 1024 + c4 * 16);
    const f32x4 kkw = LDS4(prm + 1280 + c4 * 16), kaw = LDS4(prm + 1536 + c4 * 16), rkw = LDS4(prm + 1792 + c4 * 16);
    f32x4 r, v, dec, kk, bb, k2; float n2 = 0.f, bon = 0.f;
#pragma unroll
    for (int e = 0; e < 4; ++e) { const int p = e >> 1, od = e & 1;
#define UNP_(L) (od ? bfhi(p ? x.L.y : x.L.x) : bflo(p ? x.L.y : x.L.x))
        const float r0 = UNP_(r), k0 = UNP_(k), v0 = UNP_(v), rp = UNP_(rp), kp = UNP_(kp), vp = UNP_(vp), wpre = UNP_(w), apre = UNP_(a);
#undef UNP_
        r[e] = r0 + (rp - r0) * mur[e]; const float k = k0 + (kp - k0) * muk[e]; v[e] = v0 + (vp - v0) * muv[e];
        const float z = w0[e] + wpre;
        dec[e] = __expf(-0.6065306597126334f * sigmoidf_(z));
        const float av = sigmoidf_(a0[e] + apre);
        kk[e] = k * kkw[e]; n2 += kk[e] * kk[e];
        k2[e] = k * (1.0f + (av - 1.0f) * kaw[e]);
        bb[e] = av;
        bon += r[e] * k2[e] * rkw[e];
    }
    n2 = row16_sum(n2); bon = row16_sum(bon);
    const float inv = 1.0f / fmaxf(sqrtf(n2), 1e-12f);
#pragma unroll
    for (int e = 0; e < 4; ++e) { kk[e] *= inv; bb[e] *= kk[e]; }
    *(LAS f32x4*)(rec4 + c4 * 16) = dec; *(LAS f32x4*)(rec4 + 256 + c4 * 16) = kk; *(LAS f32x4*)(rec4 + 512 + c4 * 16) = bb; *(LAS f32x4*)(rec4 + 768 + c4 * 16) = k2;
    *(LAS f32x4*)(rec2 + c4 * 16) = r; *(LAS f32x4*)(rec2 + 256 + c4 * 16) = v;
    return bon;
}
__device__ __forceinline__ void phase5f(const Ctx& c, const Args& a, float* __restrict__ YZ) {
    float* PL = (float*)(c.ws + WS_PL); float* __restrict__ BS = (float*)(c.ws + WS_BS);
    const bf16* __restrict__ P = (const bf16*)(c.ws + WS_PROJ); const bf16* __restrict__ G1 = (const bf16*)(c.ws + WS_G1);
    const int tk = c.wave >> 1, half = c.wave & 1, rg = c.lane >> 3, q = c.lane & 7, tl = c.lane >> 4, c4 = c.lane & 15;
    LAS unsigned char* prm = c.lds + 2 * SC_BUF_BYTES + tk * 2048;
    for (int tg = c.bx; tg < 256; tg += c.G) {
        const int task0 = tg * 4, task = task0 + tk, bh = task >> 6, chunk = task & 63, hd = bh & 7;
        const size_t mrow0 = (size_t)(bh >> 3) * T + chunk * 128;
        const bf16* pr0 = P + (mrow0 + 4 * half + tl) * EIN + 1024 + hd * 64 + 4 * c4; const bf16* g10 = G1 + (mrow0 + 4 * half + tl) * 1536 + hd * 64 + 4 * c4;
        float* bsp = BS + (mrow0 + 4 * half + tl) * 8 + hd;
        f32x2 Sp[4][4], Sl[4][4];
#pragma unroll
        for (int j = 0; j < 4; ++j)
#pragma unroll
            for (int i = 0; i < 4; ++i) { Sp[j][i] = (f32x2){(8 * q + 2 * i == 32 * half + 4 * rg + j) ? 1.f : 0.f, (8 * q + 2 * i + 1 == 32 * half + 4 * rg + j) ? 1.f : 0.f}; Sl[j][i] = (f32x2){0.f, 0.f}; }
        {
            const int arr = 4 * half + tl; const int cc = hd * 64 + 4 * c4;
            const float* src = arr == 0 ? INF(I_MU) + cc : arr == 1 ? INF(I_MU) + 512 + cc : arr == 2 ? INF(I_MU) + 1024 + cc : arr == 3 ? INF(I_W0) + cc : arr == 4 ? INF(I_A0) + cc : arr == 5 ? INF(I_KK) + cc : arr == 6 ? INF(I_KA) + cc : INF(I_RK) + cc;
            *(LAS f32x4*)(prm + arr * 256 + c4 * 16) = *(const f32x4*)src; }
        ScanRaw raw; scan_raw_load(raw, pr0, g10, chunk == 0 && half == 0 && tl == 0);
        __syncthreads();
        { const float bon = scan_produce(raw, prm, c.lds + tk * SC_TASK_BYTES + (4 * half + tl) * 1024, c.lds + tk * SC_TASK_BYTES + 8192 + (4 * half + tl) * 512, c4); if (c4 == 0) bsp[0] = bon; }
        scan_raw_load(raw, pr0 + (size_t)8 * EIN, g10 + (size_t)8 * 1536, false);
        __syncthreads();
#pragma unroll 1
        for (int s = 0; s < 16; ++s) {
            if (s + 1 < 16) { LAS unsigned char* nb = c.lds + ((s + 1) & 1) * SC_BUF_BYTES + tk * SC_TASK_BYTES;
                const float bon = scan_produce(raw, prm, nb + (4 * half + tl) * 1024, nb + 8192 + (4 * half + tl) * 512, c4); if (c4 == 0) bsp[(size_t)(s + 1) * 64] = bon;
                if (s + 2 < 16) scan_raw_load(raw, pr0 + (size_t)(s + 2) * 8 * EIN, g10 + (size_t)(s + 2) * 8 * 1536, false); }
            const LAS unsigned char* base = c.lds + (s & 1) * SC_BUF_BYTES + tk * SC_TASK_BYTES;
            const LAS unsigned char* r4b = base + q * 32; const LAS unsigned char* r2rb = base + 8192 + q * 32; const LAS unsigned char* r2b = base + 8192 + 256 + (32 * half + 4 * rg) * 4;
            float* yzp = YZ + ((size_t)((task0 + tk) >> 6) * T + ((task0 + tk) & 63) * 128 + s * SC_STEPS) * 128 + 32 * half + 4 * rg;
#define P5_STEP(OP, ST) do { __builtin_amdgcn_sched_barrier(0); \
                const f32x2 w2[4] = {OP.w[0].xy, OP.w[0].zw, OP.w[1].xy, OP.w[1].zw}, kk2[4] = {OP.kk[0].xy, OP.kk[0].zw, OP.kk[1].xy, OP.kk[1].zw}; \
                const f32x2 bb2[4] = {OP.bb[0].xy, OP.bb[0].zw, OP.bb[1].xy, OP.bb[1].zw}, kp2[4] = {OP.kp[0].xy, OP.kp[0].zw, OP.kp[1].xy, OP.kp[1].zw}; \
                float sp[4], sl[4]; { float rd[8]; \
                _Pragma("unroll") for (int j = 0; j < 4; ++j) { f32x2 a0 = Sp[j][0] * kk2[0], a1 = Sl[j][0] * kk2[0]; \
                    _Pragma("unroll") for (int i = 1; i < 4; ++i) { a0 = __builtin_elementwise_fma(Sp[j][i], kk2[i], a0); a1 = __builtin_elementwise_fma(Sl[j][i], kk2[i], a1); } \
                    rd[2 * j] = a0.x + a0.y; rd[2 * j + 1] = a1.x + a1.y; } \
                oct_sum8(rd); \
                _Pragma("unroll") for (int j = 0; j < 4; ++j) { sp[j] = -rd[2 * j]; sl[j] = -rd[2 * j + 1]; } } \
                _Pragma("unroll") for (int j = 0; j < 4; ++j) { const f32x2 vj = {OP.vv[j], OP.vv[j]}, spj = {sp[j], sp[j]}, slj = {sl[j], sl[j]}; \
                    _Pragma("unroll") for (int i = 0; i < 4; ++i) { Sp[j][i] = __builtin_elementwise_fma(Sp[j][i], w2[i], spj * bb2[i]); \
                        Sl[j][i] = __builtin_elementwise_fma(Sl[j][i], w2[i], __builtin_elementwise_fma(slj, bb2[i], vj * kp2[i])); } } \
                { const f32x2 rr2[4] = {OP.rr[0].xy, OP.rr[0].zw, OP.rr[1].xy, OP.rr[1].zw}; f32x4 yv, zv; float rd[8]; \
                  _Pragma("unroll") for (int j = 0; j < 4; ++j) { f32x2 a0 = Sp[j][0] * rr2[0], a1 = Sl[j][0] * rr2[0]; \
                      _Pragma("unroll") for (int i = 1; i < 4; ++i) { a0 = __builtin_elementwise_fma(Sp[j][i], rr2[i], a0); a1 = __builtin_elementwise_fma(Sl[j][i], rr2[i], a1); } \
                      rd[2 * j] = a0.x + a0.y; rd[2 * j + 1] = a1.x + a1.y; } \
                  oct_sum8(rd); \
                  _Pragma("unroll") for (int j = 0; j < 4; ++j) { yv[j] = rd[2 * j]; zv[j] = rd[2 * j + 1]; } \
                  if (q == 0) { *(f32x4*)(yzp + (size_t)(ST) * 128) = yv; *(f32x4*)(yzp + (size_t)(ST) * 128 + 64) = zv; } } \
                __builtin_amdgcn_sched_barrier(0); } while (0)
            ScanOps5 opA, opB; scan_load5(opA, r4b, r2rb, r2b);
#pragma unroll 1
            for (int st = 0; st < SC_STEPS; st += 2) {
                scan_load5(opB, r4b + (st + 1) * 1024, r2rb + (st + 1) * 512, r2b + (st + 1) * 512);
                P5_STEP(opA, st);
                if (st + 2 < SC_STEPS) scan_load5(opA, r4b + (st + 2) * 1024, r2rb + (st + 2) * 512, r2b + (st + 2) * 512);
                P5_STEP(opB, st + 1);
            }
#undef P5_STEP
            __syncthreads();
        }
        float* o = PL + (size_t)(task0 + tk) * 8192 + (32 * half + 4 * rg) * 64 + 8 * q;
#pragma unroll
        for (int j = 0; j < 4; ++j) {
            *(f32x4*)(o + j * 64) = (f32x4){Sp[j][0].x, Sp[j][0].y, Sp[j][1].x, Sp[j][1].y}; *(f32x4*)(o + j * 64 + 4) = (f32x4){Sp[j][2].x, Sp[j][2].y, Sp[j][3].x, Sp[j][3].y};
            *(f32x4*)(o + 4096 + j * 64) = (f32x4){Sl[j][0].x, Sl[j][0].y, Sl[j][1].x, Sl[j][1].y}; *(f32x4*)(o + 4096 + j * 64 + 4) = (f32x4){Sl[j][2].x, Sl[j][2].y, Sl[j][3].x, Sl[j][3].y}; }
    }
}
__device__ __forceinline__ void dma16(const void* gsrc, unsigned lds_dst) { unsigned keep;
    asm volatile("s_mov_b32 %0, m0\n\ts_mov_b32 m0, %2\n\ts_nop 0\n\tglobal_load_lds_dwordx4 %1, off\n\ts_mov_b32 m0, %0" : "=&s"(keep) : "v"(gsrc), "s"(lds_dst) : "memory"); }
__device__ __forceinline__ void dma4(const void* gsrc, unsigned lds_dst) { unsigned keep;
    asm volatile("s_mov_b32 %0, m0\n\ts_mov_b32 m0, %2\n\ts_nop 0\n\tglobal_load_lds_dword %1, off\n\ts_mov_b32 m0, %0" : "=&s"(keep) : "v"(gsrc), "s"(lds_dst) : "memory"); }
__device__ __forceinline__ void phase6(const Ctx& c, const Args& a) {
    const float* __restrict__ PL = (const float*)(c.ws + WS_PL); float* __restrict__ SI = (float*)(c.ws + WS_SINIT);
    constexpr int NB6 = 5, SLOT6 = 16384 + 4096, SB_OFF = NB6 * SLOT6, SB_BYTES = 16 * 65 * 4;
    for (int blk = c.bx; blk < 96; blk += c.G) {
        if (blk < 64) {
            const int bh = blk >> 2, rg = blk & 3;
            const unsigned lds0 = (unsigned)(uintptr_t)c.lds;
            const float* Pb = PL + (size_t)(bh * 64) * 8192;
            const int hw = c.wave - 4, nt = c.wave, j = c.lane & 15, q = c.lane >> 4;
#define P6_ISSUE(cc, slot) do { const float* pc_ = Pb + (size_t)(cc) * 8192; const unsigned d_ = lds0 + (unsigned)(slot) * SLOT6; \
            _Pragma("unroll") for (int i_ = 0; i_ < 4; ++i_) dma16(pc_ + (4 * hw + i_) * 256 + c.lane * 4, (unsigned)__builtin_amdgcn_readfirstlane(d_ + (4 * hw + i_) * 1024)); \
            dma16(pc_ + 4096 + (16 * rg) * 64 + hw * 256 + c.lane * 4, (unsigned)__builtin_amdgcn_readfirstlane(d_ + 16384 + hw * 1024)); } while (0)
            asm volatile("s_waitcnt vmcnt(0) lgkmcnt(0)\n\ts_barrier" ::: "memory");
            if (c.wave >= 4) {
#pragma unroll
                for (int cc = 0; cc < NB6 - 1; ++cc) P6_ISSUE(cc, cc);
            } else {
#pragma unroll
                for (int r = 0; r < 4; ++r) *(LAS float*)(c.lds + SB_OFF + ((4 * q + r) * 65 + 16 * nt + j) * 4) = 0.f;
            }
            f32x4 st = {0.f, 0.f, 0.f, 0.f};
            int slot = 0, islot = NB6 - 1;
#pragma unroll 1
            for (int cc = 0; cc < 64; ++cc) {
                if (c.wave >= 4) asm volatile("s_waitcnt vmcnt(15)" ::: "memory");
                asm volatile("s_waitcnt lgkmcnt(0)\n\ts_barrier" ::: "memory");
                if (c.wave >= 4) { const int nc = cc + NB6 - 1 < 64 ? cc + NB6 - 1 : 63; P6_ISSUE(nc, islot); }
                else {
                    float* sip = SI + ((size_t)(bh * 64 + cc) * 64 + 16 * rg + 4 * q) * 64 + 16 * nt + j;
#pragma unroll
                    for (int r = 0; r < 4; ++r) sip[r * 64] = st[r];
                    const LAS unsigned char* sl = c.lds + slot * SLOT6;
                    const LAS unsigned char* sa = c.lds + SB_OFF + (cc & 1) * SB_BYTES + (j * 65 + q) * 4;
                    const LAS unsigned char* sb = sl + (q * 64 + 16 * nt + j) * 4;
                    f32x4 a0, a1 = {0.f, 0.f, 0.f, 0.f};
#pragma unroll
                    for (int r = 0; r < 4; ++r) a0[r] = *(const LAS float*)(sl + 16384 + ((4 * q + r) * 64 + 16 * nt + j) * 4);
#pragma unroll
                    for (int ks = 0; ks < 16; ks += 2) {
                        a0 = __builtin_amdgcn_mfma_f32_16x16x4f32(*(const LAS float*)(sa + ks * 16), *(const LAS float*)(sb + ks * 1024), a0, 0, 0, 0);
                        a1 = __builtin_amdgcn_mfma_f32_16x16x4f32(*(const LAS float*)(sa + (ks + 1) * 16), *(const LAS float*)(sb + (ks + 1) * 1024), a1, 0, 0, 0); }
                    st = a0 + a1;
#pragma unroll
                    for (int r = 0; r < 4; ++r) *(LAS float*)(c.lds + SB_OFF + ((cc + 1) & 1) * SB_BYTES + ((4 * q + r) * 65 + 16 * nt + j) * 4) = st[r];
                }
                slot = slot + 1 == NB6 ? 0 : slot + 1; islot = islot + 1 == NB6 ? 0 : islot + 1;
            }
            asm volatile("s_waitcnt vmcnt(0) lgkmcnt(0)\n\ts_barrier" ::: "memory");
#undef P6_ISSUE
        } else {
            const int q6 = blk - 64, b = q6 >> 4, chl = c.tid & 31, ch = (q6 & 15) * 32 + chl, seg = c.tid >> 5;
            const float* __restrict__ LSA = (const float*)(c.ws + WS_LSA); const float* __restrict__ LSH = (const float*)(c.ws + WS_LSH); float* __restrict__ LC = (float*)(c.ws + WS_LC);
            const unsigned t0 = (unsigned)(b * 512 + seg * 32) * 512u + (unsigned)ch;
            float sa[32], sh[32];
#pragma unroll
            for (int i = 0; i < 32; ++i) { sa[i] = __expf(LSA[t0 + (unsigned)i * 512u]); sh[i] = LSH[t0 + (unsigned)i * 512u]; }
            float A = 1.f, H = 0.f;
#pragma unroll
            for (int i = 0; i < 32; ++i) { H = sa[i] * H + sh[i]; A *= sa[i]; }
            LAS float* ex = (LAS float*)c.lds;
            asm volatile("s_waitcnt lgkmcnt(0)\n\ts_barrier" ::: "memory");
            ex[(seg * 32 + chl) * 2] = A; ex[(seg * 32 + chl) * 2 + 1] = H;
            asm volatile("s_waitcnt lgkmcnt(0)\n\ts_barrier" ::: "memory");
            float h = 0.f;
            for (int s2 = 0; s2 < seg; ++s2) h = ex[(s2 * 32 + chl) * 2] * h + ex[(s2 * 32 + chl) * 2 + 1];
#pragma unroll
            for (int i = 0; i < 32; ++i) { LC[t0 + (unsigned)i * 512u] = h; h = sa[i] * h + sh[i]; }
            asm volatile("s_waitcnt lgkmcnt(0)\n\ts_barrier" ::: "memory");
        }
    }
    if (c.G > P6_BUSY && c.bx >= P6_BUSY) { const int gw6 = (c.bx - P6_BUSY) * NWAVES + c.wave, ngw6 = (c.G - P6_BUSY) * NWAVES; convert_rest(c, a, gw6, ngw6); moe_convert(c, a, 0, 0, P6_MOE_E, gw6, ngw6); if (P6_MOE_U > 0) moe_convert(c, a, 1, 0, P6_MOE_U, gw6, ngw6); }
}
__device__ __forceinline__ void phase7(const Ctx& c, const float* __restrict__ YZ) {
    const float* __restrict__ SI = (const float*)(c.ws + WS_SINIT); float* __restrict__ OR = (float*)(c.ws + WS_ORAW);
    LAS float* Yl = (LAS float*)c.lds;
    const int v = c.tid & 63, tq = c.wave;
    for (int task = c.bx; task < 1024; task += c.G) {
        const int bh = task >> 6, cc = task & 63; const size_t tb = (size_t)bh * T + cc * 128;
        LAS float* Sl = Yl + 16384;
#pragma unroll
        for (int i = 0; i < 2; ++i) { const int idx = c.tid + 512 * i, row = idx >> 4, c4 = idx & 15; *(LAS f32x4*)(Sl + row * 68 + 4 * c4) = *(const f32x4*)(SI + ((size_t)task * 64 + row) * 64 + 4 * c4); }
#pragma unroll
        for (int i = 0; i < 4; ++i) { const int idx = c.tid + 512 * i, tt = idx >> 4, c4 = idx & 15; *(LAS f32x4*)(Yl + tt * 64 + 4 * c4) = *(const f32x4*)(YZ + (tb + tt) * 128 + 4 * c4); }
#pragma unroll
        for (int i = 0; i < 4; ++i) { const int idx = c.tid + 512 * i, tt = idx >> 4, c4 = idx & 15; *(LAS f32x4*)(Yl + 8192 + tt * 64 + 4 * c4) = *(const f32x4*)(YZ + (tb + tt) * 128 + 64 + 4 * c4); }
        __syncthreads();
        f32x4 sr[16];
#pragma unroll
        for (int i = 0; i < 16; ++i) sr[i] = *(const LAS f32x4*)(Sl + v * 68 + 4 * i);
        float* orow = OR + ((size_t)(bh >> 3) * T + cc * 128) * 512 + (bh & 7) * 64 + v;
#pragma unroll 2
        for (int i = 0; i < 16; ++i) { const int tt = 16 * tq + i; float acc = Yl[8192 + tt * 64 + v]; f32x4 a4 = {0.f, 0.f, 0.f, 0.f};
#pragma unroll
            for (int k4 = 0; k4 < 16; ++k4) { const f32x4 y4 = *(const LAS f32x4*)(Yl + tt * 64 + 4 * k4); a4 += sr[k4] * y4; }
            acc += (a4[0] + a4[1]) + (a4[2] + a4[3]);
            orow[(size_t)tt * 512] = acc; }
        __syncthreads();
    }
}
template <int MODE> __device__ __forceinline__ void phase8(const Ctx& c, const Args& a) {
    const bf16* __restrict__ P = (const bf16*)(c.ws + WS_PROJ); bf16* __restrict__ Y = (bf16*)(c.ws + WS_Y);
    const float* __restrict__ OR = (const float*)(c.ws + WS_ORAW); const float* __restrict__ BS = (const float*)(c.ws + WS_BS);
    const bf16* __restrict__ G1 = (const bf16*)(c.ws + WS_G1);
    const bf16* __restrict__ HL = (const bf16*)(c.ws + WS_LA); const bf16* __restrict__ CP = (const bf16*)(c.ws + WS_LU); const float* __restrict__ LC = (const float*)(c.ws + WS_LC);
    const int hd = c.lane >> 3, ch = 64 * hd + 8 * (c.lane & 7);
    float gw[8], gb[8], muv[8];
#pragma unroll
    for (int e = 0; e < 8; ++e) { gw[e] = INF(I_GNW)[ch + e]; gb[e] = INF(I_GNB)[ch + e]; muv[e] = INF(I_MU)[1024 + ch + e]; }
    for (int m = c.gw; m < M; m += c.ngw) { const int t = m & (T - 1);
        const f32x4 oa = *(const f32x4*)(OR + (size_t)m * 512 + ch), ob = *(const f32x4*)(OR + (size_t)m * 512 + ch + 4);
        const u32x4 vq = *(const u32x4*)(P + (size_t)m * EIN + 2048 + ch); u32x4 vpq = {0u, 0u, 0u, 0u}; if (t > 0) vpq = *(const u32x4*)(P + (size_t)(m - 1) * EIN + 2048 + ch);
        const float bon = BS[(size_t)m * 8 + hd];
        const u32x4 gq = *(const u32x4*)(G1 + (size_t)m * 1536 + 1024 + ch);
        const u32x4 hq = *(const u32x4*)(HL + (size_t)m * 512 + ch), cq = *(const u32x4*)(CP + (size_t)m * 512 + ch), lq = *(const u32x4*)(P + (size_t)m * EIN + 512 + ch);
        const f32x4 ca = *(const f32x4*)(LC + (size_t)(m >> 4) * 512 + ch), cb = *(const f32x4*)(LC + (size_t)(m >> 4) * 512 + ch + 4);
        float o[8] = {oa[0], oa[1], oa[2], oa[3], ob[0], ob[1], ob[2], ob[3]};
        float s = 0.f;
#pragma unroll
        for (int e = 0; e < 8; ++e) s += o[e];
        s += __shfl_xor(s, 1); s += __shfl_xor(s, 2); s += __shfl_xor(s, 4);
        const float mean = s * (1.0f / 64.0f); float q = 0.f;
#pragma unroll
        for (int e = 0; e < 8; ++e) { o[e] -= mean; q += o[e] * o[e]; }
        q += __shfl_xor(q, 1); q += __shfl_xor(q, 2); q += __shfl_xor(q, 4);
        const float rstd = rsqrtf(q * (1.0f / 64.0f) + 64e-5f);
        float v[8]; { float v0[8], vp[8]; unpack8(vq, v0); unpack8(vpq, vp);
#pragma unroll
            for (int e = 0; e < 8; ++e) v[e] = v0[e] + (vp[e] - v0[e]) * muv[e]; }
        float g[8]; unpack8(gq, g);
        float y[8];
#pragma unroll
        for (int e = 0; e < 8; ++e) y[e] = (o[e] * rstd * gw[e] + gb[e] + bon * v[e]) * g[e];
        *(u32x4*)(Y + (size_t)m * 1024 + 512 + ch) = pack8(y);
        float hl[8], cp[8], lg[8]; unpack8(hq, hl); unpack8(cq, cp); unpack8(lq, lg);
        const float lc[8] = {ca[0], ca[1], ca[2], ca[3], cb[0], cb[1], cb[2], cb[3]};
#pragma unroll
        for (int e = 0; e < 8; ++e) y[e] = gelu_tanh(lg[e]) * (hl[e] + cp[e] * lc[e]);
        *(u32x4*)(Y + (size_t)m * 1024 + ch) = pack8(y);
    }
}
__device__ __forceinline__ void phase15(const Ctx& c, const Args& a) {
    bf16* Q = (bf16*)(c.ws + WS_Q); bf16* Kb = (bf16*)(c.ws + WS_K); const int* pos = (const int*)a.in[I_POS];
    const int d0 = 16 * (c.lane & 3);
    float qg[16], kg[16];
#pragma unroll
    for (int e = 0; e < 16; ++e) { qg[e] = INF(I_QNORM)[d0 + e] * (0.125f*1.4426950408889634f); kg[e] = INF(I_KNORM)[d0 + e]; }
    const float inv_l = powf(500000.0f, -(float)(2 * (c.lane & 7)) / 16.0f);
    for (int m = c.gw; m < M; m += c.ngw) {
        const float p = (float)pos[m];
        float cs[8], sn[8];
        { float sl, cl; sincosf(p * inv_l, &sl, &cl);
#pragma unroll
          for (int i = 0; i < 8; ++i) { cs[i] = __builtin_bit_cast(float, __builtin_amdgcn_readlane(__builtin_bit_cast(int, cl), i)); sn[i] = __builtin_bit_cast(float, __builtin_amdgcn_readlane(__builtin_bit_cast(int, sl), i)); } }
#pragma unroll
        for (int which = 0; which < 2; ++which) {
            bf16* row = (which ? Kb : Q) + (size_t)m * 1024 + 16 * c.lane;
            float x[16]; { float lo[8], hi[8]; unpack8(*(const u32x4*)row, lo); unpack8(*(const u32x4*)(row + 8), hi);
#pragma unroll
                for (int e = 0; e < 8; ++e) { x[e] = lo[e]; x[8 + e] = hi[e]; } }
            float s = 0.f;
#pragma unroll
            for (int e = 0; e < 16; ++e) s += x[e] * x[e];
            s += __shfl_xor(s, 1); s += __shfl_xor(s, 2);
            const float r = rsqrtf(s * (1.0f / 64.0f) + 1e-6f);
#pragma unroll
            for (int e = 0; e < 16; ++e) x[e] = x[e] * r * (which ? kg[e] : qg[e]);
            if ((c.lane & 3) == 0) {
#pragma unroll
                for (int i = 0; i < 8; ++i) { const float x1 = x[i], x2 = x[8 + i]; x[i] = x1 * cs[i] - x2 * sn[i]; x[8 + i] = x2 * cs[i] + x1 * sn[i]; } }
            float lo[8], hi[8];
#pragma unroll
            for (int e = 0; e < 8; ++e) { lo[e] = x[e]; hi[e] = x[8 + e]; }
            *(u32x4*)row = pack8(lo); *(u32x4*)(row + 8) = pack8(hi);
        }
    }
}
__device__ __forceinline__ void phase17(const Ctx& c, const Args& a) {
    const bf16* O0 = (const bf16*)(c.ws + WS_OA0); const bf16* O1 = (const bf16*)(c.ws + WS_OA1); bf16* AO = (bf16*)(c.ws + WS_AO);
    const float lam_init = 0.8f - 0.6f * 0.7408182206817179f;
    const float d1 = wave_sum(INF(I_LQ1)[c.lane] * INF(I_LK1)[c.lane]), d2 = wave_sum(INF(I_LQ2)[c.lane] * INF(I_LK2)[c.lane]);
    const float lam = __expf(d1) - __expf(d2) + lam_init;
    const int d0 = 16 * (c.lane & 7);
    float sg[16];
#pragma unroll
    for (int e = 0; e < 16; ++e) sg[e] = INF(I_SUBLN)[d0 + e] * (1.0f - lam_init);
    for (int m = c.gw; m < M; m += c.ngw) {
        const size_t off = (size_t)m * 1024 + 16 * c.lane;
        float x0[8], x1[8], y0[8], y1[8], d[16];
        unpack8(*(const u32x4*)(O0 + off), x0); unpack8(*(const u32x4*)(O0 + off + 8), x1); unpack8(*(const u32x4*)(O1 + off), y0); unpack8(*(const u32x4*)(O1 + off + 8), y1);
        float s = 0.f;
#pragma unroll
        for (int e = 0; e < 8; ++e) { d[e] = x0[e] - lam * y0[e]; d[8 + e] = x1[e] - lam * y1[e]; s += d[e] * d[e] + d[8 + e] * d[8 + e]; }
        s += __shfl_xor(s, 1); s += __shfl_xor(s, 2); s += __shfl_xor(s, 4);
        const float r = rsqrtf(s * (1.0f / 128.0f) + 1e-6f);
        float lo[8], hi[8];
#pragma unroll
        for (int e = 0; e < 8; ++e) { lo[e] = d[e] * r * sg[e]; hi[e] = d[8 + e] * r * sg[8 + e]; }
        *(u32x4*)(AO + off) = pack8(lo); *(u32x4*)(AO + off + 8) = pack8(hi);
    }
}
template <class XT> __device__ __forceinline__ void phase19(const Ctx& c, const Args& a, const XT* x3) {
    unsigned char* XNM = (unsigned char*)(c.ws + WS_XNM);       unsigned* cntw = (unsigned*)(c.ws + WS_CTL) + CW_CNT; int* LIST = (int*)(c.ws + WS_LIST); int* TOKI = (int*)(c.ws + WS_TOKI); float* TOKG = (float*)(c.ws + WS_TOKG);
    const float* g = INF(I_OLNFFN); const float* rt = INF(I_ROUTER);
    f32x4 gv[4]; f32x4 rw[4][4][2];
#pragma unroll
    for (int j = 0; j < 4; ++j) { gv[j] = ((const f32x4*)g)[c.lane + 64 * j];
#pragma unroll
        for (int i = 0; i < 4; ++i) { const float* rp = rt + (size_t)(256 * j + 4 * c.lane + i) * 8; rw[j][i][0] = *(const f32x4*)rp; rw[j][i][1] = *(const f32x4*)(rp + 4); } }
    for (int m = c.gw; m < M; m += c.ngw) {
        f32x4 v[4]; float s = 0.f;
#pragma unroll
        for (int j = 0; j < 4; ++j) { v[j] = ld_x4(x3 + (size_t)m * D, c.lane + 64 * j); s += (v[j].x * v[j].x + v[j].y * v[j].y) + (v[j].z * v[j].z + v[j].w * v[j].w); }
        const float r = rsqrtf(wave_sum(s) * (1.0f / 1024.0f) + 1e-6f);
        f32x4 l0 = {0.f, 0.f, 0.f, 0.f}, l1 = {0.f, 0.f, 0.f, 0.f};
#pragma unroll
        for (int j = 0; j < 4; ++j) { const f32x4 o = v[j] * r * gv[j];
            ((unsigned*)(XNM + (size_t)m * D))[c.lane + 64 * j] = pg8::pk4_fp8(o.x, o.y, o.z, o.w);
#pragma unroll
            for (int i = 0; i < 4; ++i) { l0 += rw[j][i][0] * o[i]; l1 += rw[j][i][1] * o[i]; } }
        float lg[8];
#pragma unroll
        for (int e = 0; e < 4; ++e) { lg[e] = wave_sum(l0[e]); lg[4 + e] = wave_sum(l1[e]); }
        int i1 = 0; float v1 = lg[0];
#pragma unroll
        for (int e = 1; e < 8; ++e) if (lg[e] > v1) { v1 = lg[e]; i1 = e; }
        int i2 = (i1 + 1) & 7; float v2 = -INFINITY;
#pragma unroll
        for (int e = 0; e < 8; ++e) if (e != i1 && lg[e] > v2) { v2 = lg[e]; i2 = e; }
        if (c.lane == 0) {
            const float g2 = 1.0f / (1.0f + __expf(v1 - v2)), g1 = 1.0f - g2;
            const int s1 = (int)__hip_atomic_fetch_add(cntw + 64 * i1, 1u, __ATOMIC_RELAXED, __HIP_MEMORY_SCOPE_AGENT);
            const int s2 = (int)__hip_atomic_fetch_add(cntw + 64 * i2, 1u, __ATOMIC_RELAXED, __HIP_MEMORY_SCOPE_AGENT);
            LIST[i1 * 16384 + s1] = m; LIST[i2 * 16384 + s2] = m;
            *(int4*)(TOKI + (size_t)m * 4) = make_int4(i1, s1, i2, s2); *(f32x2*)(TOKG + (size_t)m * 2) = (f32x2){g1, g2};
        }
    }
}
template <class XT> __device__ __forceinline__ void phase22(const Ctx& c, const XT* x3, float* out) {
    const bf16* Y2 = (const bf16*)(c.ws + WS_Y2); unsigned* cntw = (unsigned*)(c.ws + WS_CTL) + CW_CNT; const int* TOKI = (const int*)(c.ws + WS_TOKI); const float* TOKG = (const float*)(c.ws + WS_TOKG);
    int toff[8]; { int acc = 0;
#pragma unroll
        for (int e = 0; e < 8; ++e) { toff[e] = acc; acc += ((int)__hip_atomic_load(cntw + 64 * e, __ATOMIC_RELAXED, __HIP_MEMORY_SCOPE_AGENT) + 255) >> 8; } }
    for (int m = c.gw; m < M; m += c.ngw) {
        int4 ti; f32x2 tg;
        ti.x = __hip_atomic_load(TOKI + (size_t)m * 4 + 0, __ATOMIC_RELAXED, __HIP_MEMORY_SCOPE_AGENT); ti.y = __hip_atomic_load(TOKI + (size_t)m * 4 + 1, __ATOMIC_RELAXED, __HIP_MEMORY_SCOPE_AGENT);
        ti.z = __hip_atomic_load(TOKI + (size_t)m * 4 + 2, __ATOMIC_RELAXED, __HIP_MEMORY_SCOPE_AGENT); ti.w = __hip_atomic_load(TOKI + (size_t)m * 4 + 3, __ATOMIC_RELAXED, __HIP_MEMORY_SCOPE_AGENT);
        tg.x = __hip_atomic_load(TOKG + (size_t)m * 2 + 0, __ATOMIC_RELAXED, __HIP_MEMORY_SCOPE_AGENT); tg.y = __hip_atomic_load(TOKG + (size_t)m * 2 + 1, __ATOMIC_RELAXED, __HIP_MEMORY_SCOPE_AGENT);
        int b1 = 0, b2 = 0;
#pragma unroll
        for (int e = 0; e < 8; ++e) { if (ti.x == e) b1 = toff[e]; if (ti.z == e) b2 = toff[e]; }
        const bf16* y1 = Y2 + (size_t)(b1 * 256 + ti.y) * 1024; const bf16* y2 = Y2 + (size_t)(b2 * 256 + ti.w) * 1024;
#pragma unroll
        for (int j = 0; j < 4; ++j) { const u32x2 w1 = ((const u32x2*)y1)[c.lane + 64 * j], w2 = ((const u32x2*)y2)[c.lane + 64 * j];
            f32x4* op = (f32x4*)(out + (size_t)m * D) + c.lane + 64 * j; f32x4 o = ld_x4(x3 + (size_t)m * D, c.lane + 64 * j);
            o.x += tg.x * bflo(w1.x) + tg.y * bflo(w2.x); o.y += tg.x * bfhi(w1.x) + tg.y * bfhi(w2.x); o.z += tg.x * bflo(w1.y) + tg.y * bflo(w2.y); o.w += tg.x * bfhi(w1.y) + tg.y * bfhi(w2.y);
            *op = o; }
    }
}

__global__ void __launch_bounds__(NTHR, 2) fwd(Args a) {
    extern __shared__ __attribute__((aligned(16))) unsigned char lds_raw[];
    Ctx c; c.lds = (LAS unsigned char*)lds_raw; c.ws = a.ws;
    c.tid = threadIdx.x; c.lane = c.tid & 63; c.wave = __builtin_amdgcn_readfirstlane(c.tid >> 6);
    c.G = gridDim.x; c.bx = blockIdx.x; c.vcu = (c.G % 8 == 0) ? (c.bx % 8) * (c.G / 8) + c.bx / 8 : c.bx;
    c.gw = c.vcu * NWAVES + c.wave; c.ngw = c.G * NWAVES;
    volatile LAS unsigned* MISC = (volatile LAS unsigned*)(c.lds + MISC_OFF);
    for (int u = c.tid; u < (LDS_BYTES - RING_BYTES) / 4; u += NTHR) ((LAS unsigned*)(c.lds + RING_BYTES))[u] = 0u;
    __syncthreads();
    unsigned* ctl = (unsigned*)(a.ws + WS_CTL);
    const int lo = a.ph_lo, hi = a.ph_hi;
    XcdBarrier bar; bar.bar = ctl + CW_BAR; bar.x = 0; bar.st = MISC + 8;
    unsigned bar_gen = 0u; (void)bar_gen;
    if (FLAT_BAR != 1 && hi - lo > 1) bar = xcd_barrier_post(ctl + CW_BAR, MISC + 8);
#ifndef PHMASK
#define PHMASK 0x7fffffu
#endif
#define IN(k) ((((PHMASK) >> (k)) & 1u) && lo <= (k) && (k) < hi)
#ifndef REPMASK
#define REPMASK 0u
#endif
#if PROBE_BUILD
#define NREP(k) ((((REPMASK) >> (k)) & 1u) ? ((int)((a.repmask >> (k)) & 1u) + 1) : 1)
#else
#define NREP(k) 1
#endif
#define SEAM(k) do { if (IN(k) && IN((k) + 1)) { GRID_BARRIER(bar); } } while (0)
    float* out = a.out; unsigned char* ws = a.ws;
    bf16* XN = (bf16*)(ws + WS_XN); bf16* XR = (bf16*)(ws + WS_XR);

    if (IN(0)) {
#pragma unroll 1
        for (int rep_ = 0; rep_ < NREP(0); ++rep_) { { phase0(c, a); }
        if (rep_ + 1 < NREP(0)) GRID_BARRIER(bar); } }
    SEAM(0);
    if (IN(1)) {
#pragma unroll 1
        for (int rep_ = 0; rep_ < NREP(1); ++rep_) { { { pg8::Gemm g{XN, (const bf16*)(ws + WS_WIN), D, 0}; pg8::StaticOrder S; S.init(M, EIN, c.G, c.bx); pg8::EpiStore E{(bf16*)(ws + WS_PROJ), EIN, 0, 0};
        pg8::gemm_phase<pg8::EpiStore, pg8::StaticOrder, false>(c.lds, g, S, E); } }
        if (rep_ + 1 < NREP(1)) GRID_BARRIER(bar); } }
    SEAM(1);
    if (IN(2)) {
#pragma unroll 1
        for (int rep_ = 0; rep_ < NREP(2); ++rep_) { { phase2(c, a); }
        if (rep_ + 1 < NREP(2)) GRID_BARRIER(bar); } }
    SEAM(2);
    if (IN(3)) {
#pragma unroll 1
        for (int rep_ = 0; rep_ < NREP(3); ++rep_) { { {
        { pg8::Gemm g{(const bf16*)(ws + WS_A2), (const bf16*)(ws + WS_B2T), 128, 0, 256}; pg8::StaticOrderT<1> S; S.init(M, 1536, c.G, c.bx); pg8::EpiStore E{(bf16*)(ws + WS_G1), 1536, 0, 0};
          pg8::gemm_phase<pg8::EpiStore, pg8::StaticOrderT<1>, false>(c.lds, g, S, E); }
        { pg8::Gemm g{(const bf16*)(ws + WS_XC), (const bf16*)(ws + WS_BLRU), 256, 0, 512}; pg8::StaticOrderT<2> S; S.init(M, 1024, c.G, c.bx); pg8::EpiStore E{(bf16*)(ws + WS_G2), 1024, 0, 0};
          pg8::gemm_phase<pg8::EpiStore, pg8::StaticOrderT<2>, false>(c.lds, g, S, E); } } }
        if (rep_ + 1 < NREP(3)) GRID_BARRIER(bar); } }
    SEAM(3);
#if defined(PROBE_P4MODE)
    if (IN(4)) { phase4<PROBE_P4MODE>(c, a); GRID_BARRIER(bar); }
#endif
    if (IN(4)) {
#pragma unroll 1
        for (int rep_ = 0; rep_ < NREP(4); ++rep_) { { }
        if (rep_ + 1 < NREP(4)) GRID_BARRIER(bar); } }
#if defined(PROBE_P5MODE)
    if (IN(5)) { phase5<PROBE_P5MODE>(c, out); GRID_BARRIER(bar); }
#endif
    if (IN(5)) {
#pragma unroll 1
        for (int rep_ = 0; rep_ < NREP(5); ++rep_) { { phase4<2>(c, a); phase5f(c, a, out); }
        if (rep_ + 1 < NREP(5)) GRID_BARRIER(bar); } }
    SEAM(5);
#if defined(PROBE_P6)
    if (IN(6)) { phase6(c, a); GRID_BARRIER(bar); }
#endif
    if (IN(6)) {
#pragma unroll 1
        for (int rep_ = 0; rep_ < NREP(6); ++rep_) { { phase6(c, a); }
        if (rep_ + 1 < NREP(6)) GRID_BARRIER(bar); } }
    SEAM(6);
    if (IN(7)) {
#pragma unroll 1
        for (int rep_ = 0; rep_ < NREP(7); ++rep_) { { phase7(c, out); }
        if (rep_ + 1 < NREP(7)) GRID_BARRIER(bar); } }
    SEAM(7);
#if defined(PROBE_P8MODE)
    if (IN(8)) { phase8<PROBE_P8MODE>(c, a); GRID_BARRIER(bar); }
#endif
    if (IN(8)) {
#pragma unroll 1
        for (int rep_ = 0; rep_ < NREP(8); ++rep_) { { phase8<0>(c, a); }
        if (rep_ + 1 < NREP(8)) GRID_BARRIER(bar); } }
    SEAM(8);
    if (IN(9)) {
#pragma unroll 1
        for (int rep_ = 0; rep_ < NREP(9); ++rep_) { { { pg8::Gemm g{(const bf16*)(ws + WS_Y), (const bf16*)(ws + WS_WOUT), D, 0}; pg8::StaticOrder S; S.init(M, D, c.G, c.bx); pg8::EpiResidB E{INF(I_X), nullptr, XR, D, (float*)(ws + WS_RS1)};
        pg8::gemm_phase<pg8::EpiResidB, pg8::StaticOrder, false>(c.lds, g, S, E); } }
        if (rep_ + 1 < NREP(9)) GRID_BARRIER(bar); } }
    SEAM(9);
    if (IN(10)) {
#pragma unroll 1
        for (int rep_ = 0; rep_ < NREP(10); ++rep_) { { }
        if (rep_ + 1 < NREP(10)) GRID_BARRIER(bar); } }
    if (IN(11)) {
#pragma unroll 1
        for (int rep_ = 0; rep_ < NREP(11); ++rep_) { { { pg8::Gemm g{XR, (const bf16*)(ws + WS_WGU), D, 0}; pg8::StaticOrder S; S.init(M, 2 * FFN, c.G, c.bx); pg8::RowScaled<pg8::EpiSwiGLU> E{{(bf16*)(ws + WS_PROJ), FFN}, (const float*)(ws + WS_RS1)};
        pg8::gemm_phase<pg8::RowScaled<pg8::EpiSwiGLU>, pg8::StaticOrder, false>(c.lds, g, S, E);
        if (c.G == 256 && c.bx >= 128) moe_convert(c, a, 1, 0, P11_MOE_U, (c.bx - 128) * NWAVES + c.wave, 128 * NWAVES); } }
        if (rep_ + 1 < NREP(11)) GRID_BARRIER(bar); } }
    SEAM(11);
    if (IN(12)) {
#pragma unroll 1
        for (int rep_ = 0; rep_ < NREP(12); ++rep_) { { { pg8::Gemm g{(const bf16*)(ws + WS_PROJ), (const bf16*)(ws + WS_WDN), FFN, 0}; pg8::StaticOrder S; S.init(M, D, c.G, c.bx); pg8::EpiResidB E{nullptr, XR, XR, D, (float*)(ws + WS_RS2)};
        pg8::gemm_phase<pg8::EpiResidB, pg8::StaticOrder, false>(c.lds, g, S, E); } }
        if (rep_ + 1 < NREP(12)) GRID_BARRIER(bar); } }
    SEAM(12);
    if (IN(13)) {
#pragma unroll 1
        for (int rep_ = 0; rep_ < NREP(13); ++rep_) { { }
        if (rep_ + 1 < NREP(13)) GRID_BARRIER(bar); } }
    if (IN(14)) {
#pragma unroll 1
        for (int rep_ = 0; rep_ < NREP(14); ++rep_) { { { pg8::Gemm g{XR, (const bf16*)(ws + WS_WQKV), D, 0}; pg8::StaticOrder S; S.init(M, 3072, c.G, c.bx); pg8::RowScaled<pg8::EpiStore> E{{(bf16*)(ws + WS_Q), D, 1024, (size_t)(WS_K - WS_Q) / 2}, (const float*)(ws + WS_RS2)};
        pg8::gemm_phase<pg8::RowScaled<pg8::EpiStore>, pg8::StaticOrder, false>(c.lds, g, S, E); } }
        if (rep_ + 1 < NREP(14)) GRID_BARRIER(bar); } }
    SEAM(14);
    if (IN(15)) {
#pragma unroll 1
        for (int rep_ = 0; rep_ < NREP(15); ++rep_) { { { phase15(c, a); moe_convert(c, a, 1, c.G == 256 ? P11_MOE_U : 0, NE); } }
        if (rep_ + 1 < NREP(15)) GRID_BARRIER(bar); } }
    SEAM(15);
    if (IN(16)) {
#pragma unroll 1
        for (int rep_ = 0; rep_ < NREP(16); ++rep_) { { { const attn_body::AttnTensors AT{(const attn_body::bf16*)(ws + WS_Q), (const attn_body::bf16*)(ws + WS_K), (const attn_body::bf16*)(ws + WS_V), (attn_body::bf16*)(ws + WS_OA0)};
        const attn_body::StaticOrder S((int)c.G, (int)blockIdx.x); attn_body::attn_phase<attn_body::StaticOrder>((char*)lds_raw, AT, S); } }
        if (rep_ + 1 < NREP(16)) GRID_BARRIER(bar); } }
    SEAM(16);
    if (IN(17)) {
#pragma unroll 1
        for (int rep_ = 0; rep_ < NREP(17); ++rep_) { { { phase17(c, a); moe_convert(c, a, 2, 0, P17_MOE_D); } }
        if (rep_ + 1 < NREP(17)) GRID_BARRIER(bar); } }
    SEAM(17);
    if (IN(18)) {
#pragma unroll 1
        for (int rep_ = 0; rep_ < NREP(18); ++rep_) { { { pg8::Gemm g{(const bf16*)(ws + WS_AO), (const bf16*)(ws + WS_WO), D, 0}; pg8::StaticOrder S; S.init(M, D, c.G, c.bx); pg8::EpiResidB E{nullptr, XR, XR, D, nullptr};
        pg8::gemm_phase<pg8::EpiResidB, pg8::StaticOrder, false>(c.lds, g, S, E); } }
        if (rep_ + 1 < NREP(18)) GRID_BARRIER(bar); } }
    SEAM(18);
    if (IN(19)) {
#pragma unroll 1
        for (int rep_ = 0; rep_ < NREP(19); ++rep_) { { phase19(c, a, XR); if (c.G > P6_BUSY) moe_convert(c, a, 0, P6_MOE_E, NE); else moe_convert(c, a, 0); }
        if (rep_ + 1 < NREP(19)) GRID_BARRIER(bar); } }
    SEAM(19);
#if defined(PROBE_P20)
    if (IN(20)) { { pg8::Gemm g{(const bf16*)(ws + WS_XNM), (const bf16*)(ws + WS_WGUM), D / 2, MOE_GU_E8M0}; pg8::MoeOrder S; S.init(ctl + CW_CNT, 2 * ED / 256, c.G, c.bx, (const int*)(ws + WS_LIST));
        pg8::EpiSwiGLU8 E{(unsigned char*)(ws + WS_HM2), ED, MOE_H_SCALE};
        pg8::gemm_phase<pg8::EpiSwiGLU8, pg8::MoeOrder, true, true>(c.lds, g, S, E); } GRID_BARRIER(bar); }
#endif
    if (IN(20)) {
#pragma unroll 1
        for (int rep_ = 0; rep_ < NREP(20); ++rep_) { { { pg8::Gemm g{(const bf16*)(ws + WS_XNM), (const bf16*)(ws + WS_WGUM), D / 2, MOE_GU_E8M0}; pg8::MoeOrder S; S.init(ctl + CW_CNT, 2 * ED / 256, c.G, c.bx, (const int*)(ws + WS_LIST));
        pg8::EpiSwiGLU8 E{(unsigned char*)(ws + WS_HM2), ED, MOE_H_SCALE};
        pg8::gemm_phase<pg8::EpiSwiGLU8, pg8::MoeOrder, true, true>(c.lds, g, S, E);
        { const int cut = S.nwg % (int)c.G;
          if (cut == 0) moe_convert(c, a, 2, P17_MOE_D, NE);
          else if ((int)c.bx >= cut) moe_convert(c, a, 2, P17_MOE_D, NE, ((int)c.bx - cut) * NWAVES + c.wave, ((int)c.G - cut) * NWAVES); } } }
        if (rep_ + 1 < NREP(20)) GRID_BARRIER(bar); } }
    SEAM(20);
#if defined(PROBE_P21)
    if (IN(21)) { { pg8::Gemm g{(const bf16*)(ws + WS_HM2), (const bf16*)(ws + WS_WDM), ED / 2, MOE_DN_E8M0}; pg8::MoeOrder S; S.init(ctl + CW_CNT, D / 256, c.G, c.bx, (const int*)(ws + WS_LIST));
        pg8::EpiStore E{(bf16*)(ws + WS_Y2), D, 0, 0};
        pg8::gemm_phase<pg8::EpiStore, pg8::MoeOrder, false, true>(c.lds, g, S, E); } GRID_BARRIER(bar); }
#endif
    if (IN(21)) {
#pragma unroll 1
        for (int rep_ = 0; rep_ < NREP(21); ++rep_) { { { pg8::Gemm g{(const bf16*)(ws + WS_HM2), (const bf16*)(ws + WS_WDM), ED / 2, MOE_DN_E8M0}; pg8::MoeOrder S; S.init(ctl + CW_CNT, D / 256, c.G, c.bx, (const int*)(ws + WS_LIST));
        const int rtail = S.nwg % (int)c.G; const bool split = P21_SPLIT_EN && rtail > 0 && rtail * pg8::EpiSplitK::SK <= (int)c.G && rtail <= 36;
        if (split) S.lim = S.nwg - rtail;
        pg8::EpiStore E{(bf16*)(ws + WS_Y2), D, 0, 0};
        pg8::gemm_phase<pg8::EpiStore, pg8::MoeOrder, false, true>(c.lds, g, S, E);
        if (P21_TAIL_EN && split && (int)c.bx < rtail * pg8::EpiSplitK::SK) {
            const int tu = (int)c.bx / pg8::EpiSplitK::SK, ks = (int)c.bx % pg8::EpiSplitK::SK;
            pg8::TailOrder TS; pg8::order_map(S.lim + tu, S.nwg, S.t8, S.nN, TS.u0.pm, TS.u0.pn); TS.u0.pb = S.expert_of(TS.u0.pm) * S.nN + TS.u0.pn;
            constexpr int KS = ED / 2 / pg8::EpiSplitK::SK;
            pg8::Gemm g2{(const bf16*)(ws + WS_HM2) + ks * KS, (const bf16*)(ws + WS_WDM) + ks * KS, KS, MOE_DN_E8M0, ED / 2};
            pg8::EpiSplitK E2{(float*)(ws + WS_PART) + (size_t)tu * pg8::EpiSplitK::SK * 65536, ks, ctl + CW_SPL + 16 * tu + P21_CNT_OFF, (bf16*)(ws + WS_Y2), D};
            pg8::gemm_phase<pg8::EpiSplitK, pg8::TailOrder, false, true>(c.lds, g2, TS, E2); } } }
        if (rep_ + 1 < NREP(21)) GRID_BARRIER(bar); } }
    SEAM(21);
    if (IN(22)) {
#pragma unroll 1
        for (int rep_ = 0; rep_ < NREP(22); ++rep_) { { phase22(c, XR, out); }
        if (rep_ + 1 < NREP(22)) GRID_BARRIER(bar); } }
#undef IN
#undef SEAM
}

extern "C" void kernel_launch(void* const* d_in, const int* in_sizes, int n_in, void* d_out, int out_size, void* d_ws, size_t ws_size, hipStream_t stream) {
    static int grid = 0;
    if (grid == 0) {
        if (n_in != 42 || in_sizes[0] != M * D || out_size != M * D || ws_size < WS_END) { fprintf(stderr, "kernel_launch: unexpected shapes (n_in %d, in0 %d, out %d, ws %zu)\n", n_in, n_in > 0 ? in_sizes[0] : -1, out_size, ws_size); grid = -1; return; }
        int dev = 0, cus = 0, per_cu = 0;
        if (hipGetDevice(&dev) != hipSuccess || hipDeviceGetAttribute(&cus, hipDeviceAttributeMultiprocessorCount, dev) != hipSuccess) { grid = -1; return; }
        if (hipFuncSetAttribute((const void*)fwd, hipFuncAttributeMaxDynamicSharedMemorySize, LDS_BYTES) != hipSuccess) { fprintf(stderr, "kernel_launch: hipFuncSetAttribute failed\n"); grid = -1; return; }
        if (hipOccupancyMaxActiveBlocksPerMultiprocessor(&per_cu, (const void*)fwd, NTHR, LDS_BYTES) != hipSuccess || per_cu < 1) fprintf(stderr, "kernel_launch: occupancy query says %d\n", per_cu);
        (void)hipGetLastError();
        grid = cus;
    }
    if (grid < 0) return;
    (void)hipMemsetAsync((char*)d_ws + WS_CTL, 0, CTL_ZERO_BYTES, stream);
    Args a{};
    for (int i = 0; i < 42; ++i) a.in[i] = d_in[i];
    a.out = (float*)d_out; a.ws = (unsigned char*)d_ws;
#if PROBE_BUILD
#ifdef PROBE_ZERO
    a.repmask = 0; a.pad = 0;
#else
    a.repmask = REPMASK; a.pad = 0;
#endif
#endif
#if ONE_LAUNCH
    a.ph_lo = 0; a.ph_hi = LAST_PHASE + 1;
    hipLaunchKernelGGL(fwd, dim3(grid), dim3(NTHR), LDS_BYTES, stream, a);
#else
    for (int p = 0; p <= LAST_PHASE; ++p) { a.ph_lo = p; a.ph_hi = p + 1; hipLaunchKernelGGL(fwd, dim3(grid), dim3(NTHR), LDS_BYTES, stream, a); }
#endif
}
```
